# Optimizing an MI355X kernel written in HIP

```python
import jax, jax.numpy as jnp
from jax import lax
import numpy as np

D_MODEL = 2048
BATCH = 1
SEQ = 16384
DEPTH = 1

CTX_LEN = 256
GRID_W = 64
CHUNK = 128
RET_HEAD_DIM = 128
RET_HEADS = D_MODEL // RET_HEAD_DIM
RET_QK = RET_HEADS * RET_HEAD_DIM
RET_V = RET_HEADS * RET_HEAD_DIM
SSD_INNER = 2 * D_MODEL
SSD_HEAD_DIM = 64
SSD_HEADS = SSD_INNER // SSD_HEAD_DIM
SSD_STATE = 128
SSD_GROUPS = 8
SSD_CONV = 5
SSD_CONV_CH = SSD_INNER + 2 * SSD_GROUPS * SSD_STATE
D_FF = 4 * D_MODEL
ROPE_BASE = 10000.0
EPS = 1e-6
IN_SIZES = (RET_QK, RET_QK, RET_V, RET_V, SSD_INNER, SSD_CONV_CH, 2 * SSD_HEADS, 2 * D_MODEL)
IN_COLS = sum(IN_SIZES)
IN_SPLITS = tuple(int(s) for s in np.cumsum(IN_SIZES)[:-1])

kernel_name = "hybrid_retention_ssd_prefix_dit"


def rms_norm(t, w):
    tf = t.astype(jnp.float32)
    y = tf * lax.rsqrt(jnp.mean(tf * tf, axis=-1, keepdims=True) + EPS)
    return (y * w.astype(jnp.float32)).astype(t.dtype)


def head_layer_norm(y):
    yf = y.astype(jnp.float32)
    mu = jnp.mean(yf, axis=-1, keepdims=True)
    d = yf - mu
    return d * lax.rsqrt(jnp.mean(d * d, axis=-1, keepdims=True) + EPS)


def rope_angles(L):
    rows = L // GRID_W
    row = jnp.repeat(jnp.arange(rows), GRID_W).astype(jnp.float32)
    col = jnp.tile(jnp.arange(GRID_W), rows).astype(jnp.float32)
    n_freq = RET_HEAD_DIM // 4
    freqs = ROPE_BASE ** (-jnp.arange(n_freq, dtype=jnp.float32) / n_freq)
    return row[:, None] * freqs, col[:, None] * freqs


def rotate(t, ang):
    cos = jnp.cos(ang)[None, :, None, :]
    sin = jnp.sin(ang)[None, :, None, :]
    t1, t2 = jnp.split(t, 2, axis=-1)
    return jnp.concatenate([t1 * cos - t2 * sin, t1 * sin + t2 * cos], axis=-1).astype(t.dtype)


def axial_rope(t, ang_row, ang_col):
    half = RET_HEAD_DIM // 2
    return jnp.concatenate([rotate(t[..., :half], ang_row), rotate(t[..., half:], ang_col)], axis=-1)


def chunked_scan(q, k, v, log_a, h0, strict, need_output):
    bsz, L, G, N = q.shape
    H, P = v.shape[2], v.shape[3]
    r = H // G
    nc = L // CHUNK
    q = q.reshape(bsz, nc, CHUNK, G, N)
    k = k.reshape(bsz, nc, CHUNK, G, N)
    v = v.reshape(bsz, nc, CHUNK, G, r, P)
    acs = jnp.cumsum(log_a.astype(jnp.float32).reshape(bsz, nc, CHUNK, G, r), axis=2)
    to_end = jnp.exp(acs[:, :, -1:] - acs)
    chunk_state = jnp.einsum('bcjgn,bcjgrp->bcgrpn', k, v * to_end[..., None]).astype(jnp.float32)
    chunk_decay = jnp.exp(acs[:, :, -1])

    def step(h, inp):
        st, dec = inp
        return dec[..., None, None] * h + st, h

    h_last, h_in = lax.scan(step, h0.astype(jnp.float32).reshape(bsz, G, r, P, N),
                            (jnp.moveaxis(chunk_state, 1, 0), jnp.moveaxis(chunk_decay, 1, 0)))
    h_last = h_last.reshape(bsz, H, P, N)
    if not need_output:
        return None, h_last
    h_in = jnp.moveaxis(h_in, 0, 1)
    y_cross = jnp.einsum('bcign,bcgrpn->bcigrp', q, h_in) * jnp.exp(acs)[..., None]
    acs_t = jnp.moveaxis(acs, 2, -1)
    mask = jnp.tril(jnp.ones((CHUNK, CHUNK), dtype=bool), -1 if strict else 0)
    decay = jnp.exp(jnp.where(mask, acs_t[..., :, None] - acs_t[..., None, :], -jnp.inf))
    scores = jnp.einsum('bcign,bcjgn->bcgij', q, k)
    y_intra = jnp.einsum('bcgrij,bcjgrp->bcigrp', scores[:, :, :, None] * decay, v)
    return (y_intra + y_cross).reshape(bsz, L, H, P), h_last


def bidir_scan(q, k, v_f, v_b, la_f, la_b, h0_f, h0_b, need_output):
    y_f, h_f = chunked_scan(q, k, v_f, la_f, h0_f, False, need_output)
    fl = lambda t: jnp.flip(t, axis=1)
    y_b, h_b = chunked_scan(fl(q), fl(k), fl(v_b), fl(la_b), h0_b, True, need_output)
    y = y_f + fl(y_b) if need_output else None
    return y, h_f, h_b


def centred_dwconv(t, w, b):
    pad = SSD_CONV // 2
    L = t.shape[1]
    tp = jnp.pad(t, ((0, 0), (pad, pad), (0, 0)))
    out = b
    for j in range(SSD_CONV):
        out = out + tp[:, j:j + L] * w[j]
    return out


def token_mixers(u, w_in, conv_w, conv_b, ret_decay_logit, ret_norm_w, ssd_a_log, ssd_dt_bias, ssd_d,
                 ssd_norm_w, w_ret_out, w_ssd_out, rope, init, need_output):
    bsz, L, _ = u.shape
    q, k, v, g_ret, z, xbc, dt_raw, branch_logits = jnp.split(u @ w_in, IN_SPLITS, axis=-1)
    q = q.reshape(bsz, L, RET_HEADS, RET_HEAD_DIM)
    k = k.reshape(bsz, L, RET_HEADS, RET_HEAD_DIM) * (RET_HEAD_DIM ** -0.5)
    if rope is not None:
        q = axial_rope(q, *rope)
        k = axial_rope(k, *rope)
    v = v.reshape(bsz, L, RET_HEADS, RET_HEAD_DIM)
    log_gamma = jax.nn.log_sigmoid(ret_decay_logit.astype(jnp.float32))
    la_rf = jnp.broadcast_to(log_gamma[0], (bsz, L, RET_HEADS))
    la_rb = jnp.broadcast_to(log_gamma[1], (bsz, L, RET_HEADS))
    y_ret, r_f, r_b = bidir_scan(q, k, v, v, la_rf, la_rb, init[0], init[1], need_output)
    xbc = jax.nn.silu(centred_dwconv(xbc, conv_w, conv_b))
    xs, b_in, c_out = jnp.split(xbc, [SSD_INNER, SSD_INNER + SSD_GROUPS * SSD_STATE], axis=-1)
    xs = xs.reshape(bsz, L, SSD_HEADS, SSD_HEAD_DIM)
    b_in = b_in.reshape(bsz, L, SSD_GROUPS, SSD_STATE)
    c_out = c_out.reshape(bsz, L, SSD_GROUPS, SSD_STATE)
    dt = jax.nn.softplus(dt_raw.astype(jnp.float32).reshape(bsz, L, 2, SSD_HEADS) + ssd_dt_bias.astype(jnp.float32))
    a = -jnp.exp(ssd_a_log.astype(jnp.float32))
    y_ssd, s_f, s_b = bidir_scan(c_out, b_in, xs * dt[:, :, 0, :, None], xs * dt[:, :, 1, :, None],
                                 dt[:, :, 0] * a[0], dt[:, :, 1] * a[1], init[2], init[3], need_output)
    states = (r_f, r_b, s_f, s_b)
    if not need_output:
        return None, states
    yr = head_layer_norm(y_ret).reshape(bsz, L, RET_V) * ret_norm_w
    yr = (yr * jax.nn.silu(g_ret.astype(jnp.float32))).astype(u.dtype) @ w_ret_out
    ys = (y_ssd + xs * ssd_d[:, None]).reshape(bsz, L, SSD_INNER)
    ys = rms_norm((ys * jax.nn.silu(z.astype(jnp.float32))).astype(u.dtype), ssd_norm_w) @ w_ssd_out
    g_r, g_s = jnp.split(branch_logits, 2, axis=-1)
    m = jax.nn.sigmoid(g_r) * yr + jax.nn.sigmoid(g_s) * ys
    return m.astype(u.dtype), states


def sq_relu_mlp(t, w1, w2):
    return jnp.square(jax.nn.relu(t @ w1)) @ w2


def setup_inputs(seed: int = 0) -> dict:
    key = jax.random.key(seed)
    ks = jax.random.split(key, 32)
    f32 = jnp.float32
    nrm = lambda kk, shape, fan_in: jax.random.normal(kk, shape, f32) * (fan_in ** -0.5)
    gain = lambda kk, shape: 1.0 + 0.02 * jax.random.normal(kk, shape, f32)
    p = 2.0 ** (-5.0 - jnp.arange(RET_HEADS, dtype=f32))
    logit0 = jnp.log1p(-p) - jnp.log(p)
    ret_decay_logit = jnp.stack([logit0, logit0[::-1]])[None] + 0.01 * jax.random.normal(ks[9], (DEPTH, 2, RET_HEADS), f32)
    dt0 = jnp.exp(jax.random.uniform(ks[12], (DEPTH, 2, SSD_HEADS), f32, jnp.log(1e-3), jnp.log(1e-1)))
    return {
        "x": jax.random.normal(ks[0], (BATCH, SEQ, D_MODEL), f32),
        "c": jax.random.normal(ks[1], (BATCH, D_MODEL), f32),
        "ctx": jax.random.normal(ks[2], (BATCH, CTX_LEN, D_MODEL), f32),
        "c_ctx": jax.random.normal(ks[3], (D_MODEL,), f32),
        "w_mod": 0.5 * nrm(ks[4], (DEPTH, D_MODEL, 6 * D_MODEL), D_MODEL),
        "b_mod": 0.02 * jax.random.normal(ks[5], (DEPTH, 6 * D_MODEL), f32),
        "norm1_w": gain(ks[6], (DEPTH, D_MODEL)),
        "w_in": nrm(ks[7], (DEPTH, D_MODEL, IN_COLS), D_MODEL),
        "conv_w": nrm(ks[8], (DEPTH, SSD_CONV, SSD_CONV_CH), SSD_CONV),
        "conv_b": 0.02 * jax.random.normal(ks[10], (DEPTH, SSD_CONV_CH), f32),
        "ret_decay_logit": ret_decay_logit,
        "ret_norm_w": gain(ks[11], (DEPTH, RET_V)),
        "ssd_a_log": jnp.log(jax.random.uniform(ks[13], (DEPTH, 2, SSD_HEADS), f32, 1.0, 16.0)),
        "ssd_dt_bias": dt0 + jnp.log(-jnp.expm1(-dt0)),
        "ssd_d": 1.0 + 0.1 * jax.random.normal(ks[14], (DEPTH, SSD_HEADS), f32),
        "ssd_norm_w": gain(ks[15], (DEPTH, SSD_INNER)),
        "w_ret_out": nrm(ks[16], (DEPTH, RET_V, D_MODEL), RET_V),
        "w_ssd_out": nrm(ks[17], (DEPTH, SSD_INNER, D_MODEL), SSD_INNER),
        "w_o": nrm(ks[18], (DEPTH, D_MODEL, D_MODEL), D_MODEL),
        "norm2_w": gain(ks[19], (DEPTH, D_MODEL)),
        "w_mlp1": nrm(ks[20], (DEPTH, D_MODEL, D_FF), D_MODEL),
        "w_mlp2": nrm(ks[21], (DEPTH, D_FF, D_MODEL), D_FF),
        "final_norm_w": gain(ks[22], (D_MODEL,)),
    }


def reference(x, c, ctx, c_ctx, w_mod, b_mod, norm1_w, w_in, conv_w, conv_b, ret_decay_logit, ret_norm_w,
              ssd_a_log, ssd_dt_bias, ssd_d, ssd_norm_w, w_ret_out, w_ssd_out, w_o, norm2_w, w_mlp1, w_mlp2,
              final_norm_w):
    bsz, L, _ = x.shape
    rope = rope_angles(L)
    zeros_r = jnp.zeros((bsz, RET_HEADS, RET_HEAD_DIM, RET_HEAD_DIM), jnp.float32)
    zeros_s = jnp.zeros((bsz, SSD_HEADS, SSD_HEAD_DIM, SSD_STATE), jnp.float32)
    ctx_init = (zeros_r, zeros_r, zeros_s, zeros_s)
    h, hc = x, ctx
    for layer in range(DEPTH):
        last = layer == DEPTH - 1
        mod = jax.nn.silu(c) @ w_mod[layer] + b_mod[layer]
        mod_c = jax.nn.silu(c_ctx) @ w_mod[layer] + b_mod[layer]
        sh_a, sc_a, g_a, sh_f, sc_f, g_f = jnp.split(mod[:, None, :], 6, axis=-1)
        csh_a, csc_a, cg_a, csh_f, csc_f, cg_f = jnp.split(mod_c, 6, axis=-1)
        mix_w = (w_in[layer], conv_w[layer], conv_b[layer], ret_decay_logit[layer], ret_norm_w[layer],
                 ssd_a_log[layer], ssd_dt_bias[layer], ssd_d[layer], ssd_norm_w[layer],
                 w_ret_out[layer], w_ssd_out[layer])
        uc = rms_norm(hc, norm1_w[layer]) * (1.0 + csc_a) + csh_a
        mc, ctx_states = token_mixers(uc, *mix_w, None, ctx_init, not last)
        u = rms_norm(h, norm1_w[layer]) * (1.0 + sc_a) + sh_a
        m, _ = token_mixers(u, *mix_w, rope, ctx_states, True)
        h = h + g_a * (m @ w_o[layer])
        f = rms_norm(h, norm2_w[layer]) * (1.0 + sc_f) + sh_f
        h = h + g_f * sq_relu_mlp(f, w_mlp1[layer], w_mlp2[layer])
        if not last:
            hc = hc + cg_a * (mc @ w_o[layer])
            fc = rms_norm(hc, norm2_w[layer]) * (1.0 + csc_f) + csh_f
            hc = hc + cg_f * sq_relu_mlp(fc, w_mlp1[layer], w_mlp2[layer])
    return rms_norm(h, final_norm_w)
```

```cpp
#include <hip/hip_runtime.h>
#include <hip/hip_cooperative_groups.h>
#include <cstdio>
#include <cstdint>
namespace cg = cooperative_groups;

typedef unsigned short bf16_t;
typedef short bf16x8 __attribute__((ext_vector_type(8)));
typedef short bf16x4 __attribute__((ext_vector_type(4)));
typedef float f32x4 __attribute__((ext_vector_type(4)));
typedef float f32x2 __attribute__((ext_vector_type(2)));
typedef unsigned u32x4 __attribute__((ext_vector_type(4)));
typedef unsigned u32x2 __attribute__((ext_vector_type(2)));

constexpr int DM = 2048, SEQ = 16384, CTX = 256, R = SEQ + CTX, CH = 256, NCH = 65;
constexpr int INC = 22656, DFF = 8192;
constexpr float EPS = 1e-6f;
constexpr int NTH = 512;
constexpr int LDS_BYTES = 147456;
#ifndef DUP_MASK
#define DUP_MASK 0
#endif
#ifndef PHASE_MASK
#define PHASE_MASK 0x7fff
#endif

constexpr size_t SZQ = (size_t)R * 2048 * 2;
constexpr size_t OFF_Q = 0;
constexpr size_t OFF_K = OFF_Q + SZQ;
constexpr size_t OFF_VT = OFF_K + SZQ;
constexpr size_t OFF_XT = OFF_VT + SZQ;
constexpr size_t OFF_B = OFF_XT + 2 * SZQ;
constexpr size_t OFF_C = OFF_B + SZQ / 2;
constexpr size_t OFF_DTRAW = OFF_C + SZQ / 2;
constexpr size_t SZ_DTA = (size_t)R * 64 * 4;
constexpr size_t OFF_DTF = OFF_DTRAW + (size_t)R * 128 * 4;
constexpr size_t OFF_DTB = OFF_DTF + SZ_DTA;
constexpr size_t OFF_CSF = OFF_DTB + SZ_DTA;
constexpr size_t OFF_RCSB = OFF_CSF + SZ_DTA;
constexpr size_t OFF_SR = OFF_RCSB + SZ_DTA;
constexpr size_t OFF_SS = OFF_SR + SZQ;
constexpr size_t OFF_WA = OFF_SS + 2 * SZQ;
constexpr size_t OFF_WRO = OFF_WA + (size_t)12544 * 2048 * 2;
constexpr size_t OFF_WSO = OFF_WRO + (size_t)2048 * 2048 * 2;
constexpr size_t OFF_WO = OFF_WSO + (size_t)2048 * 4096 * 2;
constexpr size_t OFF_MOD = OFF_WO + (size_t)2048 * 2048 * 2;
constexpr size_t OFF_SUMSQ = OFF_MOD + 2 * 12288 * 4;
constexpr size_t OFF_BAR = OFF_SUMSQ + (size_t)SEQ * 4;
constexpr size_t OFF_SUMSQ2 = OFF_BAR + 16384;
constexpr size_t OFF_BIAS1 = OFF_SUMSQ2 + (size_t)SEQ * 4;
constexpr size_t OFF_ROPE = OFF_BIAS1 + (size_t)DFF * 4;
constexpr size_t WS_NEED = OFF_ROPE + 256 * 32 * 2 * 4;
constexpr size_t OFF_BCRAW = OFF_SR, OFF_XTRAW = OFF_SS, OFF_YS = OFF_K, OFF_W1T = OFF_SR, OFF_W2T = OFF_SR + (size_t)8192 * 2048 * 2;
constexpr size_t OFF_G = OFF_XT, OFF_H1 = OFF_SS, OFF_M = OFF_B, OFF_F = OFF_Q, OFF_A1 = OFF_K;
constexpr size_t OOFF_U = 0, OOFF_WB = SZQ;

struct Params {
  const float *x, *c, *ctx, *c_ctx, *w_mod, *b_mod, *norm1_w, *w_in, *conv_w, *conv_b, *ret_decay_logit, *ret_norm_w, *ssd_a_log,
      *ssd_dt_bias, *ssd_d, *ssd_norm_w, *w_ret_out, *w_ssd_out, *w_o, *norm2_w, *w_mlp1, *w_mlp2, *final_norm_w;
  unsigned char* ws;
  unsigned char* out;
};

extern __shared__ __attribute__((aligned(16))) unsigned char smem[];

typedef __bf16 bf16x2_t __attribute__((ext_vector_type(2)));
__device__ __forceinline__ unsigned cvt_pk_bf16(float lo, float hi) {
  f32x2 v = {lo, hi};
  bf16x2_t b = __builtin_convertvector(v, bf16x2_t);
  return __builtin_bit_cast(unsigned, b);
}
__device__ __forceinline__ float bf2f(unsigned short v) { return __uint_as_float((unsigned)v << 16); }
__device__ __forceinline__ float bflo(unsigned v) { return __uint_as_float(v << 16); }
__device__ __forceinline__ float bfhi(unsigned v) { return __uint_as_float(v & 0xffff0000u); }
__device__ __forceinline__ float sigmoidf_(float x) { return __builtin_amdgcn_rcpf(1.0f + __expf(-x)); }
__device__ __forceinline__ float siluf_(float x) { return x * __builtin_amdgcn_rcpf(1.0f + __expf(-x)); }
__device__ __forceinline__ float softplusf_(float x) { const float e = __expf(x); return x > 20.f ? x : (x < -6.f ? e * (1.0f - 0.5f * e) : __logf(1.0f + e)); }
__device__ __forceinline__ float wave_sum(float v) {
#pragma unroll
  for (int o = 32; o > 0; o >>= 1) v += __shfl_xor(v, o);
  return v;
}
__device__ __forceinline__ bf16x8 mk8(bf16x4 a, bf16x4 b) { return __builtin_shufflevector(a, b, 0, 1, 2, 3, 4, 5, 6, 7); }
__device__ __forceinline__ bf16x8 as_bf16x8(u32x4 v) { union { u32x4 u; bf16x8 b; } x; x.u = v; return x.b; }
__device__ __forceinline__ u32x4 as_u32x4(bf16x8 v) { union { u32x4 u; bf16x8 b; } x; x.b = v; return x.u; }
#define MFMA(a, b, c) __builtin_amdgcn_mfma_f32_16x16x32_bf16((a), (b), (c), 0, 0, 0)

constexpr int BM = 256, BK = 64, HALF = 128, HT = HALF * BK;
__device__ __forceinline__ int lds_byte(int r, int c) {
  int st = (r >> 4) * 2 + (c >> 5), rr = r & 15, cc = c & 31, ob = rr * 64 + cc * 2;
  return st * 1024 + (ob ^ (((ob >> 9) & 1) << 5));
}
__device__ __forceinline__ void stage_rc(int b, int& Rr, int& Cc) {
  int st = b / 1024, sb = b % 1024, swz = sb ^ (((sb >> 9) & 1) << 5);
  Rr = (st >> 1) * 16 + swz / 64;
  Cc = (st & 1) * 32 + (swz % 64) / 2;
}

template <class Epi>
__device__ __forceinline__ void gemm_unit(const bf16_t* __restrict__ A, int lda, const bf16_t* __restrict__ Bt, int ldb, int K, int pm,
                                          int pn, const Epi& epi) {
  typedef __attribute__((address_space(3))) unsigned char lds_u8;
  lds_u8* lds = (lds_u8*)smem;
  int tid = threadIdx.x;
  asm volatile("" : "+v"(tid));
  const int wid = __builtin_amdgcn_readfirstlane(tid >> 6), lane = tid & 63, wr = wid >> 2, wc = wid & 3, fr = lane & 15, fq = lane >> 4;
  unsigned voffA[2], voffB[2];
#pragma unroll
  for (int i = 0; i < 2; ++i) { int Rr, Cc; stage_rc(tid * 16 + i * 8192, Rr, Cc); voffA[i] = (unsigned)(Rr * lda + Cc) * 2u; voffB[i] = (unsigned)(Rr * ldb + Cc) * 2u; }
  const size_t kstep = (size_t)(BK * 2);
  const size_t hstepA = (size_t)HALF * lda * 2, hstepB = (size_t)HALF * ldb * 2;
  const unsigned ldsw = (unsigned)wid * 1024u;
  const int aoff = lds_byte(wr * 64 + fr, fq * 8), boff = lds_byte(wc * 32 + fr, fq * 8);
  constexpr int HTB = HT * 2;
#define SAo(b, h) (((b) * 2 + (h)) * HTB)
#define SBo(b, h) ((4 + (b) * 2 + (h)) * HTB)
#define STAGE(bufoff, gbase, voff) do { _Pragma("unroll") for (int _i = 0; _i < 2; ++_i) \
    __builtin_amdgcn_global_load_lds((const unsigned*)((const char*)(gbase) + (voff)[_i]), (__attribute__((address_space(3))) unsigned*)(lds + (bufoff) + ldsw + _i * 8192), 16, 0, 0); } while (0)
#define LDA(dst, b, h) do { _Pragma("unroll") for (int m = 0; m < 4; ++m) _Pragma("unroll") for (int k = 0; k < 2; ++k) dst[m][k] = *(const __attribute__((address_space(3))) bf16x8*)(lds + SAo(b, h) + aoff + m * 2048 + k * 1024); } while (0)
#define LDB(dst, b, h) do { _Pragma("unroll") for (int n = 0; n < 2; ++n) _Pragma("unroll") for (int k = 0; k < 2; ++k) dst[n][k] = *(const __attribute__((address_space(3))) bf16x8*)(lds + SBo(b, h) + boff + n * 2048 + k * 1024); } while (0)
#define MMA(ai, bj, At_, Bt_) do { __builtin_amdgcn_s_setprio(1); _Pragma("unroll") for (int m = 0; m < 4; ++m) _Pragma("unroll") for (int n = 0; n < 2; ++n) _Pragma("unroll") for (int k = 0; k < 2; ++k) \
    acc[ai][bj][m][n] = MFMA(Bt_[n][k], At_[m][k], acc[ai][bj][m][n]); __builtin_amdgcn_s_setprio(0); } while (0)
#define WAIT_V(n) asm volatile("s_waitcnt vmcnt(" #n ")" ::: "memory")
#define WAIT_L(n) asm volatile("s_waitcnt lgkmcnt(" #n ")" ::: "memory")
#define BAR __builtin_amdgcn_s_barrier()
#define SCHED __builtin_amdgcn_sched_barrier(0)
  const int brow = pm * BM, bcol = pn * BM;
  f32x4 acc[2][2][4][2];
#pragma unroll
  for (int a = 0; a < 2; ++a)
#pragma unroll
    for (int b = 0; b < 2; ++b)
#pragma unroll
      for (int m = 0; m < 4; ++m)
#pragma unroll
        for (int n = 0; n < 2; ++n) acc[a][b][m][n] = (f32x4){0.f, 0.f, 0.f, 0.f};
  bf16x8 At[4][2], B0[2][2], B1[2][2];
  const int nt = K / BK;
  const char* cA = (const char*)A + (size_t)brow * lda * 2;
  const char* cB = (const char*)Bt + (size_t)bcol * ldb * 2;
  STAGE(SBo(0, 0), cB, voffB); STAGE(SAo(0, 0), cA, voffA); STAGE(SBo(0, 1), cB + hstepB, voffB); STAGE(SAo(0, 1), cA + hstepA, voffA);
  if (wr == 1) BAR;
  WAIT_V(4); BAR;
  STAGE(SBo(1, 0), cB + kstep, voffB); STAGE(SAo(1, 0), cA + kstep, voffA); STAGE(SBo(1, 1), cB + hstepB + kstep, voffB);
  WAIT_V(6); BAR;
  for (int t = 0; t < nt - 2; t += 2) {
    const char* a1 = cA + (size_t)(t + 1) * kstep;
    const char* a2 = cA + (size_t)(t + 2) * kstep; const char* b2 = cB + (size_t)(t + 2) * kstep;
    const char* a3 = a2 + kstep; const char* b3 = b2 + kstep;
    LDB(B0, 0, 0); SCHED; LDA(At, 0, 0); STAGE(SAo(1, 1), a1 + hstepA, voffA);
    WAIT_L(8); BAR; WAIT_L(0); MMA(0, 0, At, B0); BAR; SCHED;
    LDB(B1, 0, 1); STAGE(SBo(0, 0), b2, voffB);
    BAR; WAIT_L(0); MMA(0, 1, At, B1); BAR;
    LDA(At, 0, 1); STAGE(SAo(0, 0), a2, voffA);
    BAR; WAIT_L(0); MMA(1, 0, At, B0); BAR; SCHED;
    STAGE(SBo(0, 1), b2 + hstepB, voffB);
    WAIT_V(6); BAR; MMA(1, 1, At, B1); BAR;
    LDB(B0, 1, 0); SCHED; LDA(At, 1, 0); STAGE(SAo(0, 1), a2 + hstepA, voffA);
    WAIT_L(8); BAR; WAIT_L(0); MMA(0, 0, At, B0); BAR; SCHED;
    LDB(B1, 1, 1); STAGE(SBo(1, 0), b3, voffB);
    BAR; WAIT_L(0); MMA(0, 1, At, B1); BAR;
    LDA(At, 1, 1); STAGE(SAo(1, 0), a3, voffA);
    BAR; WAIT_L(0); MMA(1, 0, At, B0); BAR; SCHED;
    STAGE(SBo(1, 1), b3 + hstepB, voffB);
    WAIT_V(6); BAR; MMA(1, 1, At, B1); BAR;
  }
  { const char* a1 = cA + (size_t)(nt - 1) * kstep;
    LDB(B0, 0, 0); LDA(At, 0, 0); STAGE(SAo(1, 1), a1 + hstepA, voffA);
    BAR; WAIT_L(0); MMA(0, 0, At, B0); BAR;
    LDB(B1, 0, 1); BAR; WAIT_L(0); MMA(0, 1, At, B1); BAR;
    LDA(At, 0, 1); WAIT_V(4); BAR; WAIT_L(0); MMA(1, 0, At, B0); MMA(1, 1, At, B1); BAR; }
  { LDB(B0, 1, 0); LDA(At, 1, 0); WAIT_V(2); BAR; WAIT_L(0); MMA(0, 0, At, B0); BAR;
    LDB(B1, 1, 1); WAIT_V(0); BAR; WAIT_L(0); MMA(0, 1, At, B1); BAR;
    LDA(At, 1, 1); BAR; WAIT_L(0); MMA(1, 0, At, B0); MMA(1, 1, At, B1); BAR; }
  if (wr == 0) BAR;
#pragma unroll
  for (int ai = 0; ai < 2; ++ai)
#pragma unroll
    for (int m = 0; m < 4; ++m) {
      const int row = brow + ai * HALF + wr * 64 + m * 16 + fr;
#pragma unroll
      for (int bj = 0; bj < 2; ++bj)
#pragma unroll
        for (int n = 0; n < 2; ++n) epi(acc[ai][bj][m][n], row, bcol + bj * HALF + wc * 32 + n * 16 + fq * 4, pm, pn);
      asm volatile("" ::: "memory");
    }
  __syncthreads();
}

__device__ __forceinline__ void unit_map(int wgid, int nM, int nN, int& pm, int& pn) {
  const int nwg = nM * nN, NX = 8, WGM = 2;
  { const int q = nwg / NX, r = nwg % NX, xcd = wgid % NX, off = wgid / NX; wgid = (xcd < r ? xcd * (q + 1) : r * (q + 1) + (xcd - r) * q) + off; }
  const int nig = WGM * nN, gid = wgid / nig, fm = gid * WGM, gsz = (nM - fm) < WGM ? (nM - fm) : WGM;
  pm = fm + ((wgid % nig) % gsz);
  pn = (wgid % nig) / gsz;
}

struct EpiA1 {
  bf16_t *Q, *Kb, *BC; float* DTRAW; const float* rope;
  __device__ __forceinline__ void operator()(const f32x4& v, int row, int col, int pm, int pn) const {
    if (pn < 16) {
      f32x4 o = v;
      const bool isk = pn >= 8;
      if (isk) o = o * 0.08838834764831845f;
      if (pm > 0) {
        const int t = row - CTX, cl = col & 127, half = cl >> 6, d0 = (cl & 63) >> 1;
        const int pos = half ? (t & 63) : (t >> 6);
        const f32x4 cs = *(const f32x4*)(rope + ((size_t)pos * 32 + d0) * 2);
        f32x4 q;
        q[0] = o[0] * cs[0] - o[1] * cs[1]; q[1] = o[0] * cs[1] + o[1] * cs[0];
        q[2] = o[2] * cs[2] - o[3] * cs[3]; q[3] = o[2] * cs[3] + o[3] * cs[2];
        o = q;
      }
      u32x2 w; w.x = cvt_pk_bf16(o[0], o[1]); w.y = cvt_pk_bf16(o[2], o[3]);
      bf16_t* dst = (isk ? Kb : Q) + (size_t)row * 2048 + (col & 2047);
      *(u32x2*)dst = w;
    } else if (pn < 24) {
      u32x2 w; w.x = cvt_pk_bf16(v[0], v[1]); w.y = cvt_pk_bf16(v[2], v[3]);
      *(u32x2*)(BC + (size_t)row * 2048 + (col - 4096)) = w;
    } else {
      const int cl = col - 6144;
      if (cl < 128) *(f32x4*)(DTRAW + (size_t)row * 128 + cl) = v;
    }
  }
};
struct EpiA2 {
  bf16_t *VT, *XTRAW;
  __device__ __forceinline__ void operator()(const f32x4& v, int row, int col, int pm, int pn) const {
    u32x2 w; w.x = cvt_pk_bf16(v[0], v[1]); w.y = cvt_pk_bf16(v[2], v[3]);
    bf16_t* dst = row < 2048 ? VT + (size_t)row * R + col : XTRAW + (size_t)(row - 2048) * R + col;
    *(u32x2*)dst = w;
  }
};
struct EpiB {
  bf16_t *Q, *YS, *G; const float* ssd_norm_w; float* SUMSQ;
  __device__ __forceinline__ void operator()(const f32x4& v, int row, int col, int pm, int pn) const {
    if (pn < 8) {
      bf16_t* p = Q + (size_t)(row + CTX) * 2048 + col;
      const u32x2 y = *(const u32x2*)p;
      u32x2 w;
      w.x = cvt_pk_bf16(bflo(y.x) * siluf_(v[0]), bfhi(y.x) * siluf_(v[1]));
      w.y = cvt_pk_bf16(bflo(y.y) * siluf_(v[2]), bfhi(y.y) * siluf_(v[3]));
      *(u32x2*)p = w;
    } else if (pn < 24) {
      const int zc = col - 2048;
      bf16_t* p = YS + (size_t)row * 4096 + zc;
      const u32x2 y = *(const u32x2*)p;
      const f32x4 nw = *(const f32x4*)(ssd_norm_w + zc);
      const float t0 = bflo(y.x) * siluf_(v[0]), t1 = bfhi(y.x) * siluf_(v[1]), t2 = bflo(y.y) * siluf_(v[2]), t3 = bfhi(y.y) * siluf_(v[3]);
      float ss = t0 * t0 + t1 * t1 + t2 * t2 + t3 * t3;
      ss += __shfl_xor(ss, 16); ss += __shfl_xor(ss, 32);
      if ((threadIdx.x & 48) == 0) atomicAdd(SUMSQ + row, ss);
      u32x2 w; w.x = cvt_pk_bf16(t0 * nw[0], t1 * nw[1]); w.y = cvt_pk_bf16(t2 * nw[2], t3 * nw[3]);
      *(u32x2*)p = w;
    } else {
      u32x2 w; w.x = cvt_pk_bf16(sigmoidf_(v[0]), sigmoidf_(v[1])); w.y = cvt_pk_bf16(sigmoidf_(v[2]), sigmoidf_(v[3]));
      *(u32x2*)(G + (size_t)row * 4096 + (col - 6144)) = w;
    }
  }
};
struct EpiO1a {
  const bf16_t* G; bf16_t* M;
  __device__ __forceinline__ void operator()(const f32x4& v, int row, int col, int pm, int pn) const {
    const u32x2 g = *(const u32x2*)(G + (size_t)row * 4096 + col);
    u32x2 w;
    w.x = cvt_pk_bf16(bflo(g.x) * v[0], bfhi(g.x) * v[1]);
    w.y = cvt_pk_bf16(bflo(g.y) * v[2], bfhi(g.y) * v[3]);
    *(u32x2*)(M + (size_t)row * 2048 + col) = w;
  }
};
struct EpiO1b {
  const bf16_t* G; const float* SUMSQ; bf16_t* M;
  __device__ __forceinline__ void operator()(const f32x4& v, int row, int col, int pm, int pn) const {
    const u32x2 g = *(const u32x2*)(G + (size_t)row * 4096 + 2048 + col);
    const float r = rsqrtf(SUMSQ[row] * (1.0f / 4096.0f) + EPS);
    const u32x2 t = *(const u32x2*)(M + (size_t)row * 2048 + col);
    u32x2 w;
    w.x = cvt_pk_bf16(bflo(t.x) + bflo(g.x) * r * v[0], bfhi(t.x) + bfhi(g.x) * r * v[1]);
    w.y = cvt_pk_bf16(bflo(t.y) + bflo(g.y) * r * v[2], bfhi(t.y) + bfhi(g.y) * r * v[3]);
    *(u32x2*)(M + (size_t)row * 2048 + col) = w;
  }
};
struct EpiRes {
  const float* base; const float* gate; float* H; bool do_store;
  __device__ __forceinline__ void operator()(const f32x4& v, int row, int col, int pm, int pn) const {
    const f32x4 b = *(const f32x4*)(base + (size_t)row * 2048 + col);
    const f32x4 g = *(const f32x4*)(gate + col);
    if (do_store) *(f32x4*)(H + (size_t)row * 2048 + col) = b + g * v;
  }
};
struct EpiRes9 {
  const float* base; const float* gate; float* H; const float* nw; const float* scf; bf16_t* F; float* SS2;
  __device__ __forceinline__ void operator()(const f32x4& v, int row, int col, int pm, int pn) const {
    const f32x4 b = *(const f32x4*)(base + (size_t)row * 2048 + col);
    const f32x4 g = *(const f32x4*)(gate + col);
    const f32x4 h = b + g * v;
    *(f32x4*)(H + (size_t)row * 2048 + col) = h;
    const f32x4 w = *(const f32x4*)(nw + col), sc = *(const f32x4*)(scf + col);
    u32x2 o;
    o.x = cvt_pk_bf16(h[0] * w[0] * (1.0f + sc[0]), h[1] * w[1] * (1.0f + sc[1]));
    o.y = cvt_pk_bf16(h[2] * w[2] * (1.0f + sc[2]), h[3] * w[3] * (1.0f + sc[3]));
    *(u32x2*)(F + (size_t)row * 2048 + col) = o;
    float ss = h[0] * h[0] + h[1] * h[1] + h[2] * h[2] + h[3] * h[3];
    ss += __shfl_xor(ss, 16); ss += __shfl_xor(ss, 32);
    if ((threadIdx.x & 48) == 0) atomicAdd(SS2 + row, ss);
  }
};
struct EpiM1 {
  bf16_t* A1; const float* SS2; const float* bias1;
  __device__ __forceinline__ void operator()(const f32x4& v, int row, int col, int pm, int pn) const {
    const float r_ = rsqrtf(SS2[row] * (1.0f / DM) + EPS);
    const f32x4 bi = *(const f32x4*)(bias1 + col);
    f32x4 o;
#pragma unroll
    for (int j = 0; j < 4; ++j) { const float r = fmaxf(v[j] * r_ + bi[j], 0.f); o[j] = r * r; }
    u32x2 w; w.x = cvt_pk_bf16(o[0], o[1]); w.y = cvt_pk_bf16(o[2], o[3]);
    *(u32x2*)(A1 + (size_t)row * DFF + col) = w;
  }
};

__device__ __forceinline__ void convert_tile(const float* __restrict__ src, int ldw, int c0, int K, bf16_t* __restrict__ dst, int tc, int kt, int tid) {
  float* tile = (float*)smem;
  const int c4 = (tid & 63) * 4, kq = tid >> 6;
  f32x4 v[8];
#pragma unroll
  for (int i = 0; i < 8; ++i) v[i] = *(const f32x4*)(src + (size_t)(kt * 64 + kq + i * 8) * ldw + c0 + tc * 256 + c4);
#pragma unroll
  for (int i = 0; i < 8; ++i) {
    float* tp = tile + (kq + i * 8) * 257 + c4;
    tp[0] = v[i][0]; tp[1] = v[i][1]; tp[2] = v[i][2]; tp[3] = v[i][3];
  }
  __syncthreads();
  const int c = tid >> 1, k32 = (tid & 1) * 32;
  bf16_t* dp = dst + (size_t)(tc * 256 + c) * K + kt * 64 + k32;
#pragma unroll
  for (int q = 0; q < 4; ++q) {
    const float* tp = tile + (k32 + q * 8) * 257 + c;
    u32x4 w;
    w.x = cvt_pk_bf16(tp[0], tp[257]); w.y = cvt_pk_bf16(tp[2 * 257], tp[3 * 257]);
    w.z = cvt_pk_bf16(tp[4 * 257], tp[5 * 257]); w.w = cvt_pk_bf16(tp[6 * 257], tp[7 * 257]);
    *(u32x4*)(dp + q * 8) = w;
  }
}

__device__ __forceinline__ void convert_segment(const float* __restrict__ src, int ldw, int c0, int ncols, int K, bf16_t* __restrict__ dst, bool perm,
                                                const float* bias_vec = nullptr, float* bias_out = nullptr) {
  float* tile = (float*)smem;
  int tid = threadIdx.x;
  asm volatile("" : "+v"(tid));
  const int tk = K / 64, ntc = (ncols + 255) / 256, ntiles = ntc * tk;
  const int c4 = (tid & 63) * 4, kq = tid >> 6;
  f32x4 v[8];
  auto load_tile = [&](int t) {
    const int tc = t / tk, kt = t % tk;
    const bool okc = tc * 256 + c4 < ncols;
#pragma unroll
    for (int i = 0; i < 8; ++i)
      v[i] = okc ? *(const f32x4*)(src + (size_t)(kt * 64 + kq + i * 8) * ldw + c0 + tc * 256 + c4) : (f32x4){0.f, 0.f, 0.f, 0.f};
  };
  if ((int)blockIdx.x < ntiles) load_tile(blockIdx.x);
  for (int t = blockIdx.x; t < ntiles; t += gridDim.x) {
    const int tc = t / tk, kt = t % tk;
    __syncthreads();
#pragma unroll
    for (int i = 0; i < 8; ++i) {
      float* tp = tile + (kq + i * 8) * 257 + c4;
      tp[0] = v[i][0]; tp[1] = v[i][1]; tp[2] = v[i][2]; tp[3] = v[i][3];
    }
    if (t + (int)gridDim.x < ntiles) load_tile(t + gridDim.x);
    __syncthreads();
    if (bias_out != nullptr && tid < 256) {
      float a = 0.f;
#pragma unroll 8
      for (int k = 0; k < 64; ++k) a += tile[k * 257 + tid] * bias_vec[kt * 64 + k];
      atomicAdd(bias_out + tc * 256 + tid, a);
    }
    {
      const int c = tid >> 1, k32 = (tid & 1) * 32;
      const int cr = c & 63;
      const int sc = perm ? ((c & ~63) + (cr & 1) * 32 + (cr >> 1)) : c;
      if (tc * 256 + c < ncols) {
        bf16_t* dp = dst + (size_t)(tc * 256 + c) * K + kt * 64 + k32;
#pragma unroll
        for (int q = 0; q < 4; ++q) {
          const float* tp = tile + (k32 + q * 8) * 257 + sc;
          u32x4 w;
          w.x = cvt_pk_bf16(tp[0], tp[257]); w.y = cvt_pk_bf16(tp[2 * 257], tp[3 * 257]);
          w.z = cvt_pk_bf16(tp[4 * 257], tp[5 * 257]); w.w = cvt_pk_bf16(tp[6 * 257], tp[7 * 257]);
          *(u32x4*)(dp + q * 8) = w;
        }
      }
    }
  }
  __syncthreads();
}

__device__ __forceinline__ void modnorm_rows(const float* __restrict__ xa, int rows_a, const float* __restrict__ xb, int rows_b, const float* __restrict__ nw,
                             const float* __restrict__ sca, const float* __restrict__ sha, const float* __restrict__ scb,
                             const float* __restrict__ shb, bf16_t* __restrict__ outp) {
  int tid = threadIdx.x;
  asm volatile("" : "+v"(tid));
  const int lane = tid & 63, gw = blockIdx.x * (NTH / 64) + (tid >> 6), nw_ = gridDim.x * (NTH / 64);
  for (int r = gw; r < rows_a + rows_b; r += nw_) {
    const bool isa = r < rows_a;
    const float* xr = isa ? xa + (size_t)r * DM : xb + (size_t)(r - rows_a) * DM;
    const float* sc = isa ? sca : scb;
    const float* sh = isa ? sha : shb;
    f32x4 v[8];
    float ss = 0.f;
#pragma unroll
    for (int i = 0; i < 8; ++i) { v[i] = *(const f32x4*)(xr + i * 256 + lane * 4); ss += v[i][0] * v[i][0] + v[i][1] * v[i][1] + v[i][2] * v[i][2] + v[i][3] * v[i][3]; }
    ss = wave_sum(ss);
    const float rs = rsqrtf(ss * (1.0f / DM) + EPS);
#pragma unroll
    for (int i = 0; i < 8; ++i) {
      const int cidx = i * 256 + lane * 4;
      const f32x4 w = *(const f32x4*)(nw + cidx), s = *(const f32x4*)(sc + cidx), b = *(const f32x4*)(sh + cidx);
      f32x4 o;
#pragma unroll
      for (int j = 0; j < 4; ++j) o[j] = v[i][j] * rs * w[j] * (1.0f + s[j]) + b[j];
      u32x2 pk; pk.x = cvt_pk_bf16(o[0], o[1]); pk.y = cvt_pk_bf16(o[2], o[3]);
      *(u32x2*)(outp + (size_t)r * DM + cidx) = pk;
    }
  }
}

template <int MODE>
__device__ __forceinline__ void state_build_item(const Params& p, int c, int hg) {
  unsigned char* ws = p.ws;
  int tid = threadIdx.x;
  asm volatile("" : "+v"(tid));
  const int wid = tid >> 6, lane = tid & 63, fr = lane & 15, fq = lane >> 4;
  bf16_t* Kt = (bf16_t*)smem;
  bf16_t* Vt = (bf16_t*)(smem + 67584);
  float* wfs = (float*)(smem + 135168);
  float* wbs = wfs + 256;
  const bf16_t* Ksrc = MODE == 0 ? (const bf16_t*)(ws + OFF_K) : (const bf16_t*)(ws + OFF_B);
  const int kld = MODE == 0 ? 2048 : 1024;
  constexpr int NV = MODE == 0 ? 8 : 4;
  const bf16_t* Vsrc = MODE == 0 ? (const bf16_t*)(ws + OFF_VT) : (const bf16_t*)(ws + OFF_XT);
  const int PH = MODE == 0 ? 128 : 64;
  const float* CSF = (const float*)(ws + OFF_CSF); const float* RCSB = (const float*)(ws + OFF_RCSB);
  const float* DTF = (const float*)(ws + OFF_DTF); const float* DTB = (const float*)(ws + OFF_DTB);
  u32x4 vv[NV];
  float wr_[6] = {0.f, 0.f, 0.f, 0.f, 0.f, 0.f};
#define SB_PREFETCH(H_)                                                                                               \
  do {                                                                                                                \
    _Pragma("unroll") for (int i = 0; i < NV; ++i) {                                                                  \
      const int idx = tid + i * NTH, pp = idx >> 5, chn = idx & 31;                                                   \
      vv[i] = *(const u32x4*)(Vsrc + (size_t)((H_) * PH + pp) * R + c * CH + chn * 8);                                \
    }                                                                                                                 \
    if (MODE == 1 && tid < 256) {                                                                                     \
      const size_t rj = (size_t)(c * CH + tid) * 64 + (H_);                                                           \
      wr_[0] = CSF[(size_t)(c * CH + 255) * 64 + (H_)]; wr_[1] = CSF[rj]; wr_[2] = DTF[rj];                           \
      wr_[3] = RCSB[(size_t)(c * CH) * 64 + (H_)]; wr_[4] = RCSB[rj]; wr_[5] = DTB[rj];                               \
    }                                                                                                                 \
  } while (0)
  bf16x8 kv[8];
#pragma unroll
  for (int i = 0; i < 8; ++i) {
    const int idx = tid + i * NTH, j = idx >> 4, chn = idx & 15;
    kv[i] = *(const bf16x8*)(Ksrc + (size_t)(c * CH + j) * kld + hg * 128 + chn * 8);
  }
  SB_PREFETCH(MODE == 0 ? hg : hg * 8);
  __syncthreads();
#pragma unroll
  for (int i = 0; i < 8; ++i) {
    const int idx = tid + i * NTH, j = idx >> 4, chn = idx & 15;
#pragma unroll
    for (int e = 0; e < 8; ++e) Kt[(chn * 8 + e) * 264 + j] = (bf16_t)kv[i][e];
  }
  const int nheads = MODE == 0 ? 1 : 8;
  for (int hh = 0; hh < nheads; ++hh) {
    const int h = MODE == 0 ? hg : hg * 8 + hh;
    if (hh > 0) __syncthreads();
#pragma unroll
    for (int i = 0; i < NV; ++i) {
      const int idx = tid + i * NTH, pp = idx >> 5, chn = idx & 31;
      *(u32x4*)(Vt + pp * 264 + chn * 8) = vv[i];
    }
    if (tid < 256) {
      if (MODE == 0) {
        const float lgf = -log1pf(__expf(-p.ret_decay_logit[h])) * 1.4426950408889634f;
        const float lgb = -log1pf(__expf(-p.ret_decay_logit[16 + h])) * 1.4426950408889634f;
        wfs[tid] = exp2f((float)(255 - tid) * lgf);
        wbs[tid] = exp2f((float)tid * lgb);
      } else {
        wfs[tid] = __expf(wr_[0] - wr_[1]) * wr_[2];
        wbs[tid] = __expf(wr_[3] - wr_[4]) * wr_[5];
      }
    }
    __syncthreads();
    if (MODE == 1 && hh + 1 < nheads) SB_PREFETCH(h + 1);
    constexpr int NTL = MODE == 0 ? 8 : 4;
    const int p0 = MODE == 0 ? wid * 16 : (wid & 3) * 16;
    const int nt0 = MODE == 0 ? 0 : (wid >> 2) * 4;
    f32x4 af[NTL], ab[NTL];
#pragma unroll
    for (int i = 0; i < NTL; ++i) { af[i] = (f32x4){0.f, 0.f, 0.f, 0.f}; ab[i] = af[i]; }
#pragma unroll 2
    for (int kk = 0; kk < 8; ++kk) {
      const int jb = kk * 32 + fq * 8;
      const bf16x8 vr = *(const bf16x8*)(Vt + (p0 + fr) * 264 + jb);
      const f32x4 wf0 = *(const f32x4*)(wfs + jb), wf1 = *(const f32x4*)(wfs + jb + 4);
      const f32x4 wb0 = *(const f32x4*)(wbs + jb), wb1 = *(const f32x4*)(wbs + jb + 4);
      float x[8];
#pragma unroll
      for (int e = 0; e < 8; ++e) x[e] = bf2f((unsigned short)vr[e]);
      u32x4 uf, ub;
      uf.x = cvt_pk_bf16(x[0] * wf0[0], x[1] * wf0[1]); uf.y = cvt_pk_bf16(x[2] * wf0[2], x[3] * wf0[3]);
      uf.z = cvt_pk_bf16(x[4] * wf1[0], x[5] * wf1[1]); uf.w = cvt_pk_bf16(x[6] * wf1[2], x[7] * wf1[3]);
      ub.x = cvt_pk_bf16(x[0] * wb0[0], x[1] * wb0[1]); ub.y = cvt_pk_bf16(x[2] * wb0[2], x[3] * wb0[3]);
      ub.z = cvt_pk_bf16(x[4] * wb1[0], x[5] * wb1[1]); ub.w = cvt_pk_bf16(x[6] * wb1[2], x[7] * wb1[3]);
      const bf16x8 vf = as_bf16x8(uf), vb = as_bf16x8(ub);
#pragma unroll
      for (int i = 0; i < NTL; ++i) {
        const bf16x8 kf = *(const bf16x8*)(Kt + ((nt0 + i) * 16 + fr) * 264 + jb);
        af[i] = MFMA(kf, vf, af[i]);
        ab[i] = MFMA(kf, vb, ab[i]);
      }
    }
    bf16_t *df, *db;
    if (MODE == 0) {
      bf16_t* SR = (bf16_t*)(ws + OFF_SR);
      df = SR + ((size_t)(c * 2 + 0) * 16 + h) * 16384; db = SR + ((size_t)(c * 2 + 1) * 16 + h) * 16384;
    } else {
      bf16_t* SS = (bf16_t*)(ws + OFF_SS);
      df = SS + ((size_t)(c * 64 + h) * 2 + 0) * 8192; db = df + 8192;
    }
#pragma unroll
    for (int i = 0; i < NTL; ++i) {
      const int off = (p0 + fr) * 128 + (nt0 + i) * 16 + fq * 4;
      u32x2 w; w.x = cvt_pk_bf16(af[i][0], af[i][1]); w.y = cvt_pk_bf16(af[i][2], af[i][3]);
      *(u32x2*)(df + off) = w;
      w.x = cvt_pk_bf16(ab[i][0], ab[i][1]); w.y = cvt_pk_bf16(ab[i][2], ab[i][3]);
      *(u32x2*)(db + off) = w;
    }
  }
  __syncthreads();
}

__device__ __forceinline__ void ret_out_item(const Params& p, int cc, int h, int half, bool do_store) {
  unsigned char* ws = p.ws;
  int tid = threadIdx.x;
  asm volatile("" : "+v"(tid));
  const int wid = tid >> 6, lane = tid & 63, fr = lane & 15, fq = lane >> 4;
  bf16_t* Q = (bf16_t*)(ws + OFF_Q);
  const bf16_t* Kb = (const bf16_t*)(ws + OFF_K);
  const bf16_t* VT = (const bf16_t*)(ws + OFF_VT);
  const bf16_t* SR = (const bf16_t*)(ws + OFF_SR);
  const float lgf = -log1pf(__expf(-p.ret_decay_logit[h])) * 1.4426950408889634f;
  const float lgb = -log1pf(__expf(-p.ret_decay_logit[16 + h])) * 1.4426950408889634f;
  const int i0 = half * 128 + wid * 16, il = i0 + fr;
  const size_t grow = (size_t)cc * CH + il;
  bf16x8 qf[4];
#pragma unroll
  for (int kk = 0; kk < 4; ++kk) qf[kk] = *(const bf16x8*)(Q + grow * 2048 + h * 128 + kk * 32 + fq * 8);
  bf16_t* Hf = (bf16_t*)smem;
  bf16_t* Hb = (bf16_t*)(smem + 34816);
  __syncthreads();
  {
    u32x4 hv[8];
#pragma unroll
    for (int i = 0; i < 8; ++i) {
      const int idx = tid + i * NTH, dir = idx >> 11, rr = (idx >> 4) & 127, chn = idx & 15;
      hv[i] = *(const u32x4*)(SR + ((size_t)(cc * 2 + dir) * 16 + h) * 16384 + rr * 128 + chn * 8);
    }
#pragma unroll
    for (int i = 0; i < 8; ++i) {
      const int idx = tid + i * NTH, dir = idx >> 11, rr = (idx >> 4) & 127, chn = idx & 15;
      *(u32x4*)((dir ? Hb : Hf) + rr * 136 + chn * 8) = hv[i];
    }
  }
  __syncthreads();

  f32x4 Y[8];
  {
    const float ai = exp2f((float)(il + 1) * lgf), bi = exp2f((float)(256 - il) * lgb);
#pragma unroll
    for (int pt = 0; pt < 8; ++pt) {
      f32x4 a = {0.f, 0.f, 0.f, 0.f}, b = {0.f, 0.f, 0.f, 0.f};
#pragma unroll
      for (int kk = 0; kk < 4; ++kk) {
        const bf16x8 hf = *(const bf16x8*)(Hf + (pt * 16 + fr) * 136 + kk * 32 + fq * 8);
        const bf16x8 hb = *(const bf16x8*)(Hb + (pt * 16 + fr) * 136 + kk * 32 + fq * 8);
        a = MFMA(hf, qf[kk], a);
        b = MFMA(hb, qf[kk], b);
      }
      Y[pt] = a * ai + b * bi;
      __builtin_amdgcn_sched_barrier(0);
    }
  }
  __syncthreads();
  bf16_t* Ki = (bf16_t*)smem;
  bf16_t* Vt = (bf16_t*)(smem + 69632);
  {
    u32x4 kreg[8], vreg[8];
#pragma unroll
    for (int i = 0; i < 8; ++i) {
      const int idx = tid + i * NTH;
      kreg[i] = *(const u32x4*)(Kb + (size_t)(cc * CH + (idx >> 4)) * 2048 + h * 128 + (idx & 15) * 8);
      vreg[i] = *(const u32x4*)(VT + (size_t)(h * 128 + (idx >> 5)) * R + cc * CH + (idx & 31) * 8);
    }
#pragma unroll
    for (int i = 0; i < 8; ++i) {
      const int idx = tid + i * NTH;
      *(u32x4*)(Ki + (idx >> 4) * 136 + (idx & 15) * 8) = kreg[i];
    }
#pragma unroll
    for (int i = 0; i < 8; ++i) {
      const int idx = tid + i * NTH;
      *(u32x4*)(Vt + (idx >> 5) * 264 + (idx & 31) * 8) = vreg[i];
    }
  }
  __syncthreads();
  bf16x8 pf[8];
#pragma unroll
  for (int k2 = 0; k2 < 8; ++k2) {
    u32x4 pk;
#pragma unroll
    for (int s = 0; s < 2; ++s) {
      const int jt = k2 * 2 + s;
      f32x4 sacc = {0.f, 0.f, 0.f, 0.f};
#pragma unroll
      for (int kk = 0; kk < 4; ++kk) {
        const bf16x8 kf = *(const bf16x8*)(Ki + (jt * 16 + fr) * 136 + kk * 32 + fq * 8);
        sacc = MFMA(kf, qf[kk], sacc);
      }
      float w[4];
#pragma unroll
      for (int e = 0; e < 4; ++e) {
        const int dl = il - (jt * 16 + fq * 4 + e);
        w[e] = sacc[e] * __builtin_amdgcn_exp2f(dl >= 0 ? (float)dl * lgf : (float)(-dl) * lgb);
      }
      if (s == 0) { pk.x = cvt_pk_bf16(w[0], w[1]); pk.y = cvt_pk_bf16(w[2], w[3]); }
      else { pk.z = cvt_pk_bf16(w[0], w[1]); pk.w = cvt_pk_bf16(w[2], w[3]); }
    }
    pf[k2] = as_bf16x8(pk);
    __builtin_amdgcn_sched_barrier(0);
  }
#pragma unroll
  for (int pt = 0; pt < 8; ++pt) {
#pragma unroll
    for (int k2 = 0; k2 < 8; ++k2) {
      const bf16x4 lo = *(const bf16x4*)(Vt + (pt * 16 + fr) * 264 + k2 * 32 + fq * 4);
      const bf16x4 hi = *(const bf16x4*)(Vt + (pt * 16 + fr) * 264 + k2 * 32 + 16 + fq * 4);
      Y[pt] = MFMA(mk8(lo, hi), pf[k2], Y[pt]);
    }
    __builtin_amdgcn_sched_barrier(0);
  }
  float s1 = 0.f;
#pragma unroll
  for (int pt = 0; pt < 8; ++pt) s1 += (Y[pt][0] + Y[pt][1]) + (Y[pt][2] + Y[pt][3]);
  s1 += __shfl_xor(s1, 16); s1 += __shfl_xor(s1, 32);
  const float mu = s1 * (1.0f / 128.0f);
  float s2 = 0.f;
#pragma unroll
  for (int pt = 0; pt < 8; ++pt) {
#pragma unroll
    for (int e = 0; e < 4; ++e) { const float d = Y[pt][e] - mu; s2 += d * d; }
  }
  s2 += __shfl_xor(s2, 16); s2 += __shfl_xor(s2, 32);
  const float rstd = rsqrtf(s2 * (1.0f / 128.0f) + EPS);
#pragma unroll
  for (int pt = 0; pt < 8; ++pt) {
    const int pc = h * 128 + pt * 16 + fq * 4;
    const f32x4 nw = *(const f32x4*)(p.ret_norm_w + pc);
    u32x2 w;
    w.x = cvt_pk_bf16((Y[pt][0] - mu) * rstd * nw[0], (Y[pt][1] - mu) * rstd * nw[1]);
    w.y = cvt_pk_bf16((Y[pt][2] - mu) * rstd * nw[2], (Y[pt][3] - mu) * rstd * nw[3]);
    if (do_store) *(u32x2*)(Q + grow * 2048 + pc) = w;
  }
  __syncthreads();
}

__device__ __forceinline__ void ssd_out_item(const Params& p, int cc, int g, int half) {
  unsigned char* ws = p.ws;
  int tid = threadIdx.x;
  asm volatile("" : "+v"(tid));
  const int wid = tid >> 6, lane = tid & 63, fr = lane & 15, fq = lane >> 4;
  const bf16_t* Bb = (const bf16_t*)(ws + OFF_B);
  const bf16_t* Cb = (const bf16_t*)(ws + OFF_C);
  const bf16_t* XT = (const bf16_t*)(ws + OFF_XT);
  const bf16_t* SS = (const bf16_t*)(ws + OFF_SS);
  bf16_t* YS = (bf16_t*)(ws + OFF_YS);
  const float* CSF = (const float*)(ws + OFF_CSF); const float* RCSB = (const float*)(ws + OFF_RCSB);
  const float* DTF = (const float*)(ws + OFF_DTF); const float* DTB = (const float*)(ws + OFF_DTB);
  const int i0 = half * 128 + wid * 16, il = i0 + fr;
  const size_t grow = (size_t)cc * CH + il;
  bf16_t* Bi = (bf16_t*)smem;
  bf16_t* Hf = (bf16_t*)(smem + 69632);
  bf16_t* Hb = (bf16_t*)(smem + 87040);
  bf16_t* Xt = (bf16_t*)(smem + 104448);
  float* vcs = (float*)(smem + 138240);
  bf16x8 cf[4];
#pragma unroll
  for (int kk = 0; kk < 4; ++kk) cf[kk] = *(const bf16x8*)(Cb + grow * 1024 + g * 128 + kk * 32 + fq * 8);
  __syncthreads();
  {
    u32x4 bv[8];
#pragma unroll
    for (int i = 0; i < 8; ++i) {
      const int idx = tid + i * NTH;
      bv[i] = *(const u32x4*)(Bb + (size_t)(cc * CH + (idx >> 4)) * 1024 + g * 128 + (idx & 15) * 8);
    }
#pragma unroll
    for (int i = 0; i < 8; ++i) {
      const int idx = tid + i * NTH;
      *(u32x4*)(Bi + (idx >> 4) * 136 + (idx & 15) * 8) = bv[i];
    }
  }
  __syncthreads();
  u32x2 S[16];
#pragma unroll
  for (int jt = 0; jt < 16; ++jt) {
    f32x4 sacc = {0.f, 0.f, 0.f, 0.f};
#pragma unroll
    for (int kk = 0; kk < 4; ++kk) {
      const bf16x8 kf = *(const bf16x8*)(Bi + (jt * 16 + fr) * 136 + kk * 32 + fq * 8);
      sacc = MFMA(kf, cf[kk], sacc);
    }
    S[jt].x = cvt_pk_bf16(sacc[0], sacc[1]); S[jt].y = cvt_pk_bf16(sacc[2], sacc[3]);
  }
  __syncthreads();
  u32x2* Sl = (u32x2*)smem + wid * 1024;
#pragma unroll
  for (int jt = 0; jt < 16; ++jt) Sl[jt * 64 + lane] = S[jt];
  u32x4 hreg[4], xreg[4];
  float vr[4] = {0.f, 0.f, 0.f, 0.f};
#define SSD_PREFETCH(HH)                                                                                              \
  do {                                                                                                                \
    const int h_ = g * 8 + (HH);                                                                                      \
    _Pragma("unroll") for (int i = 0; i < 4; ++i) {                                                                   \
      const int idx = tid + i * NTH;                                                                                  \
      hreg[i] = *(const u32x4*)(SS + ((size_t)(cc * 64 + h_) * 2 + (idx >> 10)) * 8192 + ((idx >> 4) & 63) * 128 + (idx & 15) * 8); \
      xreg[i] = *(const u32x4*)(XT + (size_t)(h_ * 64 + (idx >> 5)) * R + cc * CH + (idx & 31) * 8);                  \
    }                                                                                                                 \
    if (tid < 256) {                                                                                                  \
      const size_t rj = (size_t)(cc * CH + tid) * 64 + h_;                                                            \
      vr[0] = CSF[rj]; vr[1] = RCSB[rj]; vr[2] = DTF[rj]; vr[3] = DTB[rj];                                            \
    }                                                                                                                 \
  } while (0)
  SSD_PREFETCH(0);
  for (int hh = 0; hh < 8; ++hh) {
    const int h = g * 8 + hh;
    __syncthreads();
#pragma unroll
    for (int i = 0; i < 4; ++i) {
      const int idx = tid + i * NTH;
      *(u32x4*)(((idx >> 10) ? Hb : Hf) + ((idx >> 4) & 63) * 136 + (idx & 15) * 8) = hreg[i];
      *(u32x4*)(Xt + (idx >> 5) * 264 + (idx & 31) * 8) = xreg[i];
    }
    if (tid < 256) {
      const float c2 = vr[0] * 1.4426950408889634f, r2 = vr[1] * 1.4426950408889634f;
      vcs[tid] = c2; vcs[256 + tid] = r2;
      vcs[512 + tid] = c2 - __log2f(vr[2]); vcs[768 + tid] = r2 - __log2f(vr[3]);
    }
    __syncthreads();
    if (hh < 7) SSD_PREFETCH(hh + 1);
    int ilv = il;
    asm volatile("" : "+v"(ilv));
    const float csi = vcs[il], rcsi = vcs[256 + il];
    f32x4 Y[4];
    {
      const float ai = exp2f(csi), bi = exp2f(rcsi);
#pragma unroll
      for (int pt = 0; pt < 4; ++pt) {
        f32x4 a = {0.f, 0.f, 0.f, 0.f}, b = {0.f, 0.f, 0.f, 0.f};
#pragma unroll
        for (int kk = 0; kk < 4; ++kk) {
          const bf16x8 hf = *(const bf16x8*)(Hf + (pt * 16 + fr) * 136 + kk * 32 + fq * 8);
          const bf16x8 hb = *(const bf16x8*)(Hb + (pt * 16 + fr) * 136 + kk * 32 + fq * 8);
          a = MFMA(hf, cf[kk], a);
          b = MFMA(hb, cf[kk], b);
        }
        Y[pt] = a * ai + b * bi;
        __builtin_amdgcn_sched_barrier(0);
      }
    }
#pragma unroll 1
    for (int k2 = 0; k2 < 8; ++k2) {
      u32x4 pk;
#pragma unroll
      for (int s = 0; s < 2; ++s) {
        const int jt = k2 * 2 + s, jb = jt * 16 + fq * 4;
        const u32x2 sp = Sl[jt * 64 + lane];
        float w[4];
        const float sv[4] = {bflo(sp.x), bfhi(sp.x), bflo(sp.y), bfhi(sp.y)};
        const int dtile = __builtin_amdgcn_readfirstlane(half * 8 + wid);
        if (jt < dtile) {
          const f32x4 af = *(const f32x4*)(vcs + 512 + jb);
#pragma unroll
          for (int e = 0; e < 4; ++e) w[e] = sv[e] * __builtin_amdgcn_exp2f(csi - af[e]);
        } else if (jt > dtile) {
          const f32x4 ab = *(const f32x4*)(vcs + 768 + jb);
#pragma unroll
          for (int e = 0; e < 4; ++e) w[e] = sv[e] * __builtin_amdgcn_exp2f(rcsi - ab[e]);
        } else {
          const f32x4 af = *(const f32x4*)(vcs + 512 + jb), ab = *(const f32x4*)(vcs + 768 + jb);
#pragma unroll
          for (int e = 0; e < 4; ++e) w[e] = sv[e] * __builtin_amdgcn_exp2f(((jb + e) <= ilv) ? (csi - af[e]) : (rcsi - ab[e]));
        }
        if (s == 0) { pk.x = cvt_pk_bf16(w[0], w[1]); pk.y = cvt_pk_bf16(w[2], w[3]); }
        else { pk.z = cvt_pk_bf16(w[0], w[1]); pk.w = cvt_pk_bf16(w[2], w[3]); }
      }
      const bf16x8 pfr = as_bf16x8(pk);
#pragma unroll
      for (int pt = 0; pt < 4; ++pt) {
        const bf16x4 lo = *(const bf16x4*)(Xt + (pt * 16 + fr) * 264 + k2 * 32 + fq * 4);
        const bf16x4 hi = *(const bf16x4*)(Xt + (pt * 16 + fr) * 264 + k2 * 32 + 16 + fq * 4);
        Y[pt] = MFMA(mk8(lo, hi), pfr, Y[pt]);
      }
      __builtin_amdgcn_sched_barrier(0);
    }
    const float dsk = p.ssd_d[h];
#pragma unroll
    for (int pt = 0; pt < 4; ++pt) {
      float o[4];
#pragma unroll
      for (int e = 0; e < 4; ++e) o[e] = Y[pt][e] + bf2f(Xt[(pt * 16 + fq * 4 + e) * 264 + il]) * dsk;
      u32x2 w; w.x = cvt_pk_bf16(o[0], o[1]); w.y = cvt_pk_bf16(o[2], o[3]);
      *(u32x2*)(YS + ((size_t)(cc - 1) * CH + il) * 4096 + h * 64 + pt * 16 + fq * 4) = w;
    }
  }
  __syncthreads();
}

#ifdef PROBE_AFTER
__device__ void probe_dump(const Params& p, size_t lo0, size_t hi0, size_t lo1, size_t hi1) {
  float* outp = (float*)p.out;
  const size_t n = (size_t)SEQ * DM;
  const bf16_t* b0 = (const bf16_t*)(p.ws + lo0); const size_t n0 = (hi0 - lo0) / 2;
  const bf16_t* b1 = (const bf16_t*)(p.ws + lo1); const size_t n1 = (hi1 - lo1) / 2;
  const size_t k0 = (n0 + n - 1) / n, k1 = n1 ? (n1 + n - 1) / n : 0;
  for (size_t i = (size_t)blockIdx.x * NTH + threadIdx.x; i < n; i += (size_t)gridDim.x * NTH) {
    float a = 0.f;
    for (size_t k = 0; k < k0; ++k) { const size_t j = i + k * n; if (j < n0) { float v = bf2f(b0[j]); if (!(fabsf(v) < 1e30f)) v = 777.f; a += v; } }
    for (size_t k = 0; k < k1; ++k) { const size_t j = i + k * n; if (j < n1) { float v = bf2f(b1[j]); if (!(fabsf(v) < 1e30f)) v = 777.f; a += v; } }
    outp[i] = a;
  }
}
#define PROBE_POINT(idx, lo0, hi0, lo1, hi1) if (PROBE_AFTER == (idx)) { probe_dump(p, lo0, hi0, lo1, hi1); return; }
#else
#define PROBE_POINT(idx, lo0, hi0, lo1, hi1)
#endif

#define XB_TMO      128
#define XB_XCNT(j)  (256  + 64 * (j))
#define XB_XSUB(j)  (1280 + 64 * (j))
#define XB_XGEN(j)  (2304 + 64 * (j))
#define XB_TOP      3328
#define XB_TOPGEN   3392
#define XCD_BAR_WORDS 3456
#define XB_SPIN_CAP (1u << 18)
#define LAS __attribute__((address_space(3)))
__device__ __forceinline__ unsigned xb_ld(unsigned* p)              { return __hip_atomic_load(p, __ATOMIC_RELAXED, __HIP_MEMORY_SCOPE_AGENT); }
__device__ __forceinline__ unsigned xb_add(unsigned* p, unsigned v) { return __hip_atomic_fetch_add(p, v, __ATOMIC_RELAXED, __HIP_MEMORY_SCOPE_AGENT); }
__device__ __forceinline__ unsigned xb_xcc_id() { return (unsigned)__builtin_amdgcn_s_getreg((3 << 11) | 20) & 0xFu; }
#define XB_SPIN(cond, bar) do { unsigned _sp = 0; while (cond) { __builtin_amdgcn_s_sleep(1); \
    if ((++_sp & 255u) == 0u) { if (xb_ld(&(bar)[XB_TMO])) break; if (_sp > XB_SPIN_CAP) { atomicAdd(&(bar)[XB_TMO], 1u); break; } } } } while (0)
struct XcdBarrier { unsigned* bar; unsigned x; volatile LAS unsigned* st; };
__device__ __forceinline__ XcdBarrier xcd_barrier_post(unsigned* bar, volatile LAS unsigned* st) {
  XcdBarrier b; b.bar = bar; b.x = xb_xcc_id(); b.st = st;
  if (threadIdx.x == 0) (void)xb_add(&bar[XB_XCNT(b.x)], 1u);
  return b;
}
__device__ __forceinline__ void xcd_barrier_complete(unsigned* bar, unsigned x, unsigned& nloc, unsigned& nx) {
  const unsigned G = gridDim.x * gridDim.y * gridDim.z;
  unsigned sum, cnt, mine, sp = 0u;
  for (;;) {
    sum = 0u; cnt = 0u; mine = 0u;
#pragma unroll
    for (unsigned j = 0; j < 16; ++j) { const unsigned c = xb_ld(&bar[XB_XCNT(j)]); sum += c; cnt += (c > 0u) ? 1u : 0u; mine = (j == x) ? c : mine; }
    if (sum == G) break;
    __builtin_amdgcn_s_sleep(1);
    if ((++sp & 255u) == 0u) { if (xb_ld(&bar[XB_TMO])) break; if (sp > XB_SPIN_CAP) { atomicAdd(&bar[XB_TMO], 1u); break; } }
  }
  nloc = mine > 0u ? mine : 1u; nx = cnt > 0u ? cnt : 1u;
}
__device__ __forceinline__ void xcd_barrier(const XcdBarrier& b) {
  asm volatile("s_waitcnt vmcnt(0)" ::: "memory");
  __syncthreads();
  if (threadIdx.x == 0) {
    unsigned* bar = b.bar;
    __builtin_amdgcn_s_waitcnt(0);
    unsigned nloc = b.st[0], nx = b.st[1];
    if (nloc == 0u) { xcd_barrier_complete(bar, b.x, nloc, nx); b.st[0] = nloc; b.st[1] = nx; }
    const unsigned old = xb_add(&bar[XB_XSUB(b.x)], 1u);
    const unsigned gen = old / nloc;
    if (old + 1u == (gen + 1u) * nloc) {
      __builtin_amdgcn_fence(__ATOMIC_RELEASE, "agent");
      asm volatile("s_waitcnt vmcnt(0)" ::: "memory");
      const unsigned og = xb_add(&bar[XB_TOP], 1u);
      const unsigned tg = og / nx;
      if (og + 1u == (tg + 1u) * nx) xb_add(&bar[XB_TOPGEN], 1u);
      else XB_SPIN(xb_ld(&bar[XB_TOPGEN]) == tg, bar);
      __builtin_amdgcn_fence(__ATOMIC_ACQUIRE, "agent");
      xb_add(&bar[XB_XGEN(b.x)], 1u);
      asm volatile("s_waitcnt vmcnt(0)" ::: "memory");
    } else {
      XB_SPIN(xb_ld(&bar[XB_XGEN(b.x)]) == gen, bar);
      __builtin_amdgcn_fence(__ATOMIC_ACQUIRE, "agent");
      asm volatile("s_waitcnt vmcnt(0)" ::: "memory");
    }
  }
  __syncthreads();
}

__global__ void __launch_bounds__(NTH) mega(Params p) {
  cg::grid_group grid = cg::this_grid();
  unsigned char* ws = p.ws;
  volatile LAS unsigned* xb_st = (volatile LAS unsigned*)((LAS unsigned char*)smem + (LDS_BYTES - 16));
  if (threadIdx.x == 0) { xb_st[0] = 0u; xb_st[1] = 0u; }
  __syncthreads();
  const XcdBarrier xb = xcd_barrier_post((unsigned*)(ws + OFF_BAR), xb_st);
  const int bid = blockIdx.x, nb = gridDim.x, gnth = nb * NTH;
#define FRESH_TID() int tid = threadIdx.x; asm volatile("" : "+v"(tid)); const int gtid = bid * NTH + tid; (void)gtid;
  float* MOD = (float*)(ws + OFF_MOD);
  float* SUMSQ = (float*)(ws + OFF_SUMSQ);
  float* ROPE = (float*)(ws + OFF_ROPE);
  bf16_t* U = (bf16_t*)(p.out + OOFF_U);
  bf16_t* WBT = (bf16_t*)(p.out + OOFF_WB);
  bf16_t* WA1 = (bf16_t*)(ws + OFF_WA);
  bf16_t* WA2 = WA1 + (size_t)6400 * 2048;

#if (PHASE_MASK >> 0) & 1
  {
  FRESH_TID();
  for (int u = bid; u < 192; u += nb) {
    const int ks = u / 24, j = (u % 24) * NTH + tid;
    float* sc = (float*)smem;
    __syncthreads();
    if (tid < 256) { sc[tid] = siluf_(p.c[ks * 256 + tid]); sc[256 + tid] = siluf_(p.c_ctx[ks * 256 + tid]); }
    __syncthreads();
    float a0 = 0.f, a1 = 0.f;
    for (int k0 = 0; k0 < 256; k0 += 16) {
      float w[16];
#pragma unroll
      for (int e = 0; e < 16; ++e) w[e] = p.w_mod[(size_t)(ks * 256 + k0 + e) * 12288 + j];
#pragma unroll
      for (int e = 0; e < 16; ++e) { a0 += sc[k0 + e] * w[e]; a1 += sc[256 + k0 + e] * w[e]; }
    }
    if (ks == 0) { const float b = p.b_mod[j]; a0 += b; a1 += b; }
    atomicAdd(MOD + j, a0);
    atomicAdd(MOD + 12288 + j, a1);
  }
  __syncthreads();
  for (int i = gtid; i < 256 * 32; i += gnth) {
    const int pos = i >> 5, d = i & 31;
    const float freq = exp2f(-(float)d * (13.287712379549449f / 32.0f));
    const float rev = (float)pos * freq * 0.15915494309189535f;
    const float fr_ = rev - floorf(rev);
    ROPE[i * 2 + 0] = __builtin_amdgcn_cosf(fr_);
    ROPE[i * 2 + 1] = __builtin_amdgcn_sinf(fr_);
  }
  convert_segment(p.w_in, INC, 0, 2048, 2048, WA1, true);
  convert_segment(p.w_in, INC, 2048, 2048, 2048, WA1 + (size_t)2048 * 2048, true);
  convert_segment(p.w_in, INC, 16384, 2048, 2048, WA1 + (size_t)4096 * 2048, false);
  convert_segment(p.w_in, INC, 18432, 128, 2048, WA1 + (size_t)6144 * 2048, false);
  convert_segment(p.w_in, INC, 4096, 2048, 2048, WA2, false);
  convert_segment(p.w_in, INC, 12288, 4096, 2048, WA2 + (size_t)2048 * 2048, false);
  }
#endif
  if (p.ws == nullptr) grid.sync();
  xcd_barrier(xb);

#if (PHASE_MASK >> 1) & 1
  for (int rep_ = 0; rep_ < 1 + ((DUP_MASK >> 1) & 1); ++rep_) {
  modnorm_rows(p.ctx, CTX, p.x, SEQ, p.norm1_w, MOD + 12288 + 2048, MOD + 12288, MOD + 2048, MOD, U);
  }
#endif
  xcd_barrier(xb);

#if (PHASE_MASK >> 2) & 1
  for (int rep_ = 0; rep_ < 1 + ((DUP_MASK >> 2) & 1); ++rep_) {
  {
    EpiA1 e1{(bf16_t*)(ws + OFF_Q), (bf16_t*)(ws + OFF_K), (bf16_t*)(ws + OFF_BCRAW), (float*)(ws + OFF_DTRAW), ROPE};
    EpiA2 e2{(bf16_t*)(ws + OFF_VT), (bf16_t*)(ws + OFF_XTRAW)};
    const int n1 = 65 * 25, n2 = 24 * 65;
    for (int L = bid; L < n1 + n2; L += nb) {
      int pm, pn;
      if (L < n2) { unit_map(L, 24, 65, pm, pn); gemm_unit(WA2, 2048, U, 2048, 2048, pm, pn, e2); }
      else { unit_map(L - n2, 65, 25, pm, pn); gemm_unit(U, 2048, WA1, 2048, 2048, pm, pn, e1); }
    }
    {
      int tid = threadIdx.x;
      asm volatile("" : "+v"(tid));
      unsigned* qhead = (unsigned*)(ws + OFF_BAR) + 3520;
      volatile unsigned* bc = (volatile unsigned*)(smem + 66560);
      for (;;) {
        __syncthreads();
        if (tid == 0) *bc = atomicAdd(qhead, 1u);
        __syncthreads();
        const int t = (int)*bc;
        if (t >= 2304) break;
        if (t < 256) convert_tile(p.w_in, INC, 6144, 2048, WBT, t >> 5, t & 31, tid);
        else if (t < 768) convert_tile(p.w_in, INC, 8192, 2048, WBT + (size_t)2048 * 2048, (t - 256) >> 5, (t - 256) & 31, tid);
        else if (t < 1280) convert_tile(p.w_in, INC, 18560, 2048, WBT + (size_t)6144 * 2048, (t - 768) >> 5, (t - 768) & 31, tid);
        else if (t < 1536) convert_tile(p.w_ret_out, 2048, 0, 2048, (bf16_t*)(ws + OFF_WRO), (t - 1280) >> 5, (t - 1280) & 31, tid);
        else if (t < 2048) convert_tile(p.w_ssd_out, 2048, 0, 4096, (bf16_t*)(ws + OFF_WSO), (t - 1536) >> 6, (t - 1536) & 63, tid);
        else convert_tile(p.w_o, 2048, 0, 2048, (bf16_t*)(ws + OFF_WO), (t - 2048) >> 5, (t - 2048) & 31, tid);
      }
      __syncthreads();
    }
  }
  }
#endif
  xcd_barrier(xb);
  PROBE_POINT(2, OFF_Q, OFF_XT, OFF_SR, OFF_WA)

#if (PHASE_MASK >> 3) & 1
  for (int rep_ = 0; rep_ < 1 + ((DUP_MASK >> 3) & 1); ++rep_) {
  {
  FRESH_TID();
  {
    float* DTRAW = (float*)(ws + OFF_DTRAW);
    float* DTF = (float*)(ws + OFF_DTF); float* DTB = (float*)(ws + OFF_DTB);
    float* CSF = (float*)(ws + OFF_CSF); float* RCSB = (float*)(ws + OFF_RCSB);
    if ((tid >> 6) == 0) {
      for (int w = bid; w < NCH * 2; w += nb) {
        const int c = w >> 1, dir = w & 1, h = tid & 63;
        const float bias = p.ssd_dt_bias[dir * 64 + h], a = -__expf(p.ssd_a_log[dir * 64 + h]);
        float* __restrict__ DTO = dir ? DTB : DTF;
        float* __restrict__ CSO = dir ? RCSB : CSF;
        float cs = 0.f;
        for (int jb = 0; jb < CH; jb += 16) {
          float raw[16];
#pragma unroll
          for (int e = 0; e < 16; ++e) {
            const int j = dir ? (CH - 1 - jb - e) : (jb + e);
            raw[e] = DTRAW[((size_t)c * CH + j) * 128 + dir * 64 + h];
          }
#pragma unroll
          for (int e = 0; e < 16; ++e) {
            const int j = dir ? (CH - 1 - jb - e) : (jb + e);
            const size_t r = (size_t)c * CH + j;
            const float dt = softplusf_(raw[e] + bias);
            cs += dt * a;
            DTO[r * 64 + h] = dt; CSO[r * 64 + h] = cs;
          }
        }
      }
    }
    const bf16_t* __restrict__ BCRAW = (const bf16_t*)(ws + OFF_BCRAW);
    bf16_t* __restrict__ Bb = (bf16_t*)(ws + OFF_B); bf16_t* __restrict__ Cb = (bf16_t*)(ws + OFF_C);
#pragma unroll 2
    for (int i = gtid; i < R * 256; i += gnth) {
      const int r = i >> 8, c8 = (i & 255) * 8;
      const int s0 = r < CTX ? 0 : CTX, s1 = r < CTX ? CTX : R;
      bf16x8 xv[5];
      float msk[5];
#pragma unroll
      for (int j = 0; j < 5; ++j) {
        const int rr = r + j - 2;
        const bool ok = rr >= s0 && rr < s1;
        msk[j] = ok ? 1.f : 0.f;
        xv[j] = *(const bf16x8*)(BCRAW + (size_t)(ok ? rr : r) * 2048 + c8);
      }
      const float* cwp = p.conv_w + 4096 + c8;
      const f32x4 b0 = *(const f32x4*)(p.conv_b + 4096 + c8), b1 = *(const f32x4*)(p.conv_b + 4096 + c8 + 4);
      float a[8] = {b0[0], b0[1], b0[2], b0[3], b1[0], b1[1], b1[2], b1[3]};
#pragma unroll
      for (int j = 0; j < 5; ++j) {
        const f32x4 w0 = *(const f32x4*)(cwp + (size_t)j * 6144) * msk[j], w1 = *(const f32x4*)(cwp + (size_t)j * 6144 + 4) * msk[j];
#pragma unroll
        for (int e = 0; e < 4; ++e) { a[e] += bf2f((unsigned short)xv[j][e]) * w0[e]; a[4 + e] += bf2f((unsigned short)xv[j][4 + e]) * w1[e]; }
      }
      u32x4 w;
      w.x = cvt_pk_bf16(siluf_(a[0]), siluf_(a[1])); w.y = cvt_pk_bf16(siluf_(a[2]), siluf_(a[3]));
      w.z = cvt_pk_bf16(siluf_(a[4]), siluf_(a[5])); w.w = cvt_pk_bf16(siluf_(a[6]), siluf_(a[7]));
      bf16_t* dst = c8 < 1024 ? Bb + (size_t)r * 1024 + c8 : Cb + (size_t)r * 1024 + (c8 - 1024);
      *(u32x4*)dst = w;
    }
    const bf16_t* __restrict__ XTRAW = (const bf16_t*)(ws + OFF_XTRAW);
    bf16_t* __restrict__ XT = (bf16_t*)(ws + OFF_XT);
#pragma unroll 2
    for (int i = gtid; i < 4096 * (R / 16); i += gnth) {
      const int ch = i / (R / 16), t16 = (i % (R / 16)) * 16;
      const int s0 = t16 < CTX ? 0 : CTX, s1 = t16 < CTX ? CTX : R;
      const bf16_t* src = XTRAW + (size_t)ch * R;
      const bool okp = t16 - 8 >= s0, okn = t16 + 16 < s1;
      const bf16x8 vp = *(const bf16x8*)(src + (okp ? t16 - 8 : t16));
      const bf16x8 v0 = *(const bf16x8*)(src + t16);
      const bf16x8 v1 = *(const bf16x8*)(src + t16 + 8);
      const bf16x8 vn = *(const bf16x8*)(src + (okn ? t16 + 16 : t16));
      float x[20];
      x[0] = okp ? bf2f((unsigned short)vp[6]) : 0.f;
      x[1] = okp ? bf2f((unsigned short)vp[7]) : 0.f;
#pragma unroll
      for (int e = 0; e < 8; ++e) { x[2 + e] = bf2f((unsigned short)v0[e]); x[10 + e] = bf2f((unsigned short)v1[e]); }
      x[18] = okn ? bf2f((unsigned short)vn[0]) : 0.f;
      x[19] = okn ? bf2f((unsigned short)vn[1]) : 0.f;
      float wj[5];
#pragma unroll
      for (int j = 0; j < 5; ++j) wj[j] = p.conv_w[(size_t)j * 6144 + ch];
      const float cb = p.conv_b[ch];
      float o[16];
#pragma unroll
      for (int e = 0; e < 16; ++e) {
        float a = cb;
#pragma unroll
        for (int j = 0; j < 5; ++j) a += x[e + j] * wj[j];
        o[e] = siluf_(a);
      }
      u32x4 w;
      w.x = cvt_pk_bf16(o[0], o[1]); w.y = cvt_pk_bf16(o[2], o[3]); w.z = cvt_pk_bf16(o[4], o[5]); w.w = cvt_pk_bf16(o[6], o[7]);
      *(u32x4*)(XT + (size_t)ch * R + t16) = w;
      w.x = cvt_pk_bf16(o[8], o[9]); w.y = cvt_pk_bf16(o[10], o[11]); w.z = cvt_pk_bf16(o[12], o[13]); w.w = cvt_pk_bf16(o[14], o[15]);
      *(u32x4*)(XT + (size_t)ch * R + t16 + 8) = w;
    }
  }
  }
  }
#endif
  xcd_barrier(xb);
  PROBE_POINT(3, OFF_XT, OFF_DTRAW, OFF_DTF, OFF_SR)

#if (PHASE_MASK >> 4) & 1
  for (int rep_ = 0; rep_ < 1 + ((DUP_MASK >> 4) & 1); ++rep_) {
  for (int it = bid; it < NCH * 24; it += nb) {
    if (it < NCH * 8) state_build_item<1>(p, it >> 3, it & 7);
    else { const int r = it - NCH * 8; state_build_item<0>(p, r >> 4, r & 15); }
  }
  }
#endif
  xcd_barrier(xb);
  PROBE_POINT(4, OFF_SR, OFF_WA, 0, 0)

#if (PHASE_MASK >> 5) & 1
  for (int rep_ = 0; rep_ < 1 + ((DUP_MASK >> 5) & 1); ++rep_) {
  {
  FRESH_TID();
  {
    bf16_t* SR = (bf16_t*)(ws + OFF_SR);
    bf16_t* SS = (bf16_t*)(ws + OFF_SS);
    const float* CSF = (const float*)(ws + OFF_CSF); const float* RCSB = (const float*)(ws + OFF_RCSB);
    for (int i = gtid; i < 65536 + 131072; i += gnth) {
      bf16_t* base; size_t cstride; int dir, h; bool isr = i < 65536;
      if (isr) { const int e = i * 8; dir = e / (16 * 16384); h = (e / 16384) & 15; base = SR + e; cstride = 524288; }
      else { const int e = (i - 65536) * 8; h = e / 16384; dir = (e / 8192) & 1; base = SS + e; cstride = 1048576; }
      float decr = 0.f;
      if (isr) { const float lg = -log1pf(__expf(-p.ret_decay_logit[dir * 16 + h])); decr = __expf(256.0f * lg); }
      float H[8];
#pragma unroll
      for (int e = 0; e < 8; ++e) H[e] = 0.f;
      u32x4 q[4]; float dq[4];
#pragma unroll
      for (int k = 0; k < 4; ++k) {
        const int c = dir == 0 ? k : (k == 0 ? 0 : NCH - k);
        q[k] = *(const u32x4*)(base + (size_t)c * cstride);
        dq[k] = isr ? 0.f : (dir == 0 ? CSF[((size_t)c * CH + 255) * 64 + h] : RCSB[((size_t)c * CH) * 64 + h]);
      }
      for (int s0 = 0; s0 < NCH; s0 += 4) {
#pragma unroll
        for (int k = 0; k < 4; ++k) {
          const int s = s0 + k;
          if (s < NCH) {
            const int c = dir == 0 ? s : (s == 0 ? 0 : NCH - s);
            bf16_t* ptr = base + (size_t)c * cstride;
            const u32x4 tv = q[k];
            const float dl = dq[k];
            if (s + 4 < NCH) {
              const int cn = dir == 0 ? s + 4 : NCH - (s + 4);
              q[k] = *(const u32x4*)(base + (size_t)cn * cstride);
              dq[k] = isr ? 0.f : (dir == 0 ? CSF[((size_t)cn * CH + 255) * 64 + h] : RCSB[((size_t)cn * CH) * 64 + h]);
            }
            u32x4 hv;
            hv.x = cvt_pk_bf16(H[0], H[1]); hv.y = cvt_pk_bf16(H[2], H[3]); hv.z = cvt_pk_bf16(H[4], H[5]); hv.w = cvt_pk_bf16(H[6], H[7]);
            if (rep_ == ((DUP_MASK >> 5) & 1) || p.ws == nullptr) *(u32x4*)ptr = hv;
            const float dec = isr ? decr : __expf(dl);
            H[0] = dec * H[0] + bflo(tv.x); H[1] = dec * H[1] + bfhi(tv.x);
            H[2] = dec * H[2] + bflo(tv.y); H[3] = dec * H[3] + bfhi(tv.y);
            H[4] = dec * H[4] + bflo(tv.z); H[5] = dec * H[5] + bfhi(tv.z);
            H[6] = dec * H[6] + bflo(tv.w); H[7] = dec * H[7] + bfhi(tv.w);
          }
        }
      }
    }
  }
  }
  }
#endif
  xcd_barrier(xb);
  PROBE_POINT(5, OFF_SR, OFF_WA, 0, 0)

#if (PHASE_MASK >> 6) & 1
  for (int rep_ = 0; rep_ < 1 + ((DUP_MASK >> 6) & 1); ++rep_) {
  for (int it = bid; it < 64 * 16 * 2; it += nb) {
    const int half = (it >> 3) & 1, q = ((it >> 4) << 3) | (it & 7), h = q & 15, cc = 1 + (q >> 4);
    ret_out_item(p, cc, h, half, rep_ == ((DUP_MASK >> 6) & 1) || p.ws == nullptr);
  }
  }
#endif
  xcd_barrier(xb);
  PROBE_POINT(6, OFF_Q, OFF_K, 0, 0)

#if (PHASE_MASK >> 7) & 1
  for (int rep_ = 0; rep_ < 1 + ((DUP_MASK >> 7) & 1); ++rep_) {
  for (int ph = 0; ph < 2; ++ph) {
    if ((ph == 0) == ((bid & 1) != 0)) {
      convert_segment(p.w_mlp1, DFF, 0, DFF, 2048, (bf16_t*)(ws + OFF_W1T), false, MOD + 6144, (float*)(ws + OFF_BIAS1));
      convert_segment(p.w_mlp2, 2048, 0, 2048, DFF, (bf16_t*)(ws + OFF_W2T), false);
    }
    if (ph == 0) {
      for (int it = bid; it < 64 * 8 * 2; it += nb) {
        const int half = (it >> 3) & 1, q = ((it >> 4) << 3) | (it & 7), g = q & 7, cc = 1 + (q >> 3);
        ssd_out_item(p, cc, g, half);
      }
    }
  }
  }
#endif
  xcd_barrier(xb);
  PROBE_POINT(7, OFF_YS, OFF_XT, OFF_SR, OFF_SS)

#if (PHASE_MASK >> 8) & 1
  for (int rep_ = 0; rep_ < 1 + ((DUP_MASK >> 8) & 1); ++rep_) {
  {
    EpiB e{(bf16_t*)(ws + OFF_Q), (bf16_t*)(ws + OFF_YS), (bf16_t*)(ws + OFF_G), p.ssd_norm_w, SUMSQ};
    for (int L = bid; L < 64 * 40; L += nb) {
      int pm, pn; unit_map(L, 64, 40, pm, pn);
      gemm_unit(U + (size_t)CTX * 2048, 2048, WBT, 2048, 2048, pm, pn, e);
    }
  }
  }
#endif
  xcd_barrier(xb);
  PROBE_POINT(8, OFF_Q, OFF_B, 0, 0)

#if (PHASE_MASK >> 9) & 1
  for (int rep_ = 0; rep_ < 1 + ((DUP_MASK >> 9) & 1); ++rep_) {
  {
    EpiO1a ea{(const bf16_t*)(ws + OFF_G), (bf16_t*)(ws + OFF_M)};
    EpiO1b eb{(const bf16_t*)(ws + OFF_G), SUMSQ, (bf16_t*)(ws + OFF_M)};
    for (int L = bid; L < 64 * 8; L += nb) {
      int pm, pn; unit_map(L, 64, 8, pm, pn);
      gemm_unit((const bf16_t*)(ws + OFF_Q) + (size_t)CTX * 2048, 2048, (const bf16_t*)(ws + OFF_WRO), 2048, 2048, pm, pn, ea);
      gemm_unit((const bf16_t*)(ws + OFF_YS), 4096, (const bf16_t*)(ws + OFF_WSO), 4096, 4096, pm, pn, eb);
    }
  }
  }
#endif
  xcd_barrier(xb);
  PROBE_POINT(9, OFF_M, OFF_DTRAW, 0, 0)

#if (PHASE_MASK >> 10) & 1
  for (int rep_ = 0; rep_ < 1 + ((DUP_MASK >> 10) & 1); ++rep_) {
  {
    EpiRes9 e{p.x, MOD + 4096, (float*)(ws + OFF_H1), p.norm2_w, MOD + 8192, (bf16_t*)(ws + OFF_F), (float*)(ws + OFF_SUMSQ2)};
    for (int L = bid; L < 64 * 8; L += nb) {
      int pm, pn; unit_map(L, 64, 8, pm, pn);
      gemm_unit((const bf16_t*)(ws + OFF_M), 2048, (const bf16_t*)(ws + OFF_WO), 2048, 2048, pm, pn, e);
    }
  }
  }
#endif
  xcd_barrier(xb);
  PROBE_POINT(10, OFF_H1, OFF_H1 + (size_t)SEQ * DM * 4, 0, 0)

#if (PHASE_MASK >> 12) & 1
  for (int rep_ = 0; rep_ < 1 + ((DUP_MASK >> 12) & 1); ++rep_) {
  {
    EpiM1 e{(bf16_t*)(ws + OFF_A1), (const float*)(ws + OFF_SUMSQ2), (const float*)(ws + OFF_BIAS1)};
    for (int L = bid; L < 64 * 32; L += nb) {
      int pm, pn; unit_map(L, 64, 32, pm, pn);
      gemm_unit((const bf16_t*)(ws + OFF_F), 2048, (const bf16_t*)(ws + OFF_W1T), 2048, 2048, pm, pn, e);
    }
  }
  }
#endif
  xcd_barrier(xb);
  PROBE_POINT(12, OFF_A1, OFF_A1 + (size_t)SEQ * DFF * 2, 0, 0)

#if (PHASE_MASK >> 13) & 1
  for (int rep_ = 0; rep_ < 1 + ((DUP_MASK >> 13) & 1); ++rep_) {
  {
    EpiRes e{(const float*)(ws + OFF_H1), MOD + 10240, (float*)(ws + OFF_H1), rep_ == ((DUP_MASK >> 13) & 1) || p.ws == nullptr};
    for (int L = bid; L < 64 * 8; L += nb) {
      int pm, pn; unit_map(L, 64, 8, pm, pn);
      gemm_unit((const bf16_t*)(ws + OFF_A1), DFF, (const bf16_t*)(ws + OFF_W2T), DFF, DFF, pm, pn, e);
    }
  }
  }
#endif
  xcd_barrier(xb);
  PROBE_POINT(13, OFF_H1, OFF_H1 + (size_t)SEQ * DM * 4, 0, 0)

#if (PHASE_MASK >> 14) & 1
  for (int rep_ = 0; rep_ < 1 + ((DUP_MASK >> 14) & 1); ++rep_) {
  {
  FRESH_TID();
  {
    const float* H2 = (const float*)(ws + OFF_H1);
    float* outp = (float*)p.out;
    const int lane = tid & 63, gw = bid * (NTH / 64) + (tid >> 6), nw_ = nb * (NTH / 64);
    for (int r = gw; r < SEQ; r += nw_) {
      f32x4 v[8];
      float ss = 0.f;
#pragma unroll
      for (int i = 0; i < 8; ++i) { v[i] = *(const f32x4*)(H2 + (size_t)r * DM + i * 256 + lane * 4); ss += v[i][0] * v[i][0] + v[i][1] * v[i][1] + v[i][2] * v[i][2] + v[i][3] * v[i][3]; }
      ss = wave_sum(ss);
      const float rs = rsqrtf(ss * (1.0f / DM) + EPS);
#pragma unroll
      for (int i = 0; i < 8; ++i) {
        const f32x4 w = *(const f32x4*)(p.final_norm_w + i * 256 + lane * 4);
        f32x4 o = v[i] * rs * w;
        *(f32x4*)(outp + (size_t)r * DM + i * 256 + lane * 4) = o;
      }
    }
  }
  }
  }
#endif
}

extern "C" void kernel_launch(void* const* d_in, const int* in_sizes, int n_in, void* d_out, int out_size, void* d_ws, size_t ws_size,
                              hipStream_t stream) {
  static int grid_blocks = 0;
  if (!grid_blocks) {
    int dev = 0, cus = 0, per_cu = 0;
    (void)hipGetDevice(&dev);
    (void)hipDeviceGetAttribute(&cus, hipDeviceAttributeMultiprocessorCount, dev);
    (void)hipFuncSetAttribute((const void*)mega, hipFuncAttributeMaxDynamicSharedMemorySize, LDS_BYTES);
    (void)hipOccupancyMaxActiveBlocksPerMultiprocessor(&per_cu, mega, NTH, LDS_BYTES);
    if (per_cu > 1) per_cu = 1;
    grid_blocks = cus * per_cu;
  }
  if (ws_size < WS_NEED || grid_blocks <= 0) { fprintf(stderr, "workspace too small or no occupancy\n"); return; }
  Params p{};
  const float** pp = (const float**)&p;
  for (int i = 0; i < 23; ++i) pp[i] = (const float*)d_in[i];
  p.ws = (unsigned char*)d_ws;
  p.out = (unsigned char*)d_out;
  (void)hipMemsetAsync((unsigned char*)d_ws + OFF_MOD, 0, OFF_ROPE - OFF_MOD, stream);
  void* args[] = {&p};
  hipError_t e = hipLaunchCooperativeKernel((void*)mega, dim3(grid_blocks), dim3(NTH), args, LDS_BYTES, stream);
  if (e != hipSuccess) fprintf(stderr, "cooperative launch failed: %s (grid %d)\n", hipGetErrorString(e), grid_blocks);
}
```

```cpp
#include <hip/hip_runtime.h>
#include <hip/hip_cooperative_groups.h>
#include <cstdio>
#include <cstdint>
namespace cg = cooperative_groups;

typedef unsigned short bf16_t;
typedef short bf16x8 __attribute__((ext_vector_type(8)));
typedef short bf16x4 __attribute__((ext_vector_type(4)));
typedef float f32x4 __attribute__((ext_vector_type(4)));
typedef float f32x2 __attribute__((ext_vector_type(2)));
typedef unsigned u32x4 __attribute__((ext_vector_type(4)));
typedef unsigned u32x2 __attribute__((ext_vector_type(2)));

constexpr int DM = 2048, SEQ = 16384, CTX = 256, R = SEQ + CTX, CH = 256, NCH = 65;
constexpr int INC = 22656, DFF = 8192;
constexpr float EPS = 1e-6f;
constexpr int NTH = 512;
constexpr int LDS_BYTES = 147456;
#ifndef DUP_MASK
#define DUP_MASK 0
#endif
#ifndef PHASE_MASK
#define PHASE_MASK 0x7fff
#endif

constexpr size_t SZQ = (size_t)R * 2048 * 2;
constexpr size_t OFF_Q = 0;
constexpr size_t OFF_K = OFF_Q + SZQ;
constexpr size_t OFF_VT = OFF_K + SZQ;
constexpr size_t OFF_XT = OFF_VT + SZQ;
constexpr size_t OFF_B = OFF_XT + 2 * SZQ;
constexpr size_t OFF_C = OFF_B + SZQ / 2;
constexpr size_t OFF_DTRAW = OFF_C + SZQ / 2;
constexpr size_t SZ_DTA = (size_t)R * 64 * 4;
constexpr size_t OFF_DTF = OFF_DTRAW + (size_t)R * 128 * 4;
constexpr size_t OFF_DTB = OFF_DTF + SZ_DTA;
constexpr size_t OFF_CSF = OFF_DTB + SZ_DTA;
constexpr size_t OFF_RCSB = OFF_CSF + SZ_DTA;
constexpr size_t OFF_SR = OFF_RCSB + SZ_DTA;
constexpr size_t OFF_SS = OFF_SR + SZQ;
constexpr size_t OFF_WA = OFF_SS + 2 * SZQ;
constexpr size_t OFF_WRO = OFF_WA + (size_t)12544 * 2048 * 2;
constexpr size_t OFF_WSO = OFF_WRO + (size_t)2048 * 2048 * 2;
constexpr size_t OFF_WO = OFF_WSO + (size_t)2048 * 4096 * 2;
constexpr size_t OFF_MOD = OFF_WO + (size_t)2048 * 2048 * 2;
constexpr size_t OFF_SUMSQ = OFF_MOD + 2 * 12288 * 4;
constexpr size_t OFF_BAR = OFF_SUMSQ + (size_t)SEQ * 4;
constexpr size_t OFF_SUMSQ2 = OFF_BAR + 16384;
constexpr size_t OFF_BIAS1 = OFF_SUMSQ2 + (size_t)SEQ * 4;
constexpr size_t OFF_ROPE = OFF_BIAS1 + (size_t)DFF * 4;
constexpr size_t WS_NEED = OFF_ROPE + 256 * 32 * 2 * 4;
constexpr size_t OFF_BCRAW = OFF_SR, OFF_XTRAW = OFF_SS, OFF_YS = OFF_K, OFF_W1T = OFF_SR, OFF_W2T = OFF_SR + (size_t)8192 * 2048 * 2;
constexpr size_t OFF_G = OFF_XT, OFF_H1 = OFF_SS, OFF_M = OFF_B, OFF_F = OFF_Q, OFF_A1 = OFF_K;
constexpr size_t OOFF_U = 0, OOFF_WB = SZQ;

struct Params {
  const float *x, *c, *ctx, *c_ctx, *w_mod, *b_mod, *norm1_w, *w_in, *conv_w, *conv_b, *ret_decay_logit, *ret_norm_w, *ssd_a_log,
      *ssd_dt_bias, *ssd_d, *ssd_norm_w, *w_ret_out, *w_ssd_out, *w_o, *norm2_w, *w_mlp1, *w_mlp2, *final_norm_w;
  unsigned char* ws;
  unsigned char* out;
};

extern __shared__ __attribute__((aligned(16))) unsigned char smem[];

typedef __bf16 bf16x2_t __attribute__((ext_vector_type(2)));
__device__ __forceinline__ unsigned cvt_pk_bf16(float lo, float hi) {
  f32x2 v = {lo, hi};
  bf16x2_t b = __builtin_convertvector(v, bf16x2_t);
  return __builtin_bit_cast(unsigned, b);
}
__device__ __forceinline__ float bf2f(unsigned short v) { return __uint_as_float((unsigned)v << 16); }
__device__ __forceinline__ float bflo(unsigned v) { return __uint_as_float(v << 16); }
__device__ __forceinline__ float bfhi(unsigned v) { return __uint_as_float(v & 0xffff0000u); }
__device__ __forceinline__ float sigmoidf_(float x) { return __builtin_amdgcn_rcpf(1.0f + __expf(-x)); }
__device__ __forceinline__ float siluf_(float x) { return x * __builtin_amdgcn_rcpf(1.0f + __expf(-x)); }
__device__ __forceinline__ float softplusf_(float x) { const float e = __expf(x); return x > 20.f ? x : (x < -6.f ? e * (1.0f - 0.5f * e) : __logf(1.0f + e)); }
__device__ __forceinline__ float wave_sum(float v) {
#pragma unroll
  for (int o = 32; o > 0; o >>= 1) v += __shfl_xor(v, o);
  return v;
}
__device__ __forceinline__ bf16x8 mk8(bf16x4 a, bf16x4 b) { return __builtin_shufflevector(a, b, 0, 1, 2, 3, 4, 5, 6, 7); }
__device__ __forceinline__ bf16x8 as_bf16x8(u32x4 v) { union { u32x4 u; bf16x8 b; } x; x.u = v; return x.b; }
__device__ __forceinline__ u32x4 as_u32x4(bf16x8 v) { union { u32x4 u; bf16x8 b; } x; x.b = v; return x.u; }
#define MFMA(a, b, c) __builtin_amdgcn_mfma_f32_16x16x32_bf16((a), (b), (c), 0, 0, 0)

constexpr int BM = 256, BK = 64, HALF = 128, HT = HALF * BK;
__device__ __forceinline__ int lds_byte(int r, int c) {
  int st = (r >> 4) * 2 + (c >> 5), rr = r & 15, cc = c & 31, ob = rr * 64 + cc * 2;
  return st * 1024 + (ob ^ (((ob >> 9) & 1) << 5));
}
__device__ __forceinline__ void stage_rc(int b, int& Rr, int& Cc) {
  int st = b / 1024, sb = b % 1024, swz = sb ^ (((sb >> 9) & 1) << 5);
  Rr = (st >> 1) * 16 + swz / 64;
  Cc = (st & 1) * 32 + (swz % 64) / 2;
}

template <class Epi>
__device__ __forceinline__ void gemm_unit(const bf16_t* __restrict__ A, int lda, const bf16_t* __restrict__ Bt, int ldb, int K, int pm,
                                          int pn, const Epi& epi) {
  typedef __attribute__((address_space(3))) unsigned char lds_u8;
  lds_u8* lds = (lds_u8*)smem;
  int tid = threadIdx.x;
  asm volatile("" : "+v"(tid));
  const int wid = __builtin_amdgcn_readfirstlane(tid >> 6), lane = tid & 63, wr = wid >> 2, wc = wid & 3, fr = lane & 15, fq = lane >> 4;
  unsigned voffA[2], voffB[2];
#pragma unroll
  for (int i = 0; i < 2; ++i) { int Rr, Cc; stage_rc(tid * 16 + i * 8192, Rr, Cc); voffA[i] = (unsigned)(Rr * lda + Cc) * 2u; voffB[i] = (unsigned)(Rr * ldb + Cc) * 2u; }
  const size_t kstep = (size_t)(BK * 2);
  const size_t hstepA = (size_t)HALF * lda * 2, hstepB = (size_t)HALF * ldb * 2;
  const unsigned ldsw = (unsigned)wid * 1024u;
  const int aoff = lds_byte(wr * 64 + fr, fq * 8), boff = lds_byte(wc * 32 + fr, fq * 8);
  constexpr int HTB = HT * 2;
#define SAo(b, h) (((b) * 2 + (h)) * HTB)
#define SBo(b, h) ((4 + (b) * 2 + (h)) * HTB)
#define STAGE(bufoff, gbase, voff) do { _Pragma("unroll") for (int _i = 0; _i < 2; ++_i) \
    __builtin_amdgcn_global_load_lds((const unsigned*)((const char*)(gbase) + (voff)[_i]), (__attribute__((address_space(3))) unsigned*)(lds + (bufoff) + ldsw + _i * 8192), 16, 0, 0); } while (0)
#define LDA(dst, b, h) do { _Pragma("unroll") for (int m = 0; m < 4; ++m) _Pragma("unroll") for (int k = 0; k < 2; ++k) dst[m][k] = *(const __attribute__((address_space(3))) bf16x8*)(lds + SAo(b, h) + aoff + m * 2048 + k * 1024); } while (0)
#define LDB(dst, b, h) do { _Pragma("unroll") for (int n = 0; n < 2; ++n) _Pragma("unroll") for (int k = 0; k < 2; ++k) dst[n][k] = *(const __attribute__((address_space(3))) bf16x8*)(lds + SBo(b, h) + boff + n * 2048 + k * 1024); } while (0)
#define MMA(ai, bj, At_, Bt_) do { __builtin_amdgcn_s_setprio(1); _Pragma("unroll") for (int m = 0; m < 4; ++m) _Pragma("unroll") for (int n = 0; n < 2; ++n) _Pragma("unroll") for (int k = 0; k < 2; ++k) \
    acc[ai][bj][m][n] = MFMA(Bt_[n][k], At_[m][k], acc[ai][bj][m][n]); __builtin_amdgcn_s_setprio(0); } while (0)
#define WAIT_V(n) asm volatile("s_waitcnt vmcnt(" #n ")" ::: "memory")
#define WAIT_L(n) asm volatile("s_waitcnt lgkmcnt(" #n ")" ::: "memory")
#define BAR __builtin_amdgcn_s_barrier()
#define SCHED __builtin_amdgcn_sched_barrier(0)
  const int brow = pm * BM, bcol = pn * BM;
  f32x4 acc[2][2][4][2];
#pragma unroll
  for (int a = 0; a < 2; ++a)
#pragma unroll
    for (int b = 0; b < 2; ++b)
#pragma unroll
      for (int m = 0; m < 4; ++m)
#pragma unroll
        for (int n = 0; n < 2; ++n) acc[a][b][m][n] = (f32x4){0.f, 0.f, 0.f, 0.f};
  bf16x8 At[4][2], B0[2][2], B1[2][2];
  const int nt = K / BK;
  const char* cA = (const char*)A + (size_t)brow * lda * 2;
  const char* cB = (const char*)Bt + (size_t)bcol * ldb * 2;
  STAGE(SBo(0, 0), cB, voffB); STAGE(SAo(0, 0), cA, voffA); STAGE(SBo(0, 1), cB + hstepB, voffB); STAGE(SAo(0, 1), cA + hstepA, voffA);
  if (wr == 1) BAR;
  WAIT_V(4); BAR;
  STAGE(SBo(1, 0), cB + kstep, voffB); STAGE(SAo(1, 0), cA + kstep, voffA); STAGE(SBo(1, 1), cB + hstepB + kstep, voffB);
  WAIT_V(6); BAR;
  for (int t = 0; t < nt - 2; t += 2) {
    const char* a1 = cA + (size_t)(t + 1) * kstep;
    const char* a2 = cA + (size_t)(t + 2) * kstep; const char* b2 = cB + (size_t)(t + 2) * kstep;
    const char* a3 = a2 + kstep; const char* b3 = b2 + kstep;
    LDB(B0, 0, 0); SCHED; LDA(At, 0, 0); STAGE(SAo(1, 1), a1 + hstepA, voffA);
    WAIT_L(8); BAR; WAIT_L(0); MMA(0, 0, At, B0); BAR; SCHED;
    LDB(B1, 0, 1); STAGE(SBo(0, 0), b2, voffB);
    BAR; WAIT_L(0); MMA(0, 1, At, B1); BAR;
    LDA(At, 0, 1); STAGE(SAo(0, 0), a2, voffA);
    BAR; WAIT_L(0); MMA(1, 0, At, B0); BAR; SCHED;
    STAGE(SBo(0, 1), b2 + hstepB, voffB);
    WAIT_V(6); BAR; MMA(1, 1, At, B1); BAR;
    LDB(B0, 1, 0); SCHED; LDA(At, 1, 0); STAGE(SAo(0, 1), a2 + hstepA, voffA);
    WAIT_L(8); BAR; WAIT_L(0); MMA(0, 0, At, B0); BAR; SCHED;
    LDB(B1, 1, 1); STAGE(SBo(1, 0), b3, voffB);
    BAR; WAIT_L(0); MMA(0, 1, At, B1); BAR;
    LDA(At, 1, 1); STAGE(SAo(1, 0), a3, voffA);
    BAR; WAIT_L(0); MMA(1, 0, At, B0); BAR; SCHED;
    STAGE(SBo(1, 1), b3 + hstepB, voffB);
    WAIT_V(6); BAR; MMA(1, 1, At, B1); BAR;
  }
  { const char* a1 = cA + (size_t)(nt - 1) * kstep;
    LDB(B0, 0, 0); LDA(At, 0, 0); STAGE(SAo(1, 1), a1 + hstepA, voffA);
    BAR; WAIT_L(0); MMA(0, 0, At, B0); BAR;
    LDB(B1, 0, 1); BAR; WAIT_L(0); MMA(0, 1, At, B1); BAR;
    LDA(At, 0, 1); WAIT_V(4); BAR; WAIT_L(0); MMA(1, 0, At, B0); MMA(1, 1, At, B1); BAR; }
  { LDB(B0, 1, 0); LDA(At, 1, 0); WAIT_V(2); BAR; WAIT_L(0); MMA(0, 0, At, B0); BAR;
    LDB(B1, 1, 1); WAIT_V(0); BAR; WAIT_L(0); MMA(0, 1, At, B1); BAR;
    LDA(At, 1, 1); BAR; WAIT_L(0); MMA(1, 0, At, B0); MMA(1, 1, At, B1); BAR; }
  if (wr == 0) BAR;
#pragma unroll
  for (int ai = 0; ai < 2; ++ai)
#pragma unroll
    for (int m = 0; m < 4; ++m) {
      const int row = brow + ai * HALF + wr * 64 + m * 16 + fr;
#pragma unroll
      for (int bj = 0; bj < 2; ++bj)
#pragma unroll
        for (int n = 0; n < 2; ++n) epi(acc[ai][bj][m][n], row, bcol + bj * HALF + wc * 32 + n * 16 + fq * 4, pm, pn);
      asm volatile("" ::: "memory");
    }
}

__device__ __forceinline__ void unit_map(int wgid, int nM, int nN, int& pm, int& pn) {
  const int nwg = nM * nN, NX = 8, WGM = 4;
  { const int q = nwg / NX, r = nwg % NX, xcd = wgid % NX, off = wgid / NX; wgid = (xcd < r ? xcd * (q + 1) : r * (q + 1) + (xcd - r) * q) + off; }
  const int nig = WGM * nN, gid = wgid / nig, fm = gid * WGM, gsz = (nM - fm) < WGM ? (nM - fm) : WGM;
  pm = fm + ((wgid % nig) % gsz);
  pn = (wgid % nig) / gsz;
}

struct EpiA1 {
  bf16_t *Q, *Kb, *BC; float* DTRAW; const float* rope;
  __device__ __forceinline__ void operator()(const f32x4& v, int row, int col, int pm, int pn) const {
    if (pn < 16) {
      f32x4 o = v;
      const bool isk = pn >= 8;
      if (isk) o = o * 0.08838834764831845f;
      if (pm > 0) {
        const int t = row - CTX, cl = col & 127, half = cl >> 6, d0 = (cl & 63) >> 1;
        const int pos = half ? (t & 63) : (t >> 6);
        const f32x4 cs = *(const f32x4*)(rope + ((size_t)pos * 32 + d0) * 2);
        f32x4 q;
        q[0] = o[0] * cs[0] - o[1] * cs[1]; q[1] = o[0] * cs[1] + o[1] * cs[0];
        q[2] = o[2] * cs[2] - o[3] * cs[3]; q[3] = o[2] * cs[3] + o[3] * cs[2];
        o = q;
      }
      u32x2 w; w.x = cvt_pk_bf16(o[0], o[1]); w.y = cvt_pk_bf16(o[2], o[3]);
      bf16_t* dst = (isk ? Kb : Q) + (size_t)row * 2048 + (col & 2047);
      *(u32x2*)dst = w;
    } else if (pn < 24) {
      u32x2 w; w.x = cvt_pk_bf16(v[0], v[1]); w.y = cvt_pk_bf16(v[2], v[3]);
      *(u32x2*)(BC + (size_t)row * 2048 + (col - 4096)) = w;
    } else {
      const int cl = col - 6144;
      if (cl < 128) *(f32x4*)(DTRAW + (size_t)row * 128 + cl) = v;
    }
  }
};
struct EpiA2 {
  bf16_t *VT, *XTRAW;
  __device__ __forceinline__ void operator()(const f32x4& v, int row, int col, int pm, int pn) const {
    u32x2 w; w.x = cvt_pk_bf16(v[0], v[1]); w.y = cvt_pk_bf16(v[2], v[3]);
    bf16_t* dst = row < 2048 ? VT + (size_t)row * R + col : XTRAW + (size_t)(row - 2048) * R + col;
    *(u32x2*)dst = w;
  }
};
struct EpiB {
  bf16_t *Q, *YS, *G; const float* ssd_norm_w; float* SUMSQ;
  __device__ __forceinline__ void operator()(const f32x4& v, int row, int col, int pm, int pn) const {
    if (pn < 8) {
      bf16_t* p = Q + (size_t)(row + CTX) * 2048 + col;
      const u32x2 y = *(const u32x2*)p;
      u32x2 w;
      w.x = cvt_pk_bf16(bflo(y.x) * siluf_(v[0]), bfhi(y.x) * siluf_(v[1]));
      w.y = cvt_pk_bf16(bflo(y.y) * siluf_(v[2]), bfhi(y.y) * siluf_(v[3]));
      *(u32x2*)p = w;
    } else if (pn < 24) {
      const int zc = col - 2048;
      bf16_t* p = YS + (size_t)row * 4096 + zc;
      const u32x2 y = *(const u32x2*)p;
      const f32x4 nw = *(const f32x4*)(ssd_norm_w + zc);
      const float t0 = bflo(y.x) * siluf_(v[0]), t1 = bfhi(y.x) * siluf_(v[1]), t2 = bflo(y.y) * siluf_(v[2]), t3 = bfhi(y.y) * siluf_(v[3]);
      float ss = t0 * t0 + t1 * t1 + t2 * t2 + t3 * t3;
      ss += __shfl_xor(ss, 16); ss += __shfl_xor(ss, 32);
      if ((threadIdx.x & 48) == 0) atomicAdd(SUMSQ + row, ss);
      u32x2 w; w.x = cvt_pk_bf16(t0 * nw[0], t1 * nw[1]); w.y = cvt_pk_bf16(t2 * nw[2], t3 * nw[3]);
      *(u32x2*)p = w;
    } else {
      u32x2 w; w.x = cvt_pk_bf16(sigmoidf_(v[0]), sigmoidf_(v[1])); w.y = cvt_pk_bf16(sigmoidf_(v[2]), sigmoidf_(v[3]));
      *(u32x2*)(G + (size_t)row * 4096 + (col - 6144)) = w;
    }
  }
};
struct EpiO1a {
  const bf16_t* G; bf16_t* M;
  __device__ __forceinline__ void operator()(const f32x4& v, int row, int col, int pm, int pn) const {
    const u32x2 g = *(const u32x2*)(G + (size_t)row * 4096 + col);
    u32x2 w;
    w.x = cvt_pk_bf16(bflo(g.x) * v[0], bfhi(g.x) * v[1]);
    w.y = cvt_pk_bf16(bflo(g.y) * v[2], bfhi(g.y) * v[3]);
    *(u32x2*)(M + (size_t)row * 2048 + col) = w;
  }
};
struct EpiO1b {
  const bf16_t* G; const float* SUMSQ; bf16_t* M;
  __device__ __forceinline__ void operator()(const f32x4& v, int row, int col, int pm, int pn) const {
    const u32x2 g = *(const u32x2*)(G + (size_t)row * 4096 + 2048 + col);
    const float r = rsqrtf(SUMSQ[row] * (1.0f / 4096.0f) + EPS);
    const u32x2 t = *(const u32x2*)(M + (size_t)row * 2048 + col);
    u32x2 w;
    w.x = cvt_pk_bf16(bflo(t.x) + bflo(g.x) * r * v[0], bfhi(t.x) + bfhi(g.x) * r * v[1]);
    w.y = cvt_pk_bf16(bflo(t.y) + bflo(g.y) * r * v[2], bfhi(t.y) + bfhi(g.y) * r * v[3]);
    *(u32x2*)(M + (size_t)row * 2048 + col) = w;
  }
};
struct EpiRes {
  const float* base; const float* gate; float* H; bool do_store;
  __device__ __forceinline__ void operator()(const f32x4& v, int row, int col, int pm, int pn) const {
    const f32x4 b = *(const f32x4*)(base + (size_t)row * 2048 + col);
    const f32x4 g = *(const f32x4*)(gate + col);
    if (do_store) *(f32x4*)(H + (size_t)row * 2048 + col) = b + g * v;
  }
};
struct EpiRes9 {
  const float* base; const float* gate; float* H; const float* nw; const float* scf; bf16_t* F; float* SS2;
  __device__ __forceinline__ void operator()(const f32x4& v, int row, int col, int pm, int pn) const {
    const f32x4 b = *(const f32x4*)(base + (size_t)row * 2048 + col);
    const f32x4 g = *(const f32x4*)(gate + col);
    const f32x4 h = b + g * v;
    *(f32x4*)(H + (size_t)row * 2048 + col) = h;
    const f32x4 w = *(const f32x4*)(nw + col), sc = *(const f32x4*)(scf + col);
    u32x2 o;
    o.x = cvt_pk_bf16(h[0] * w[0] * (1.0f + sc[0]), h[1] * w[1] * (1.0f + sc[1]));
    o.y = cvt_pk_bf16(h[2] * w[2] * (1.0f + sc[2]), h[3] * w[3] * (1.0f + sc[3]));
    *(u32x2*)(F + (size_t)row * 2048 + col) = o;
    float ss = h[0] * h[0] + h[1] * h[1] + h[2] * h[2] + h[3] * h[3];
    ss += __shfl_xor(ss, 16); ss += __shfl_xor(ss, 32);
    if ((threadIdx.x & 48) == 0) atomicAdd(SS2 + row, ss);
  }
};
struct EpiM1 {
  bf16_t* A1; const float* SS2; const float* bias1;
  __device__ __forceinline__ void operator()(const f32x4& v, int row, int col, int pm, int pn) const {
    const float r_ = rsqrtf(SS2[row] * (1.0f / DM) + EPS);
    const f32x4 bi = *(const f32x4*)(bias1 + col);
    f32x4 o;
#pragma unroll
    for (int j = 0; j < 4; ++j) { const float r = fmaxf(v[j] * r_ + bi[j], 0.f); o[j] = r * r; }
    u32x2 w; w.x = cvt_pk_bf16(o[0], o[1]); w.y = cvt_pk_bf16(o[2], o[3]);
    *(u32x2*)(A1 + (size_t)row * DFF + col) = w;
  }
};

__device__ __forceinline__ void convert_tile(const float* __restrict__ src, int ldw, int c0, int K, bf16_t* __restrict__ dst, int tc, int kt, int tid) {
  float* tile = (float*)smem;
  const int c4 = (tid & 63) * 4, kq = tid >> 6;
  f32x4 v[8];
#pragma unroll
  for (int i = 0; i < 8; ++i) v[i] = *(const f32x4*)(src + (size_t)(kt * 64 + kq + i * 8) * ldw + c0 + tc * 256 + c4);
#pragma unroll
  for (int i = 0; i < 8; ++i) {
    float* tp = tile + (kq + i * 8) * 257 + c4;
    tp[0] = v[i][0]; tp[1] = v[i][1]; tp[2] = v[i][2]; tp[3] = v[i][3];
  }
  __syncthreads();
  const int c = tid >> 1, k32 = (tid & 1) * 32;
  bf16_t* dp = dst + (size_t)(tc * 256 + c) * K + kt * 64 + k32;
#pragma unroll
  for (int q = 0; q < 4; ++q) {
    const float* tp = tile + (k32 + q * 8) * 257 + c;
    u32x4 w;
    w.x = cvt_pk_bf16(tp[0], tp[257]); w.y = cvt_pk_bf16(tp[2 * 257], tp[3 * 257]);
    w.z = cvt_pk_bf16(tp[4 * 257], tp[5 * 257]); w.w = cvt_pk_bf16(tp[6 * 257], tp[7 * 257]);
    *(u32x4*)(dp + q * 8) = w;
  }
}

__device__ __forceinline__ void convert_segment(const float* __restrict__ src, int ldw, int c0, int ncols, int K, bf16_t* __restrict__ dst, bool perm,
                                                const float* bias_vec = nullptr, float* bias_out = nullptr) {
  float* tile = (float*)smem;
  int tid = threadIdx.x;
  asm volatile("" : "+v"(tid));
  const int tk = K / 64, ntc = (ncols + 255) / 256, ntiles = ntc * tk;
  const int c4 = (tid & 63) * 4, kq = tid >> 6;
  f32x4 v[8];
  auto load_tile = [&](int t) {
    const int tc = t / tk, kt = t % tk;
    const bool okc = tc * 256 + c4 < ncols;
#pragma unroll
    for (int i = 0; i < 8; ++i)
      v[i] = okc ? *(const f32x4*)(src + (size_t)(kt * 64 + kq + i * 8) * ldw + c0 + tc * 256 + c4) : (f32x4){0.f, 0.f, 0.f, 0.f};
  };
  if ((int)blockIdx.x < ntiles) load_tile(blockIdx.x);
  for (int t = blockIdx.x; t < ntiles; t += gridDim.x) {
    const int tc = t / tk, kt = t % tk;
    __syncthreads();
#pragma unroll
    for (int i = 0; i < 8; ++i) {
      float* tp = tile + (kq + i * 8) * 257 + c4;
      tp[0] = v[i][0]; tp[1] = v[i][1]; tp[2] = v[i][2]; tp[3] = v[i][3];
    }
    if (t + (int)gridDim.x < ntiles) load_tile(t + gridDim.x);
    __syncthreads();
    if (bias_out != nullptr && tid < 256) {
      float a = 0.f;
#pragma unroll 8
      for (int k = 0; k < 64; ++k) a += tile[k * 257 + tid] * bias_vec[kt * 64 + k];
      atomicAdd(bias_out + tc * 256 + tid, a);
    }
    {
      const int c = tid >> 1, k32 = (tid & 1) * 32;
      const int cr = c & 63;
      const int sc = perm ? ((c & ~63) + (cr & 1) * 32 + (cr >> 1)) : c;
      if (tc * 256 + c < ncols) {
        bf16_t* dp = dst + (size_t)(tc * 256 + c) * K + kt * 64 + k32;
#pragma unroll
        for (int q = 0; q < 4; ++q) {
          const float* tp = tile + (k32 + q * 8) * 257 + sc;
          u32x4 w;
          w.x = cvt_pk_bf16(tp[0], tp[257]); w.y = cvt_pk_bf16(tp[2 * 257], tp[3 * 257]);
          w.z = cvt_pk_bf16(tp[4 * 257], tp[5 * 257]); w.w = cvt_pk_bf16(tp[6 * 257], tp[7 * 257]);
          *(u32x4*)(dp + q * 8) = w;
        }
      }
    }
  }
  __syncthreads();
}

__device__ __forceinline__ void modnorm_rows(const float* __restrict__ xa, int rows_a, const float* __restrict__ xb, int rows_b, const float* __restrict__ nw,
                             const float* __restrict__ sca, const float* __restrict__ sha, const float* __restrict__ scb,
                             const float* __restrict__ shb, bf16_t* __restrict__ outp) {
  int tid = threadIdx.x;
  asm volatile("" : "+v"(tid));
  const int lane = tid & 63, gw = blockIdx.x * (NTH / 64) + (tid >> 6), nw_ = gridDim.x * (NTH / 64);
  for (int r = gw; r < rows_a + rows_b; r += nw_) {
    const bool isa = r < rows_a;
    const float* xr = isa ? xa + (size_t)r * DM : xb + (size_t)(r - rows_a) * DM;
    const float* sc = isa ? sca : scb;
    const float* sh = isa ? sha : shb;
    f32x4 v[8];
    float ss = 0.f;
#pragma unroll
    for (int i = 0; i < 8; ++i) { v[i] = *(const f32x4*)(xr + i * 256 + lane * 4); ss += v[i][0] * v[i][0] + v[i][1] * v[i][1] + v[i][2] * v[i][2] + v[i][3] * v[i][3]; }
    ss = wave_sum(ss);
    const float rs = rsqrtf(ss * (1.0f / DM) + EPS);
#pragma unroll
    for (int i = 0; i < 8; ++i) {
      const int cidx = i * 256 + lane * 4;
      const f32x4 w = *(const f32x4*)(nw + cidx), s = *(const f32x4*)(sc + cidx), b = *(const f32x4*)(sh + cidx);
      f32x4 o;
#pragma unroll
      for (int j = 0; j < 4; ++j) o[j] = v[i][j] * rs * w[j] * (1.0f + s[j]) + b[j];
      u32x2 pk; pk.x = cvt_pk_bf16(o[0], o[1]); pk.y = cvt_pk_bf16(o[2], o[3]);
      *(u32x2*)(outp + (size_t)r * DM + cidx) = pk;
    }
  }
}

template <int MODE>
__device__ __forceinline__ void state_build_item(const Params& p, int c, int hg) {
  unsigned char* ws = p.ws;
  int tid = threadIdx.x;
  asm volatile("" : "+v"(tid));
  const int wid = tid >> 6, lane = tid & 63, fr = lane & 15, fq = lane >> 4;
  bf16_t* Kt = (bf16_t*)smem;
  bf16_t* Vt = (bf16_t*)(smem + 67584);
  float* wfs = (float*)(smem + 135168);
  float* wbs = wfs + 256;
  const bf16_t* Ksrc = MODE == 0 ? (const bf16_t*)(ws + OFF_K) : (const bf16_t*)(ws + OFF_B);
  const int kld = MODE == 0 ? 2048 : 1024;
  constexpr int NV = MODE == 0 ? 8 : 4;
  const bf16_t* Vsrc = MODE == 0 ? (const bf16_t*)(ws + OFF_VT) : (const bf16_t*)(ws + OFF_XT);
  const int PH = MODE == 0 ? 128 : 64;
  const float* CSF = (const float*)(ws + OFF_CSF); const float* RCSB = (const float*)(ws + OFF_RCSB);
  const float* DTF = (const float*)(ws + OFF_DTF); const float* DTB = (const float*)(ws + OFF_DTB);
  u32x4 vv[NV];
  float wr_[6] = {0.f, 0.f, 0.f, 0.f, 0.f, 0.f};
#define SB_PREFETCH(H_)                                                                                               \
  do {                                                                                                                \
    _Pragma("unroll") for (int i = 0; i < NV; ++i) {                                                                  \
      const int idx = tid + i * NTH, pp = idx >> 5, chn = idx & 31;                                                   \
      vv[i] = *(const u32x4*)(Vsrc + (size_t)((H_) * PH + pp) * R + c * CH + chn * 8);                                \
    }                                                                                                                 \
    if (MODE == 1 && tid < 256) {                                                                                     \
      const size_t rj = (size_t)(c * CH + tid) * 64 + (H_);                                                           \
      wr_[0] = CSF[(size_t)(c * CH + 255) * 64 + (H_)]; wr_[1] = CSF[rj]; wr_[2] = DTF[rj];                           \
      wr_[3] = RCSB[(size_t)(c * CH) * 64 + (H_)]; wr_[4] = RCSB[rj]; wr_[5] = DTB[rj];                               \
    }                                                                                                                 \
  } while (0)
  bf16x8 kv[8];
#pragma unroll
  for (int i = 0; i < 8; ++i) {
    const int idx = tid + i * NTH, j = idx >> 4, chn = idx & 15;
    kv[i] = *(const bf16x8*)(Ksrc + (size_t)(c * CH + j) * kld + hg * 128 + chn * 8);
  }
  SB_PREFETCH(MODE == 0 ? hg : hg * 8);
  __syncthreads();
#pragma unroll
  for (int i = 0; i < 8; ++i) {
    const int idx = tid + i * NTH, j = idx >> 4, chn = idx & 15;
#pragma unroll
    for (int e = 0; e < 8; ++e) Kt[(chn * 8 + e) * 264 + j] = (bf16_t)kv[i][e];
  }
  const int nheads = MODE == 0 ? 1 : 8;
  for (int hh = 0; hh < nheads; ++hh) {
    const int h = MODE == 0 ? hg : hg * 8 + hh;
    if (hh > 0) __syncthreads();
#pragma unroll
    for (int i = 0; i < NV; ++i) {
      const int idx = tid + i * NTH, pp = idx >> 5, chn = idx & 31;
      *(u32x4*)(Vt + pp * 264 + chn * 8) = vv[i];
    }
    if (tid < 256) {
      if (MODE == 0) {
        const float lgf = -log1pf(__expf(-p.ret_decay_logit[h])) * 1.4426950408889634f;
        const float lgb = -log1pf(__expf(-p.ret_decay_logit[16 + h])) * 1.4426950408889634f;
        wfs[tid] = exp2f((float)(255 - tid) * lgf);
        wbs[tid] = exp2f((float)tid * lgb);
      } else {
        wfs[tid] = __expf(wr_[0] - wr_[1]) * wr_[2];
        wbs[tid] = __expf(wr_[3] - wr_[4]) * wr_[5];
      }
    }
    __syncthreads();
    if (MODE == 1 && hh + 1 < nheads) SB_PREFETCH(h + 1);
    constexpr int NTL = MODE == 0 ? 8 : 4;
    const int p0 = MODE == 0 ? wid * 16 : (wid & 3) * 16;
    const int nt0 = MODE == 0 ? 0 : (wid >> 2) * 4;
    f32x4 af[NTL], ab[NTL];
#pragma unroll
    for (int i = 0; i < NTL; ++i) { af[i] = (f32x4){0.f, 0.f, 0.f, 0.f}; ab[i] = af[i]; }
#pragma unroll 2
    for (int kk = 0; kk < 8; ++kk) {
      const int jb = kk * 32 + fq * 8;
      const bf16x8 vr = *(const bf16x8*)(Vt + (p0 + fr) * 264 + jb);
      const f32x4 wf0 = *(const f32x4*)(wfs + jb), wf1 = *(const f32x4*)(wfs + jb + 4);
      const f32x4 wb0 = *(const f32x4*)(wbs + jb), wb1 = *(const f32x4*)(wbs + jb + 4);
      float x[8];
#pragma unroll
      for (int e = 0; e < 8; ++e) x[e] = bf2f((unsigned short)vr[e]);
      u32x4 uf, ub;
      uf.x = cvt_pk_bf16(x[0] * wf0[0], x[1] * wf0[1]); uf.y = cvt_pk_bf16(x[2] * wf0[2], x[3] * wf0[3]);
      uf.z = cvt_pk_bf16(x[4] * wf1[0], x[5] * wf1[1]); uf.w = cvt_pk_bf16(x[6] * wf1[2], x[7] * wf1[3]);
      ub.x = cvt_pk_bf16(x[0] * wb0[0], x[1] * wb0[1]); ub.y = cvt_pk_bf16(x[2] * wb0[2], x[3] * wb0[3]);
      ub.z = cvt_pk_bf16(x[4] * wb1[0], x[5] * wb1[1]); ub.w = cvt_pk_bf16(x[6] * wb1[2], x[7] * wb1[3]);
      const bf16x8 vf = as_bf16x8(uf), vb = as_bf16x8(ub);
#pragma unroll
      for (int i = 0; i < NTL; ++i) {
        const bf16x8 kf = *(const bf16x8*)(Kt + ((nt0 + i) * 16 + fr) * 264 + jb);
        af[i] = MFMA(kf, vf, af[i]);
        ab[i] = MFMA(kf, vb, ab[i]);
      }
    }
    bf16_t *df, *db;
    if (MODE == 0) {
      bf16_t* SR = (bf16_t*)(ws + OFF_SR);
      df = SR + ((size_t)(c * 2 + 0) * 16 + h) * 16384; db = SR + ((size_t)(c * 2 + 1) * 16 + h) * 16384;
    } else {
      bf16_t* SS = (bf16_t*)(ws + OFF_SS);
      df = SS + ((size_t)(c * 64 + h) * 2 + 0) * 8192; db = df + 8192;
    }
#pragma unroll
    for (int i = 0; i < NTL; ++i) {
      const int off = (p0 + fr) * 128 + (nt0 + i) * 16 + fq * 4;
      u32x2 w; w.x = cvt_pk_bf16(af[i][0], af[i][1]); w.y = cvt_pk_bf16(af[i][2], af[i][3]);
      *(u32x2*)(df + off) = w;
      w.x = cvt_pk_bf16(ab[i][0], ab[i][1]); w.y = cvt_pk_bf16(ab[i][2], ab[i][3]);
      *(u32x2*)(db + off) = w;
    }
  }
  __syncthreads();
}

__device__ __forceinline__ void ret_out_item(const Params& p, int cc, int h, int half, bool do_store) {
  unsigned char* ws = p.ws;
  int tid = threadIdx.x;
  asm volatile("" : "+v"(tid));
  const int wid = tid >> 6, lane = tid & 63, fr = lane & 15, fq = lane >> 4;
  bf16_t* Q = (bf16_t*)(ws + OFF_Q);
  const bf16_t* Kb = (const bf16_t*)(ws + OFF_K);
  const bf16_t* VT = (const bf16_t*)(ws + OFF_VT);
  const bf16_t* SR = (const bf16_t*)(ws + OFF_SR);
  const float lgf = -log1pf(__expf(-p.ret_decay_logit[h])) * 1.4426950408889634f;
  const float lgb = -log1pf(__expf(-p.ret_decay_logit[16 + h])) * 1.4426950408889634f;
  const int i0 = half * 128 + wid * 16, il = i0 + fr;
  const size_t grow = (size_t)cc * CH + il;
  bf16x8 qf[4];
#pragma unroll
  for (int kk = 0; kk < 4; ++kk) qf[kk] = *(const bf16x8*)(Q + grow * 2048 + h * 128 + kk * 32 + fq * 8);
  bf16_t* Hf = (bf16_t*)smem;
  bf16_t* Hb = (bf16_t*)(smem + 34816);
  __syncthreads();
  {
    u32x4 hv[8];
#pragma unroll
    for (int i = 0; i < 8; ++i) {
      const int idx = tid + i * NTH, dir = idx >> 11, rr = (idx >> 4) & 127, chn = idx & 15;
      hv[i] = *(const u32x4*)(SR + ((size_t)(cc * 2 + dir) * 16 + h) * 16384 + rr * 128 + chn * 8);
    }
#pragma unroll
    for (int i = 0; i < 8; ++i) {
      const int idx = tid + i * NTH, dir = idx >> 11, rr = (idx >> 4) & 127, chn = idx & 15;
      *(u32x4*)((dir ? Hb : Hf) + rr * 136 + chn * 8) = hv[i];
    }
  }
  __syncthreads();

  f32x4 Y[8];
  {
    const float ai = exp2f((float)(il + 1) * lgf), bi = exp2f((float)(256 - il) * lgb);
#pragma unroll
    for (int pt = 0; pt < 8; ++pt) {
      f32x4 a = {0.f, 0.f, 0.f, 0.f}, b = {0.f, 0.f, 0.f, 0.f};
#pragma unroll
      for (int kk = 0; kk < 4; ++kk) {
        const bf16x8 hf = *(const bf16x8*)(Hf + (pt * 16 + fr) * 136 + kk * 32 + fq * 8);
        const bf16x8 hb = *(const bf16x8*)(Hb + (pt * 16 + fr) * 136 + kk * 32 + fq * 8);
        a = MFMA(hf, qf[kk], a);
        b = MFMA(hb, qf[kk], b);
      }
      Y[pt] = a * ai + b * bi;
      __builtin_amdgcn_sched_barrier(0);
    }
  }
  __syncthreads();
  bf16_t* Ki = (bf16_t*)smem;
  bf16_t* Vt = (bf16_t*)(smem + 69632);
  {
    u32x4 kreg[8], vreg[8];
#pragma unroll
    for (int i = 0; i < 8; ++i) {
      const int idx = tid + i * NTH;
      kreg[i] = *(const u32x4*)(Kb + (size_t)(cc * CH + (idx >> 4)) * 2048 + h * 128 + (idx & 15) * 8);
      vreg[i] = *(const u32x4*)(VT + (size_t)(h * 128 + (idx >> 5)) * R + cc * CH + (idx & 31) * 8);
    }
#pragma unroll
    for (int i = 0; i < 8; ++i) {
      const int idx = tid + i * NTH;
      *(u32x4*)(Ki + (idx >> 4) * 136 + (idx & 15) * 8) = kreg[i];
    }
#pragma unroll
    for (int i = 0; i < 8; ++i) {
      const int idx = tid + i * NTH;
      *(u32x4*)(Vt + (idx >> 5) * 264 + (idx & 31) * 8) = vreg[i];
    }
  }
  __syncthreads();
  bf16x8 pf[8];
#pragma unroll
  for (int k2 = 0; k2 < 8; ++k2) {
    u32x4 pk;
#pragma unroll
    for (int s = 0; s < 2; ++s) {
      const int jt = k2 * 2 + s;
      f32x4 sacc = {0.f, 0.f, 0.f, 0.f};
#pragma unroll
      for (int kk = 0; kk < 4; ++kk) {
        const bf16x8 kf = *(const bf16x8*)(Ki + (jt * 16 + fr) * 136 + kk * 32 + fq * 8);
        sacc = MFMA(kf, qf[kk], sacc);
      }
      float w[4];
#pragma unroll
      for (int e = 0; e < 4; ++e) {
        const int dl = il - (jt * 16 + fq * 4 + e);
        w[e] = sacc[e] * __builtin_amdgcn_exp2f(dl >= 0 ? (float)dl * lgf : (float)(-dl) * lgb);
      }
      if (s == 0) { pk.x = cvt_pk_bf16(w[0], w[1]); pk.y = cvt_pk_bf16(w[2], w[3]); }
      else { pk.z = cvt_pk_bf16(w[0], w[1]); pk.w = cvt_pk_bf16(w[2], w[3]); }
    }
    pf[k2] = as_bf16x8(pk);
    __builtin_amdgcn_sched_barrier(0);
  }
#pragma unroll
  for (int pt = 0; pt < 8; ++pt) {
#pragma unroll
    for (int k2 = 0; k2 < 8; ++k2) {
      const bf16x4 lo = *(const bf16x4*)(Vt + (pt * 16 + fr) * 264 + k2 * 32 + fq * 4);
      const bf16x4 hi = *(const bf16x4*)(Vt + (pt * 16 + fr) * 264 + k2 * 32 + 16 + fq * 4);
      Y[pt] = MFMA(mk8(lo, hi), pf[k2], Y[pt]);
    }
    __builtin_amdgcn_sched_barrier(0);
  }
  float s1 = 0.f;
#pragma unroll
  for (int pt = 0; pt < 8; ++pt) s1 += (Y[pt][0] + Y[pt][1]) + (Y[pt][2] + Y[pt][3]);
  s1 += __shfl_xor(s1, 16); s1 += __shfl_xor(s1, 32);
  const float mu = s1 * (1.0f / 128.0f);
  float s2 = 0.f;
#pragma unroll
  for (int pt = 0; pt < 8; ++pt) {
#pragma unroll
    for (int e = 0; e < 4; ++e) { const float d = Y[pt][e] - mu; s2 += d * d; }
  }
  s2 += __shfl_xor(s2, 16); s2 += __shfl_xor(s2, 32);
  const float rstd = rsqrtf(s2 * (1.0f / 128.0f) + EPS);
#pragma unroll
  for (int pt = 0; pt < 8; ++pt) {
    const int pc = h * 128 + pt * 16 + fq * 4;
    const f32x4 nw = *(const f32x4*)(p.ret_norm_w + pc);
    u32x2 w;
    w.x = cvt_pk_bf16((Y[pt][0] - mu) * rstd * nw[0], (Y[pt][1] - mu) * rstd * nw[1]);
    w.y = cvt_pk_bf16((Y[pt][2] - mu) * rstd * nw[2], (Y[pt][3] - mu) * rstd * nw[3]);
    if (do_store) *(u32x2*)(Q + grow * 2048 + pc) = w;
  }
  __syncthreads();
}

__device__ __forceinline__ void ssd_out_item(const Params& p, int cc, int g, int half) {
  unsigned char* ws = p.ws;
  int tid = threadIdx.x;
  asm volatile("" : "+v"(tid));
  const int wid = tid >> 6, lane = tid & 63, fr = lane & 15, fq = lane >> 4;
  const bf16_t* Bb = (const bf16_t*)(ws + OFF_B);
  const bf16_t* Cb = (const bf16_t*)(ws + OFF_C);
  const bf16_t* XT = (const bf16_t*)(ws + OFF_XT);
  const bf16_t* SS = (const bf16_t*)(ws + OFF_SS);
  bf16_t* YS = (bf16_t*)(ws + OFF_YS);
  const float* CSF = (const float*)(ws + OFF_CSF); const float* RCSB = (const float*)(ws + OFF_RCSB);
  const float* DTF = (const float*)(ws + OFF_DTF); const float* DTB = (const float*)(ws + OFF_DTB);
  const int i0 = half * 128 + wid * 16, il = i0 + fr;
  const size_t grow = (size_t)cc * CH + il;
  bf16_t* Bi = (bf16_t*)smem;
  bf16_t* Hf = (bf16_t*)(smem + 69632);
  bf16_t* Hb = (bf16_t*)(smem + 87040);
  bf16_t* Xt = (bf16_t*)(smem + 104448);
  float* vcs = (float*)(smem + 138240);
  bf16x8 cf[4];
#pragma unroll
  for (int kk = 0; kk < 4; ++kk) cf[kk] = *(const bf16x8*)(Cb + grow * 1024 + g * 128 + kk * 32 + fq * 8);
  __syncthreads();
  {
    u32x4 bv[8];
#pragma unroll
    for (int i = 0; i < 8; ++i) {
      const int idx = tid + i * NTH;
      bv[i] = *(const u32x4*)(Bb + (size_t)(cc * CH + (idx >> 4)) * 1024 + g * 128 + (idx & 15) * 8);
    }
#pragma unroll
    for (int i = 0; i < 8; ++i) {
      const int idx = tid + i * NTH;
      *(u32x4*)(Bi + (idx >> 4) * 136 + (idx & 15) * 8) = bv[i];
    }
  }
  __syncthreads();
  u32x2 S[16];
#pragma unroll
  for (int jt = 0; jt < 16; ++jt) {
    f32x4 sacc = {0.f, 0.f, 0.f, 0.f};
#pragma unroll
    for (int kk = 0; kk < 4; ++kk) {
      const bf16x8 kf = *(const bf16x8*)(Bi + (jt * 16 + fr) * 136 + kk * 32 + fq * 8);
      sacc = MFMA(kf, cf[kk], sacc);
    }
    S[jt].x = cvt_pk_bf16(sacc[0], sacc[1]); S[jt].y = cvt_pk_bf16(sacc[2], sacc[3]);
  }
  __syncthreads();
  u32x2* Sl = (u32x2*)smem + wid * 1024;
#pragma unroll
  for (int jt = 0; jt < 16; ++jt) Sl[jt * 64 + lane] = S[jt];
  u32x4 hreg[4], xreg[4];
  float vr[4] = {0.f, 0.f, 0.f, 0.f};
#define SSD_PREFETCH(HH)                                                                                              \
  do {                                                                                                                \
    const int h_ = g * 8 + (HH);                                                                                      \
    _Pragma("unroll") for (int i = 0; i < 4; ++i) {                                                                   \
      const int idx = tid + i * NTH;                                                                                  \
      hreg[i] = *(const u32x4*)(SS + ((size_t)(cc * 64 + h_) * 2 + (idx >> 10)) * 8192 + ((idx >> 4) & 63) * 128 + (idx & 15) * 8); \
      xreg[i] = *(const u32x4*)(XT + (size_t)(h_ * 64 + (idx >> 5)) * R + cc * CH + (idx & 31) * 8);                  \
    }                                                                                                                 \
    if (tid < 256) {                                                                                                  \
      const size_t rj = (size_t)(cc * CH + tid) * 64 + h_;                                                            \
      vr[0] = CSF[rj]; vr[1] = RCSB[rj]; vr[2] = DTF[rj]; vr[3] = DTB[rj];                                            \
    }                                                                                                                 \
  } while (0)
  SSD_PREFETCH(0);
  for (int hh = 0; hh < 8; ++hh) {
    const int h = g * 8 + hh;
    __syncthreads();
#pragma unroll
    for (int i = 0; i < 4; ++i) {
      const int idx = tid + i * NTH;
      *(u32x4*)(((idx >> 10) ? Hb : Hf) + ((idx >> 4) & 63) * 136 + (idx & 15) * 8) = hreg[i];
      *(u32x4*)(Xt + (idx >> 5) * 264 + (idx & 31) * 8) = xreg[i];
    }
    if (tid < 256) {
      const float c2 = vr[0] * 1.4426950408889634f, r2 = vr[1] * 1.4426950408889634f;
      vcs[tid] = c2; vcs[256 + tid] = r2;
      vcs[512 + tid] = c2 - __log2f(vr[2]); vcs[768 + tid] = r2 - __log2f(vr[3]);
    }
    __syncthreads();
    if (hh < 7) SSD_PREFETCH(hh + 1);
    int ilv = il;
    asm volatile("" : "+v"(ilv));
    const float csi = vcs[il], rcsi = vcs[256 + il];
    f32x4 Y[4];
    {
      const float ai = exp2f(csi), bi = exp2f(rcsi);
#pragma unroll
      for (int pt = 0; pt < 4; ++pt) {
        f32x4 a = {0.f, 0.f, 0.f, 0.f}, b = {0.f, 0.f, 0.f, 0.f};
#pragma unroll
        for (int kk = 0; kk < 4; ++kk) {
          const bf16x8 hf = *(const bf16x8*)(Hf + (pt * 16 + fr) * 136 + kk * 32 + fq * 8);
          const bf16x8 hb = *(const bf16x8*)(Hb + (pt * 16 + fr) * 136 + kk * 32 + fq * 8);
          a = MFMA(hf, cf[kk], a);
          b = MFMA(hb, cf[kk], b);
        }
        Y[pt] = a * ai + b * bi;
        __builtin_amdgcn_sched_barrier(0);
      }
    }
#pragma unroll 1
    for (int k2 = 0; k2 < 8; ++k2) {
      u32x4 pk;
#pragma unroll
      for (int s = 0; s < 2; ++s) {
        const int jt = k2 * 2 + s, jb = jt * 16 + fq * 4;
        const u32x2 sp = Sl[jt * 64 + lane];
        float w[4];
        const float sv[4] = {bflo(sp.x), bfhi(sp.x), bflo(sp.y), bfhi(sp.y)};
        const int dtile = __builtin_amdgcn_readfirstlane(half * 8 + wid);
        if (jt < dtile) {
          const f32x4 af = *(const f32x4*)(vcs + 512 + jb);
#pragma unroll
          for (int e = 0; e < 4; ++e) w[e] = sv[e] * __builtin_amdgcn_exp2f(csi - af[e]);
        } else if (jt > dtile) {
          const f32x4 ab = *(const f32x4*)(vcs + 768 + jb);
#pragma unroll
          for (int e = 0; e < 4; ++e) w[e] = sv[e] * __builtin_amdgcn_exp2f(rcsi - ab[e]);
        } else {
          const f32x4 af = *(const f32x4*)(vcs + 512 + jb), ab = *(const f32x4*)(vcs + 768 + jb);
#pragma unroll
          for (int e = 0; e < 4; ++e) w[e] = sv[e] * __builtin_amdgcn_exp2f(((jb + e) <= ilv) ? (csi - af[e]) : (rcsi - ab[e]));
        }
        if (s == 0) { pk.x = cvt_pk_bf16(w[0], w[1]); pk.y = cvt_pk_bf16(w[2], w[3]); }
        else { pk.z = cvt_pk_bf16(w[0], w[1]); pk.w = cvt_pk_bf16(w[2], w[3]); }
      }
      const bf16x8 pfr = as_bf16x8(pk);
#pragma unroll
      for (int pt = 0; pt < 4; ++pt) {
        const bf16x4 lo = *(const bf16x4*)(Xt + (pt * 16 + fr) * 264 + k2 * 32 + fq * 4);
        const bf16x4 hi = *(const bf16x4*)(Xt + (pt * 16 + fr) * 264 + k2 * 32 + 16 + fq * 4);
        Y[pt] = MFMA(mk8(lo, hi), pfr, Y[pt]);
      }
      __builtin_amdgcn_sched_barrier(0);
    }
    const float dsk = p.ssd_d[h];
#pragma unroll
    for (int pt = 0; pt < 4; ++pt) {
      float o[4];
#pragma unroll
      for (int e = 0; e < 4; ++e) o[e] = Y[pt][e] + bf2f(Xt[(pt * 16 + fq * 4 + e) * 264 + il]) * dsk;
      u32x2 w; w.x = cvt_pk_bf16(o[0], o[1]); w.y = cvt_pk_bf16(o[2], o[3]);
      *(u32x2*)(YS + ((size_t)(cc - 1) * CH + il) * 4096 + h * 64 + pt * 16 + fq * 4) = w;
    }
  }
  __syncthreads();
}

#ifdef PROBE_AFTER
__device__ void probe_dump(const Params& p, size_t lo0, size_t hi0, size_t lo1, size_t hi1) {
  float* outp = (float*)p.out;
  const size_t n = (size_t)SEQ * DM;
  const bf16_t* b0 = (const bf16_t*)(p.ws + lo0); const size_t n0 = (hi0 - lo0) / 2;
  const bf16_t* b1 = (const bf16_t*)(p.ws + lo1); const size_t n1 = (hi1 - lo1) / 2;
  const size_t k0 = (n0 + n - 1) / n, k1 = n1 ? (n1 + n - 1) / n : 0;
  for (size_t i = (size_t)blockIdx.x * NTH + threadIdx.x; i < n; i += (size_t)gridDim.x * NTH) {
    float a = 0.f;
    for (size_t k = 0; k < k0; ++k) { const size_t j = i + k * n; if (j < n0) { float v = bf2f(b0[j]); if (!(fabsf(v) < 1e30f)) v = 777.f; a += v; } }
    for (size_t k = 0; k < k1; ++k) { const size_t j = i + k * n; if (j < n1) { float v = bf2f(b1[j]); if (!(fabsf(v) < 1e30f)) v = 777.f; a += v; } }
    outp[i] = a;
  }
}
#define PROBE_POINT(idx, lo0, hi0, lo1, hi1) if (PROBE_AFTER == (idx)) { probe_dump(p, lo0, hi0, lo1, hi1); return; }
#else
#define PROBE_POINT(idx, lo0, hi0, lo1, hi1)
#endif

#define XB_TMO      128
#define XB_XCNT(j)  (256  + 64 * (j))
#define XB_XSUB(j)  (1280 + 64 * (j))
#define XB_XGEN(j)  (2304 + 64 * (j))
#define XB_TOP      3328
#define XB_TOPGEN   3392
#define XCD_BAR_WORDS 3456
#define XB_SPIN_CAP (1u << 18)
#define LAS __attribute__((address_space(3)))
__device__ __forceinline__ unsigned xb_ld(unsigned* p)              { return __hip_atomic_load(p, __ATOMIC_RELAXED, __HIP_MEMORY_SCOPE_AGENT); }
__device__ __forceinline__ unsigned xb_add(unsigned* p, unsigned v) { return __hip_atomic_fetch_add(p, v, __ATOMIC_RELAXED, __HIP_MEMORY_SCOPE_AGENT); }
__device__ __forceinline__ unsigned xb_xcc_id() { return (unsigned)__builtin_amdgcn_s_getreg((3 << 11) | 20) & 0xFu; }
#define XB_SPIN(cond, bar) do { unsigned _sp = 0; while (cond) { __builtin_amdgcn_s_sleep(1); \
    if ((++_sp & 255u) == 0u) { if (xb_ld(&(bar)[XB_TMO])) break; if (_sp > XB_SPIN_CAP) { atomicAdd(&(bar)[XB_TMO], 1u); break; } } } } while (0)
struct XcdBarrier { unsigned* bar; unsigned x; volatile LAS unsigned* st; };
__device__ __forceinline__ XcdBarrier xcd_barrier_post(unsigned* bar, volatile LAS unsigned* st) {
  XcdBarrier b; b.bar = bar; b.x = xb_xcc_id(); b.st = st;
  if (threadIdx.x == 0) (void)xb_add(&bar[XB_XCNT(b.x)], 1u);
  return b;
}
__device__ __forceinline__ void xcd_barrier_complete(unsigned* bar, unsigned x, unsigned& nloc, unsigned& nx) {
  const unsigned G = gridDim.x * gridDim.y * gridDim.z;
  unsigned sum, cnt, mine, sp = 0u;
  for (;;) {
    sum = 0u; cnt = 0u; mine = 0u;
#pragma unroll
    for (unsigned j = 0; j < 16; ++j) { const unsigned c = xb_ld(&bar[XB_XCNT(j)]); sum += c; cnt += (c > 0u) ? 1u : 0u; mine = (j == x) ? c : mine; }
    if (sum == G) break;
    __builtin_amdgcn_s_sleep(1);
    if ((++sp & 255u) == 0u) { if (xb_ld(&bar[XB_TMO])) break; if (sp > XB_SPIN_CAP) { atomicAdd(&bar[XB_TMO], 1u); break; } }
  }
  nloc = mine > 0u ? mine : 1u; nx = cnt > 0u ? cnt : 1u;
}
__device__ __forceinline__ void xcd_barrier(const XcdBarrier& b) {
  asm volatile("s_waitcnt vmcnt(0)" ::: "memory");
  __syncthreads();
  if (threadIdx.x == 0) {
    unsigned* bar = b.bar;
    __builtin_amdgcn_s_waitcnt(0);
    unsigned nloc = b.st[0], nx = b.st[1];
    if (nloc == 0u) { xcd_barrier_complete(bar, b.x, nloc, nx); b.st[0] = nloc; b.st[1] = nx; }
    const unsigned old = xb_add(&bar[XB_XSUB(b.x)], 1u);
    const unsigned gen = old / nloc;
    if (old + 1u == (gen + 1u) * nloc) {
      __builtin_amdgcn_fence(__ATOMIC_RELEASE, "agent");
      asm volatile("s_waitcnt vmcnt(0)" ::: "memory");
      const unsigned og = xb_add(&bar[XB_TOP], 1u);
      const unsigned tg = og / nx;
      if (og + 1u == (tg + 1u) * nx) xb_add(&bar[XB_TOPGEN], 1u);
      else XB_SPIN(xb_ld(&bar[XB_TOPGEN]) == tg, bar);
      __builtin_amdgcn_fence(__ATOMIC_ACQUIRE, "agent");
      xb_add(&bar[XB_XGEN(b.x)], 1u);
      asm volatile("s_waitcnt vmcnt(0)" ::: "memory");
    } else {
      XB_SPIN(xb_ld(&bar[XB_XGEN(b.x)]) == gen, bar);
      __builtin_amdgcn_fence(__ATOMIC_ACQUIRE, "agent");
      asm volatile("s_waitcnt vmcnt(0)" ::: "memory");
    }
  }
  __syncthreads();
}

__global__ void __launch_bounds__(NTH) mega(Params p) {
  cg::grid_group grid = cg::this_grid();
  unsigned char* ws = p.ws;
  volatile LAS unsigned* xb_st = (volatile LAS unsigned*)((LAS unsigned char*)smem + (LDS_BYTES - 16));
  if (threadIdx.x == 0) { xb_st[0] = 0u; xb_st[1] = 0u; }
  __syncthreads();
  const XcdBarrier xb = xcd_barrier_post((unsigned*)(ws + OFF_BAR), xb_st);
  const int bid = blockIdx.x, nb = gridDim.x, gnth = nb * NTH;
#define FRESH_TID() int tid = threadIdx.x; asm volatile("" : "+v"(tid)); const int gtid = bid * NTH + tid; (void)gtid;
  float* MOD = (float*)(ws + OFF_MOD);
  float* SUMSQ = (float*)(ws + OFF_SUMSQ);
  float* ROPE = (float*)(ws + OFF_ROPE);
  bf16_t* U = (bf16_t*)(p.out + OOFF_U);
  bf16_t* WBT = (bf16_t*)(p.out + OOFF_WB);
  bf16_t* WA1 = (bf16_t*)(ws + OFF_WA);
  bf16_t* WA2 = WA1 + (size_t)6400 * 2048;

#if (PHASE_MASK >> 0) & 1
  {
  FRESH_TID();
  for (int u = bid; u < 192; u += nb) {
    const int ks = u / 24, j = (u % 24) * NTH + tid;
    float* sc = (float*)smem;
    __syncthreads();
    if (tid < 256) { sc[tid] = siluf_(p.c[ks * 256 + tid]); sc[256 + tid] = siluf_(p.c_ctx[ks * 256 + tid]); }
    __syncthreads();
    float a0 = 0.f, a1 = 0.f;
    for (int k0 = 0; k0 < 256; k0 += 16) {
      float w[16];
#pragma unroll
      for (int e = 0; e < 16; ++e) w[e] = p.w_mod[(size_t)(ks * 256 + k0 + e) * 12288 + j];
#pragma unroll
      for (int e = 0; e < 16; ++e) { a0 += sc[k0 + e] * w[e]; a1 += sc[256 + k0 + e] * w[e]; }
    }
    if (ks == 0) { const float b = p.b_mod[j]; a0 += b; a1 += b; }
    atomicAdd(MOD + j, a0);
    atomicAdd(MOD + 12288 + j, a1);
  }
  __syncthreads();
  for (int i = gtid; i < 256 * 32; i += gnth) {
    const int pos = i >> 5, d = i & 31;
    const float freq = exp2f(-(float)d * (13.287712379549449f / 32.0f));
    const float rev = (float)pos * freq * 0.15915494309189535f;
    const float fr_ = rev - floorf(rev);
    ROPE[i * 2 + 0] = __builtin_amdgcn_cosf(fr_);
    ROPE[i * 2 + 1] = __builtin_amdgcn_sinf(fr_);
  }
  convert_segment(p.w_in, INC, 0, 2048, 2048, WA1, true);
  convert_segment(p.w_in, INC, 2048, 2048, 2048, WA1 + (size_t)2048 * 2048, true);
  convert_segment(p.w_in, INC, 16384, 2048, 2048, WA1 + (size_t)4096 * 2048, false);
  convert_segment(p.w_in, INC, 18432, 128, 2048, WA1 + (size_t)6144 * 2048, false);
  convert_segment(p.w_in, INC, 4096, 2048, 2048, WA2, false);
  convert_segment(p.w_in, INC, 12288, 4096, 2048, WA2 + (size_t)2048 * 2048, false);
  }
#endif
  if (p.ws == nullptr) grid.sync();
  xcd_barrier(xb);

#if (PHASE_MASK >> 1) & 1
  for (int rep_ = 0; rep_ < 1 + ((DUP_MASK >> 1) & 1); ++rep_) {
  modnorm_rows(p.ctx, CTX, p.x, SEQ, p.norm1_w, MOD + 12288 + 2048, MOD + 12288, MOD + 2048, MOD, U);
  }
#endif
  xcd_barrier(xb);

#if (PHASE_MASK >> 2) & 1
  for (int rep_ = 0; rep_ < 1 + ((DUP_MASK >> 2) & 1); ++rep_) {
  {
    EpiA1 e1{(bf16_t*)(ws + OFF_Q), (bf16_t*)(ws + OFF_K), (bf16_t*)(ws + OFF_BCRAW), (float*)(ws + OFF_DTRAW), ROPE};
    EpiA2 e2{(bf16_t*)(ws + OFF_VT), (bf16_t*)(ws + OFF_XTRAW)};
    const int n1 = 65 * 25, n2 = 24 * 65;
    for (int L = bid; L < n1 + n2; L += nb) {
      int pm, pn;
      if (L < n2) { unit_map(L, 24, 65, pm, pn); gemm_unit(WA2, 2048, U, 2048, 2048, pm, pn, e2); }
      else { unit_map(L - n2, 65, 25, pm, pn); gemm_unit(U, 2048, WA1, 2048, 2048, pm, pn, e1); }
    }
    {
      int tid = threadIdx.x;
      asm volatile("" : "+v"(tid));
      unsigned* qhead = (unsigned*)(ws + OFF_BAR) + 3520;
      volatile unsigned* bc = (volatile unsigned*)(smem + 66560);
      for (;;) {
        __syncthreads();
        if (tid == 0) *bc = atomicAdd(qhead, 1u);
        __syncthreads();
        const int t = (int)*bc;
        if (t >= 2304) break;
        if (t < 256) convert_tile(p.w_in, INC, 6144, 2048, WBT, t >> 5, t & 31, tid);
        else if (t < 768) convert_tile(p.w_in, INC, 8192, 2048, WBT + (size_t)2048 * 2048, (t - 256) >> 5, (t - 256) & 31, tid);
        else if (t < 1280) convert_tile(p.w_in, INC, 18560, 2048, WBT + (size_t)6144 * 2048, (t - 768) >> 5, (t - 768) & 31, tid);
        else if (t < 1536) convert_tile(p.w_ret_out, 2048, 0, 2048, (bf16_t*)(ws + OFF_WRO), (t - 1280) >> 5, (t - 1280) & 31, tid);
        else if (t < 2048) convert_tile(p.w_ssd_out, 2048, 0, 4096, (bf16_t*)(ws + OFF_WSO), (t - 1536) >> 6, (t - 1536) & 63, tid);
        else convert_tile(p.w_o, 2048, 0, 2048, (bf16_t*)(ws + OFF_WO), (t - 2048) >> 5, (t - 2048) & 31, tid);
      }
      __syncthreads();
    }
  }
  }
#endif
  xcd_barrier(xb);
  PROBE_POINT(2, OFF_Q, OFF_XT, OFF_SR, OFF_WA)

#if (PHASE_MASK >> 3) & 1
  for (int rep_ = 0; rep_ < 1 + ((DUP_MASK >> 3) & 1); ++rep_) {
  {
  FRESH_TID();
  {
    float* DTRAW = (float*)(ws + OFF_DTRAW);
    float* DTF = (float*)(ws + OFF_DTF); float* DTB = (float*)(ws + OFF_DTB);
    float* CSF = (float*)(ws + OFF_CSF); float* RCSB = (float*)(ws + OFF_RCSB);
    if ((tid >> 6) == 0) {
      for (int w = bid; w < NCH * 2; w += nb) {
        const int c = w >> 1, dir = w & 1, h = tid & 63;
        const float bias = p.ssd_dt_bias[dir * 64 + h], a = -__expf(p.ssd_a_log[dir * 64 + h]);
        float* __restrict__ DTO = dir ? DTB : DTF;
        float* __restrict__ CSO = dir ? RCSB : CSF;
        float cs = 0.f;
        for (int jb = 0; jb < CH; jb += 16) {
          float raw[16];
#pragma unroll
          for (int e = 0; e < 16; ++e) {
            const int j = dir ? (CH - 1 - jb - e) : (jb + e);
            raw[e] = DTRAW[((size_t)c * CH + j) * 128 + dir * 64 + h];
          }
#pragma unroll
          for (int e = 0; e < 16; ++e) {
            const int j = dir ? (CH - 1 - jb - e) : (jb + e);
            const size_t r = (size_t)c * CH + j;
            const float dt = softplusf_(raw[e] + bias);
            cs += dt * a;
            DTO[r * 64 + h] = dt; CSO[r * 64 + h] = cs;
          }
        }
      }
    }
    const bf16_t* __restrict__ BCRAW = (const bf16_t*)(ws + OFF_BCRAW);
    bf16_t* __restrict__ Bb = (bf16_t*)(ws + OFF_B); bf16_t* __restrict__ Cb = (bf16_t*)(ws + OFF_C);
#pragma unroll 2
    for (int i = gtid; i < R * 256; i += gnth) {
      const int r = i >> 8, c8 = (i & 255) * 8;
      const int s0 = r < CTX ? 0 : CTX, s1 = r < CTX ? CTX : R;
      bf16x8 xv[5];
      float msk[5];
#pragma unroll
      for (int j = 0; j < 5; ++j) {
        const int rr = r + j - 2;
        const bool ok = rr >= s0 && rr < s1;
        msk[j] = ok ? 1.f : 0.f;
        xv[j] = *(const bf16x8*)(BCRAW + (size_t)(ok ? rr : r) * 2048 + c8);
      }
      const float* cwp = p.conv_w + 4096 + c8;
      const f32x4 b0 = *(const f32x4*)(p.conv_b + 4096 + c8), b1 = *(const f32x4*)(p.conv_b + 4096 + c8 + 4);
      float a[8] = {b0[0], b0[1], b0[2], b0[3], b1[0], b1[1], b1[2], b1[3]};
#pragma unroll
      for (int j = 0; j < 5; ++j) {
        const f32x4 w0 = *(const f32x4*)(cwp + (size_t)j * 6144) * msk[j], w1 = *(const f32x4*)(cwp + (size_t)j * 6144 + 4) * msk[j];
#pragma unroll
        for (int e = 0; e < 4; ++e) { a[e] += bf2f((unsigned short)xv[j][e]) * w0[e]; a[4 + e] += bf2f((unsigned short)xv[j][4 + e]) * w1[e]; }
      }
      u32x4 w;
      w.x = cvt_pk_bf16(siluf_(a[0]), siluf_(a[1])); w.y = cvt_pk_bf16(siluf_(a[2]), siluf_(a[3]));
      w.z = cvt_pk_bf16(siluf_(a[4]), siluf_(a[5])); w.w = cvt_pk_bf16(siluf_(a[6]), siluf_(a[7]));
      bf16_t* dst = c8 < 1024 ? Bb + (size_t)r * 1024 + c8 : Cb + (size_t)r * 1024 + (c8 - 1024);
      *(u32x4*)dst = w;
    }
    const bf16_t* __restrict__ XTRAW = (const bf16_t*)(ws + OFF_XTRAW);
    bf16_t* __restrict__ XT = (bf16_t*)(ws + OFF_XT);
#pragma unroll 2
    for (int i = gtid; i < 4096 * (R / 16); i += gnth) {
      const int ch = i / (R / 16), t16 = (i % (R / 16)) * 16;
      const int s0 = t16 < CTX ? 0 : CTX, s1 = t16 < CTX ? CTX : R;
      const bf16_t* src = XTRAW + (size_t)ch * R;
      const bool okp = t16 - 8 >= s0, okn = t16 + 16 < s1;
      const bf16x8 vp = *(const bf16x8*)(src + (okp ? t16 - 8 : t16));
      const bf16x8 v0 = *(const bf16x8*)(src + t16);
      const bf16x8 v1 = *(const bf16x8*)(src + t16 + 8);
      const bf16x8 vn = *(const bf16x8*)(src + (okn ? t16 + 16 : t16));
      float x[20];
      x[0] = okp ? bf2f((unsigned short)vp[6]) : 0.f;
      x[1] = okp ? bf2f((unsigned short)vp[7]) : 0.f;
#pragma unroll
      for (int e = 0; e < 8; ++e) { x[2 + e] = bf2f((unsigned short)v0[e]); x[10 + e] = bf2f((unsigned short)v1[e]); }
      x[18] = okn ? bf2f((unsigned short)vn[0]) : 0.f;
      x[19] = okn ? bf2f((unsigned short)vn[1]) : 0.f;
      float wj[5];
#pragma unroll
      for (int j = 0; j < 5; ++j) wj[j] = p.conv_w[(size_t)j * 6144 + ch];
      const float cb = p.conv_b[ch];
      float o[16];
#pragma unroll
      for (int e = 0; e < 16; ++e) {
        float a = cb;
#pragma unroll
        for (int j = 0; j < 5; ++j) a += x[e + j] * wj[j];
        o[e] = siluf_(a);
      }
      u32x4 w;
      w.x = cvt_pk_bf16(o[0], o[1]); w.y = cvt_pk_bf16(o[2], o[3]); w.z = cvt_pk_bf16(o[4], o[5]); w.w = cvt_pk_bf16(o[6], o[7]);
      *(u32x4*)(XT + (size_t)ch * R + t16) = w;
      w.x = cvt_pk_bf16(o[8], o[9]); w.y = cvt_pk_bf16(o[10], o[11]); w.z = cvt_pk_bf16(o[12], o[13]); w.w = cvt_pk_bf16(o[14], o[15]);
      *(u32x4*)(XT + (size_t)ch * R + t16 + 8) = w;
    }
  }
  }
  }
#endif
  xcd_barrier(xb);
  PROBE_POINT(3, OFF_XT, OFF_DTRAW, OFF_DTF, OFF_SR)

#if (PHASE_MASK >> 4) & 1
  for (int rep_ = 0; rep_ < 1 + ((DUP_MASK >> 4) & 1); ++rep_) {
  for (int it = bid; it < NCH * 24; it += nb) {
    if (it < NCH * 8) state_build_item<1>(p, it >> 3, it & 7);
    else { const int r = it - NCH * 8; state_build_item<0>(p, r >> 4, r & 15); }
  }
  }
#endif
  xcd_barrier(xb);
  PROBE_POINT(4, OFF_SR, OFF_WA, 0, 0)

#if (PHASE_MASK >> 5) & 1
  for (int rep_ = 0; rep_ < 1 + ((DUP_MASK >> 5) & 1); ++rep_) {
  {
  FRESH_TID();
  {
    bf16_t* SR = (bf16_t*)(ws + OFF_SR);
    bf16_t* SS = (bf16_t*)(ws + OFF_SS);
    const float* CSF = (const float*)(ws + OFF_CSF); const float* RCSB = (const float*)(ws + OFF_RCSB);
    for (int i = gtid; i < 65536 + 131072; i += gnth) {
      bf16_t* base; size_t cstride; int dir, h; bool isr = i < 65536;
      if (isr) { const int e = i * 8; dir = e / (16 * 16384); h = (e / 16384) & 15; base = SR + e; cstride = 524288; }
      else { const int e = (i - 65536) * 8; h = e / 16384; dir = (e / 8192) & 1; base = SS + e; cstride = 1048576; }
      float decr = 0.f;
      if (isr) { const float lg = -log1pf(__expf(-p.ret_decay_logit[dir * 16 + h])); decr = __expf(256.0f * lg); }
      float H[8];
#pragma unroll
      for (int e = 0; e < 8; ++e) H[e] = 0.f;
      u32x4 q[4]; float dq[4];
#pragma unroll
      for (int k = 0; k < 4; ++k) {
        const int c = dir == 0 ? k : (k == 0 ? 0 : NCH - k);
        q[k] = *(const u32x4*)(base + (size_t)c * cstride);
        dq[k] = isr ? 0.f : (dir == 0 ? CSF[((size_t)c * CH + 255) * 64 + h] : RCSB[((size_t)c * CH) * 64 + h]);
      }
      for (int s0 = 0; s0 < NCH; s0 += 4) {
#pragma unroll
        for (int k = 0; k < 4; ++k) {
          const int s = s0 + k;
          if (s < NCH) {
            const int c = dir == 0 ? s : (s == 0 ? 0 : NCH - s);
            bf16_t* ptr = base + (size_t)c * cstride;
            const u32x4 tv = q[k];
            const float dl = dq[k];
            if (s + 4 < NCH) {
              const int cn = dir == 0 ? s + 4 : NCH - (s + 4);
              q[k] = *(const u32x4*)(base + (size_t)cn * cstride);
              dq[k] = isr ? 0.f : (dir == 0 ? CSF[((size_t)cn * CH + 255) * 64 + h] : RCSB[((size_t)cn * CH) * 64 + h]);
            }
            u32x4 hv;
            hv.x = cvt_pk_bf16(H[0], H[1]); hv.y = cvt_pk_bf16(H[2], H[3]); hv.z = cvt_pk_bf16(H[4], H[5]); hv.w = cvt_pk_bf16(H[6], H[7]);
            if (rep_ == ((DUP_MASK >> 5) & 1) || p.ws == nullptr) *(u32x4*)ptr = hv;
            const float dec = isr ? decr : __expf(dl);
            H[0] = dec * H[0] + bflo(tv.x); H[1] = dec * H[1] + bfhi(tv.x);
            H[2] = dec * H[2] + bflo(tv.y); H[3] = dec * H[3] + bfhi(tv.y);
            H[4] = dec * H[4] + bflo(tv.z); H[5] = dec * H[5] + bfhi(tv.z);
            H[6] = dec * H[6] + bflo(tv.w); H[7] = dec * H[7] + bfhi(tv.w);
          }
        }
      }
    }
  }
  }
  }
#endif
  xcd_barrier(xb);
  PROBE_POINT(5, OFF_SR, OFF_WA, 0, 0)

#if (PHASE_MASK >> 6) & 1
  for (int rep_ = 0; rep_ < 1 + ((DUP_MASK >> 6) & 1); ++rep_) {
  for (int it = bid; it < 64 * 16 * 2; it += nb) {
    const int half = (it >> 3) & 1, q = ((it >> 4) << 3) | (it & 7), h = q & 15, cc = 1 + (q >> 4);
    ret_out_item(p, cc, h, half, rep_ == ((DUP_MASK >> 6) & 1) || p.ws == nullptr);
  }
  }
#endif
  xcd_barrier(xb);
  PROBE_POINT(6, OFF_Q, OFF_K, 0, 0)

#if (PHASE_MASK >> 7) & 1
  for (int rep_ = 0; rep_ < 1 + ((DUP_MASK >> 7) & 1); ++rep_) {
  for (int ph = 0; ph < 2; ++ph) {
    if ((ph == 0) == ((bid & 1) != 0)) {
      convert_segment(p.w_mlp1, DFF, 0, DFF, 2048, (bf16_t*)(ws + OFF_W1T), false, MOD + 6144, (float*)(ws + OFF_BIAS1));
      convert_segment(p.w_mlp2, 2048, 0, 2048, DFF, (bf16_t*)(ws + OFF_W2T), false);
    }
    if (ph == 0) {
      for (int it = bid; it < 64 * 8 * 2; it += nb) {
        const int half = (it >> 3) & 1, q = ((it >> 4) << 3) | (it & 7), g = q & 7, cc = 1 + (q >> 3);
        ssd_out_item(p, cc, g, half);
      }
    }
  }
  }
#endif
  xcd_barrier(xb);
  PROBE_POINT(7, OFF_YS, OFF_XT, OFF_SR, OFF_SS)

#if (PHASE_MASK >> 8) & 1
  for (int rep_ = 0; rep_ < 1 + ((DUP_MASK >> 8) & 1); ++rep_) {
  {
    EpiB e{(bf16_t*)(ws + OFF_Q), (bf16_t*)(ws + OFF_YS), (bf16_t*)(ws + OFF_G), p.ssd_norm_w, SUMSQ};
    for (int L = bid; L < 64 * 40; L += nb) {
      int pm, pn; unit_map(L, 64, 40, pm, pn);
      gemm_unit(U + (size_t)CTX * 2048, 2048, WBT, 2048, 2048, pm, pn, e);
    }
  }
  }
#endif
  xcd_barrier(xb);
  PROBE_POINT(8, OFF_Q, OFF_B, 0, 0)

#if (PHASE_MASK >> 9) & 1
  for (int rep_ = 0; rep_ < 1 + ((DUP_MASK >> 9) & 1); ++rep_) {
  {
    EpiO1a ea{(const bf16_t*)(ws + OFF_G), (bf16_t*)(ws + OFF_M)};
    EpiO1b eb{(const bf16_t*)(ws + OFF_G), SUMSQ, (bf16_t*)(ws + OFF_M)};
    for (int L = bid; L < 64 * 8; L += nb) {
      int pm, pn; unit_map(L, 64, 8, pm, pn);
      gemm_unit((const bf16_t*)(ws + OFF_Q) + (size_t)CTX * 2048, 2048, (const bf16_t*)(ws + OFF_WRO), 2048, 2048, pm, pn, ea);
      gemm_unit((const bf16_t*)(ws + OFF_YS), 4096, (const bf16_t*)(ws + OFF_WSO), 4096, 4096, pm, pn, eb);
    }
  }
  }
#endif
  xcd_barrier(xb);
  PROBE_POINT(9, OFF_M, OFF_DTRAW, 0, 0)

#if (PHASE_MASK >> 10) & 1
  for (int rep_ = 0; rep_ < 1 + ((DUP_MASK >> 10) & 1); ++rep_) {
  {
    EpiRes9 e{p.x, MOD + 4096, (float*)(ws + OFF_H1), p.norm2_w, MOD + 8192, (bf16_t*)(ws + OFF_F), (float*)(ws + OFF_SUMSQ2)};
    for (int L = bid; L < 64 * 8; L += nb) {
      int pm, pn; unit_map(L, 64, 8, pm, pn);
      gemm_unit((const bf16_t*)(ws + OFF_M), 2048, (const bf16_t*)(ws + OFF_WO), 2048, 2048, pm, pn, e);
    }
  }
  }
#endif
  xcd_barrier(xb);
  PROBE_POINT(10, OFF_H1, OFF_H1 + (size_t)SEQ * DM * 4, 0, 0)

#if (PHASE_MASK >> 12) & 1
  for (int rep_ = 0; rep_ < 1 + ((DUP_MASK >> 12) & 1); ++rep_) {
  {
    EpiM1 e{(bf16_t*)(ws + OFF_A1), (const float*)(ws + OFF_SUMSQ2), (const float*)(ws + OFF_BIAS1)};
    for (int L = bid; L < 64 * 32; L += nb) {
      int pm, pn; unit_map(L, 64, 32, pm, pn);
      gemm_unit((const bf16_t*)(ws + OFF_F), 2048, (const bf16_t*)(ws + OFF_W1T), 2048, 2048, pm, pn, e);
    }
  }
  }
#endif
  xcd_barrier(xb);
  PROBE_POINT(12, OFF_A1, OFF_A1 + (size_t)SEQ * DFF * 2, 0, 0)

#if (PHASE_MASK >> 13) & 1
  for (int rep_ = 0; rep_ < 1 + ((DUP_MASK >> 13) & 1); ++rep_) {
  {
    EpiRes e{(const float*)(ws + OFF_H1), MOD + 10240, (float*)(ws + OFF_H1), rep_ == ((DUP_MASK >> 13) & 1) || p.ws == nullptr};
    for (int L = bid; L < 64 * 8; L += nb) {
      int pm, pn; unit_map(L, 64, 8, pm, pn);
      gemm_unit((const bf16_t*)(ws + OFF_A1), DFF, (const bf16_t*)(ws + OFF_W2T), DFF, DFF, pm, pn, e);
    }
  }
  }
#endif
  xcd_barrier(xb);
  PROBE_POINT(13, OFF_H1, OFF_H1 + (size_t)SEQ * DM * 4, 0, 0)

#if (PHASE_MASK >> 14) & 1
  for (int rep_ = 0; rep_ < 1 + ((DUP_MASK >> 14) & 1); ++rep_) {
  {
  FRESH_TID();
  {
    const float* H2 = (const float*)(ws + OFF_H1);
    float* outp = (float*)p.out;
    const int lane = tid & 63, gw = bid * (NTH / 64) + (tid >> 6), nw_ = nb * (NTH / 64);
    for (int r = gw; r < SEQ; r += nw_) {
      f32x4 v[8];
      float ss = 0.f;
#pragma unroll
      for (int i = 0; i < 8; ++i) { v[i] = *(const f32x4*)(H2 + (size_t)r * DM + i * 256 + lane * 4); ss += v[i][0] * v[i][0] + v[i][1] * v[i][1] + v[i][2] * v[i][2] + v[i][3] * v[i][3]; }
      ss = wave_sum(ss);
      const float rs = rsqrtf(ss * (1.0f / DM) + EPS);
#pragma unroll
      for (int i = 0; i < 8; ++i) {
        const f32x4 w = *(const f32x4*)(p.final_norm_w + i * 256 + lane * 4);
        f32x4 o = v[i] * rs * w;
        *(f32x4*)(outp + (size_t)r * DM + i * 256 + lane * 4) = o;
      }
    }
  }
  }
  }
#endif
}

extern "C" void kernel_launch(void* const* d_in, const int* in_sizes, int n_in, void* d_out, int out_size, void* d_ws, size_t ws_size,
                              hipStream_t stream) {
  static int grid_blocks = 0;
  if (!grid_blocks) {
    int dev = 0, cus = 0, per_cu = 0;
    (void)hipGetDevice(&dev);
    (void)hipDeviceGetAttribute(&cus, hipDeviceAttributeMultiprocessorCount, dev);
    (void)hipFuncSetAttribute((const void*)mega, hipFuncAttributeMaxDynamicSharedMemorySize, LDS_BYTES);
    (void)hipOccupancyMaxActiveBlocksPerMultiprocessor(&per_cu, mega, NTH, LDS_BYTES);
    if (per_cu > 1) per_cu = 1;
    grid_blocks = cus * per_cu;
  }
  if (ws_size < WS_NEED || grid_blocks <= 0) { fprintf(stderr, "workspace too small or no occupancy\n"); return; }
  Params p{};
  const float** pp = (const float**)&p;
  for (int i = 0; i < 23; ++i) pp[i] = (const float*)d_in[i];
  p.ws = (unsigned char*)d_ws;
  p.out = (unsigned char*)d_out;
  (void)hipMemsetAsync((unsigned char*)d_ws + OFF_MOD, 0, OFF_ROPE - OFF_MOD, stream);
  void* args[] = {&p};
  hipError_t e = hipLaunchCooperativeKernel((void*)mega, dim3(grid_blocks), dim3(NTH), args, LDS_BYTES, stream);
  if (e != hipSuccess) fprintf(stderr, "cooperative launch failed: %s (grid %d)\n", hipGetErrorString(e), grid_blocks);
}
```

```cpp
#include <hip/hip_runtime.h>
#include <hip/hip_cooperative_groups.h>
#include <cstdio>
#include <cstdint>
namespace cg = cooperative_groups;

typedef unsigned short bf16_t;
typedef short bf16x8 __attribute__((ext_vector_type(8)));
typedef short bf16x4 __attribute__((ext_vector_type(4)));
typedef float f32x4 __attribute__((ext_vector_type(4)));
typedef float f32x2 __attribute__((ext_vector_type(2)));
typedef unsigned u32x4 __attribute__((ext_vector_type(4)));
typedef unsigned u32x2 __attribute__((ext_vector_type(2)));

constexpr int DM = 2048, SEQ = 16384, CTX = 256, R = SEQ + CTX, CH = 256, NCH = 65;
constexpr int INC = 22656, DFF = 8192;
constexpr float EPS = 1e-6f;
constexpr int NTH = 512;
constexpr int LDS_BYTES = 147456;
#ifndef DUP_MASK
#define DUP_MASK 0
#endif
#ifndef PHASE_MASK
#define PHASE_MASK 0x7fff
#endif

constexpr size_t SZQ = (size_t)R * 2048 * 2;
constexpr size_t OFF_Q = 0;
constexpr size_t OFF_K = OFF_Q + SZQ;
constexpr size_t OFF_VT = OFF_K + SZQ;
constexpr size_t OFF_XT = OFF_VT + SZQ;
constexpr size_t OFF_B = OFF_XT + 2 * SZQ;
constexpr size_t OFF_C = OFF_B + SZQ / 2;
constexpr size_t OFF_DTRAW = OFF_C + SZQ / 2;
constexpr size_t SZ_DTA = (size_t)R * 64 * 4;
constexpr size_t OFF_DTF = OFF_DTRAW + (size_t)R * 128 * 4;
constexpr size_t OFF_DTB = OFF_DTF + SZ_DTA;
constexpr size_t OFF_CSF = OFF_DTB + SZ_DTA;
constexpr size_t OFF_RCSB = OFF_CSF + SZ_DTA;
constexpr size_t OFF_SR = OFF_RCSB + SZ_DTA;
constexpr size_t OFF_SS = OFF_SR + SZQ;
constexpr size_t OFF_WA = OFF_SS + 2 * SZQ;
constexpr size_t OFF_WRO = OFF_WA + (size_t)12544 * 2048 * 2;
constexpr size_t OFF_WSO = OFF_WRO + (size_t)2048 * 2048 * 2;
constexpr size_t OFF_WO = OFF_WSO + (size_t)2048 * 4096 * 2;
constexpr size_t OFF_MOD = OFF_WO + (size_t)2048 * 2048 * 2;
constexpr size_t OFF_SUMSQ = OFF_MOD + 2 * 12288 * 4;
constexpr size_t OFF_BAR = OFF_SUMSQ + (size_t)SEQ * 4;
constexpr size_t OFF_SUMSQ2 = OFF_BAR + 16384;
constexpr size_t OFF_BIAS1 = OFF_SUMSQ2 + (size_t)SEQ * 4;
constexpr size_t OFF_ROPE = OFF_BIAS1 + (size_t)DFF * 4;
constexpr size_t WS_NEED = OFF_ROPE + 256 * 32 * 2 * 4;
constexpr size_t OFF_BCRAW = OFF_SR, OFF_XTRAW = OFF_SS, OFF_YS = OFF_K, OFF_W1T = OFF_SR, OFF_W2T = OFF_SR + (size_t)8192 * 2048 * 2;
constexpr size_t OFF_G = OFF_XT, OFF_H1 = OFF_SS, OFF_M = OFF_B, OFF_F = OFF_Q, OFF_A1 = OFF_K;
constexpr size_t OOFF_U = 0, OOFF_WB = SZQ;

struct Params {
  const float *x, *c, *ctx, *c_ctx, *w_mod, *b_mod, *norm1_w, *w_in, *conv_w, *conv_b, *ret_decay_logit, *ret_norm_w, *ssd_a_log,
      *ssd_dt_bias, *ssd_d, *ssd_norm_w, *w_ret_out, *w_ssd_out, *w_o, *norm2_w, *w_mlp1, *w_mlp2, *final_norm_w;
  unsigned char* ws;
  unsigned char* out;
};

extern __shared__ __attribute__((aligned(16))) unsigned char smem[];

typedef __bf16 bf16x2_t __attribute__((ext_vector_type(2)));
__device__ __forceinline__ unsigned cvt_pk_bf16(float lo, float hi) {
  f32x2 v = {lo, hi};
  bf16x2_t b = __builtin_convertvector(v, bf16x2_t);
  return __builtin_bit_cast(unsigned, b);
}
__device__ __forceinline__ float bf2f(unsigned short v) { return __uint_as_float((unsigned)v << 16); }
__device__ __forceinline__ float bflo(unsigned v) { return __uint_as_float(v << 16); }
__device__ __forceinline__ float bfhi(unsigned v) { return __uint_as_float(v & 0xffff0000u); }
__device__ __forceinline__ float sigmoidf_(float x) { return __builtin_amdgcn_rcpf(1.0f + __expf(-x)); }
__device__ __forceinline__ float siluf_(float x) { return x * __builtin_amdgcn_rcpf(1.0f + __expf(-x)); }
__device__ __forceinline__ float softplusf_(float x) { const float e = __expf(x); return x > 20.f ? x : (x < -6.f ? e * (1.0f - 0.5f * e) : __logf(1.0f + e)); }
__device__ __forceinline__ float wave_sum(float v) {
#pragma unroll
  for (int o = 32; o > 0; o >>= 1) v += __shfl_xor(v, o);
  return v;
}
__device__ __forceinline__ bf16x8 mk8(bf16x4 a, bf16x4 b) { return __builtin_shufflevector(a, b, 0, 1, 2, 3, 4, 5, 6, 7); }
__device__ __forceinline__ bf16x8 as_bf16x8(u32x4 v) { union { u32x4 u; bf16x8 b; } x; x.u = v; return x.b; }
__device__ __forceinline__ u32x4 as_u32x4(bf16x8 v) { union { u32x4 u; bf16x8 b; } x; x.b = v; return x.u; }
#define MFMA(a, b, c) __builtin_amdgcn_mfma_f32_16x16x32_bf16((a), (b), (c), 0, 0, 0)

constexpr int BM = 256, BK = 64, HALF = 128, HT = HALF * BK;
__device__ __forceinline__ int lds_byte(int r, int c) {
  int st = (r >> 4) * 2 + (c >> 5), rr = r & 15, cc = c & 31, ob = rr * 64 + cc * 2;
  return st * 1024 + (ob ^ (((ob >> 9) & 1) << 5));
}
__device__ __forceinline__ void stage_rc(int b, int& Rr, int& Cc) {
  int st = b / 1024, sb = b % 1024, swz = sb ^ (((sb >> 9) & 1) << 5);
  Rr = (st >> 1) * 16 + swz / 64;
  Cc = (st & 1) * 32 + (swz % 64) / 2;
}

template <class Epi>
__device__ __forceinline__ void gemm_unit(const bf16_t* __restrict__ A, int lda, const bf16_t* __restrict__ Bt, int ldb, int K, int pm,
                                          int pn, const Epi& epi) {
  typedef __attribute__((address_space(3))) unsigned char lds_u8;
  lds_u8* lds = (lds_u8*)smem;
  int tid = threadIdx.x;
  asm volatile("" : "+v"(tid));
  const int wid = __builtin_amdgcn_readfirstlane(tid >> 6), lane = tid & 63, wr = wid >> 2, wc = wid & 3, fr = lane & 15, fq = lane >> 4;
  unsigned voffA[2], voffB[2];
#pragma unroll
  for (int i = 0; i < 2; ++i) {
    int Rr, Cc; stage_rc(tid * 16 + i * 8192, Rr, Cc);
    const int rho = Rr & 31, Rb = (Rr & ~31) + 8 * ((rho & 15) >> 2) + 4 * (rho >> 4) + (rho & 3);
    voffA[i] = (unsigned)(Rr * lda + Cc) * 2u; voffB[i] = (unsigned)(Rb * ldb + Cc) * 2u;
  }
  const size_t kstep = (size_t)(BK * 2);
  const size_t hstepA = (size_t)HALF * lda * 2, hstepB = (size_t)HALF * ldb * 2;
  const unsigned ldsw = (unsigned)wid * 1024u;
  const int aoff = lds_byte(wr * 64 + fr, fq * 8), boff = lds_byte(wc * 32 + fr, fq * 8);
  constexpr int HTB = HT * 2;
#define SAo(b, h) (((b) * 2 + (h)) * HTB)
#define SBo(b, h) ((4 + (b) * 2 + (h)) * HTB)
#define STAGE(bufoff, gbase, voff) do { _Pragma("unroll") for (int _i = 0; _i < 2; ++_i) \
    __builtin_amdgcn_global_load_lds((const unsigned*)((const char*)(gbase) + (voff)[_i]), (__attribute__((address_space(3))) unsigned*)(lds + (bufoff) + ldsw + _i * 8192), 16, 0, 0); } while (0)
#define LDA(dst, b, h) do { _Pragma("unroll") for (int m = 0; m < 4; ++m) _Pragma("unroll") for (int k = 0; k < 2; ++k) dst[m][k] = *(const __attribute__((address_space(3))) bf16x8*)(lds + SAo(b, h) + aoff + m * 2048 + k * 1024); } while (0)
#define LDB(dst, b, h) do { _Pragma("unroll") for (int n = 0; n < 2; ++n) _Pragma("unroll") for (int k = 0; k < 2; ++k) dst[n][k] = *(const __attribute__((address_space(3))) bf16x8*)(lds + SBo(b, h) + boff + n * 2048 + k * 1024); } while (0)
#define MMA(ai, bj, At_, Bt_) do { __builtin_amdgcn_s_setprio(1); _Pragma("unroll") for (int m = 0; m < 4; ++m) _Pragma("unroll") for (int n = 0; n < 2; ++n) _Pragma("unroll") for (int k = 0; k < 2; ++k) \
    acc[ai][bj][m][n] = MFMA(Bt_[n][k], At_[m][k], acc[ai][bj][m][n]); __builtin_amdgcn_s_setprio(0); } while (0)
#define WAIT_V(n) asm volatile("s_waitcnt vmcnt(" #n ")" ::: "memory")
#define WAIT_L(n) asm volatile("s_waitcnt lgkmcnt(" #n ")" ::: "memory")
#define BAR __builtin_amdgcn_s_barrier()
#define SCHED __builtin_amdgcn_sched_barrier(0)
  const int brow = pm * BM, bcol = pn * BM;
  f32x4 acc[2][2][4][2];
#pragma unroll
  for (int a = 0; a < 2; ++a)
#pragma unroll
    for (int b = 0; b < 2; ++b)
#pragma unroll
      for (int m = 0; m < 4; ++m)
#pragma unroll
        for (int n = 0; n < 2; ++n) acc[a][b][m][n] = (f32x4){0.f, 0.f, 0.f, 0.f};
  bf16x8 At[4][2], B0[2][2], B1[2][2];
  const int nt = K / BK;
  const char* cA = (const char*)A + (size_t)brow * lda * 2;
  const char* cB = (const char*)Bt + (size_t)bcol * ldb * 2;
  STAGE(SBo(0, 0), cB, voffB); STAGE(SAo(0, 0), cA, voffA); STAGE(SBo(0, 1), cB + hstepB, voffB); STAGE(SAo(0, 1), cA + hstepA, voffA);
  if (wr == 1) BAR;
  WAIT_V(4); BAR;
  STAGE(SBo(1, 0), cB + kstep, voffB); STAGE(SAo(1, 0), cA + kstep, voffA); STAGE(SBo(1, 1), cB + hstepB + kstep, voffB);
  WAIT_V(6); BAR;
  for (int t = 0; t < nt - 2; t += 2) {
    const char* a1 = cA + (size_t)(t + 1) * kstep;
    const char* a2 = cA + (size_t)(t + 2) * kstep; const char* b2 = cB + (size_t)(t + 2) * kstep;
    const char* a3 = a2 + kstep; const char* b3 = b2 + kstep;
    LDB(B0, 0, 0); SCHED; LDA(At, 0, 0); STAGE(SAo(1, 1), a1 + hstepA, voffA);
    WAIT_L(8); BAR; WAIT_L(0); MMA(0, 0, At, B0); BAR; SCHED;
    LDB(B1, 0, 1); STAGE(SBo(0, 0), b2, voffB);
    BAR; WAIT_L(0); MMA(0, 1, At, B1); BAR;
    LDA(At, 0, 1); STAGE(SAo(0, 0), a2, voffA);
    BAR; WAIT_L(0); MMA(1, 0, At, B0); BAR; SCHED;
    STAGE(SBo(0, 1), b2 + hstepB, voffB);
    WAIT_V(6); BAR; MMA(1, 1, At, B1); BAR;
    LDB(B0, 1, 0); SCHED; LDA(At, 1, 0); STAGE(SAo(0, 1), a2 + hstepA, voffA);
    WAIT_L(8); BAR; WAIT_L(0); MMA(0, 0, At, B0); BAR; SCHED;
    LDB(B1, 1, 1); STAGE(SBo(1, 0), b3, voffB);
    BAR; WAIT_L(0); MMA(0, 1, At, B1); BAR;
    LDA(At, 1, 1); STAGE(SAo(1, 0), a3, voffA);
    BAR; WAIT_L(0); MMA(1, 0, At, B0); BAR; SCHED;
    STAGE(SBo(1, 1), b3 + hstepB, voffB);
    WAIT_V(6); BAR; MMA(1, 1, At, B1); BAR;
  }
  { const char* a1 = cA + (size_t)(nt - 1) * kstep;
    LDB(B0, 0, 0); LDA(At, 0, 0); STAGE(SAo(1, 1), a1 + hstepA, voffA);
    BAR; WAIT_L(0); MMA(0, 0, At, B0); BAR;
    LDB(B1, 0, 1); BAR; WAIT_L(0); MMA(0, 1, At, B1); BAR;
    LDA(At, 0, 1); WAIT_V(4); BAR; WAIT_L(0); MMA(1, 0, At, B0); MMA(1, 1, At, B1); BAR; }
  { LDB(B0, 1, 0); LDA(At, 1, 0); WAIT_V(2); BAR; WAIT_L(0); MMA(0, 0, At, B0); BAR;
    LDB(B1, 1, 1); WAIT_V(0); BAR; WAIT_L(0); MMA(0, 1, At, B1); BAR;
    LDA(At, 1, 1); BAR; WAIT_L(0); MMA(1, 0, At, B0); MMA(1, 1, At, B1); BAR; }
  if (wr == 0) BAR;
#pragma unroll
  for (int ai = 0; ai < 2; ++ai)
#pragma unroll
    for (int m = 0; m < 4; ++m) {
      const int row = brow + ai * HALF + wr * 64 + m * 16 + fr;
#pragma unroll
      for (int bj = 0; bj < 2; ++bj)
#pragma unroll
        for (int n = 0; n < 2; ++n) epi(acc[ai][bj][m][n], row, bcol + bj * HALF + wc * 32 + fq * 8 + n * 4, pm, pn);
      asm volatile("" ::: "memory");
    }
  __syncthreads();
}

__device__ __forceinline__ void unit_map(int wgid, int nM, int nN, int& pm, int& pn) {
  const int nwg = nM * nN, NX = 8, WGM = 4;
  { const int q = nwg / NX, r = nwg % NX, xcd = wgid % NX, off = wgid / NX; wgid = (xcd < r ? xcd * (q + 1) : r * (q + 1) + (xcd - r) * q) + off; }
  const int nig = WGM * nN, gid = wgid / nig, fm = gid * WGM, gsz = (nM - fm) < WGM ? (nM - fm) : WGM;
  pm = fm + ((wgid % nig) % gsz);
  pn = (wgid % nig) / gsz;
}

struct EpiA1 {
  bf16_t *Q, *Kb, *BC; float* DTRAW; const float* rope;
  __device__ __forceinline__ void operator()(const f32x4& v, int row, int col, int pm, int pn) const {
    if (pn < 16) {
      f32x4 o = v;
      const bool isk = pn >= 8;
      if (isk) o = o * 0.08838834764831845f;
      if (pm > 0) {
        const int t = row - CTX, cl = col & 127, half = cl >> 6, d0 = (cl & 63) >> 1;
        const int pos = half ? (t & 63) : (t >> 6);
        const f32x4 cs = *(const f32x4*)(rope + ((size_t)pos * 32 + d0) * 2);
        f32x4 q;
        q[0] = o[0] * cs[0] - o[1] * cs[1]; q[1] = o[0] * cs[1] + o[1] * cs[0];
        q[2] = o[2] * cs[2] - o[3] * cs[3]; q[3] = o[2] * cs[3] + o[3] * cs[2];
        o = q;
      }
      u32x2 w; w.x = cvt_pk_bf16(o[0], o[1]); w.y = cvt_pk_bf16(o[2], o[3]);
      bf16_t* dst = (isk ? Kb : Q) + (size_t)row * 2048 + (col & 2047);
      *(u32x2*)dst = w;
    } else if (pn < 24) {
      u32x2 w; w.x = cvt_pk_bf16(v[0], v[1]); w.y = cvt_pk_bf16(v[2], v[3]);
      *(u32x2*)(BC + (size_t)row * 2048 + (col - 4096)) = w;
    } else {
      const int cl = col - 6144;
      if (cl < 128) *(f32x4*)(DTRAW + (size_t)row * 128 + cl) = v;
    }
  }
};
struct EpiA2 {
  bf16_t *VT, *XTRAW;
  __device__ __forceinline__ void operator()(const f32x4& v, int row, int col, int pm, int pn) const {
    u32x2 w; w.x = cvt_pk_bf16(v[0], v[1]); w.y = cvt_pk_bf16(v[2], v[3]);
    bf16_t* dst = row < 2048 ? VT + (size_t)row * R + col : XTRAW + (size_t)(row - 2048) * R + col;
    *(u32x2*)dst = w;
  }
};
struct EpiB {
  bf16_t *Q, *YS, *G; const float* ssd_norm_w; float* SUMSQ;
  __device__ __forceinline__ void operator()(const f32x4& v, int row, int col, int pm, int pn) const {
    if (pn < 8) {
      bf16_t* p = Q + (size_t)(row + CTX) * 2048 + col;
      const u32x2 y = *(const u32x2*)p;
      u32x2 w;
      w.x = cvt_pk_bf16(bflo(y.x) * siluf_(v[0]), bfhi(y.x) * siluf_(v[1]));
      w.y = cvt_pk_bf16(bflo(y.y) * siluf_(v[2]), bfhi(y.y) * siluf_(v[3]));
      *(u32x2*)p = w;
    } else if (pn < 24) {
      const int zc = col - 2048;
      bf16_t* p = YS + (size_t)row * 4096 + zc;
      const u32x2 y = *(const u32x2*)p;
      const f32x4 nw = *(const f32x4*)(ssd_norm_w + zc);
      const float t0 = bflo(y.x) * siluf_(v[0]), t1 = bfhi(y.x) * siluf_(v[1]), t2 = bflo(y.y) * siluf_(v[2]), t3 = bfhi(y.y) * siluf_(v[3]);
      float ss = t0 * t0 + t1 * t1 + t2 * t2 + t3 * t3;
      ss += __shfl_xor(ss, 16); ss += __shfl_xor(ss, 32);
      if ((threadIdx.x & 48) == 0) atomicAdd(SUMSQ + row, ss);
      u32x2 w; w.x = cvt_pk_bf16(t0 * nw[0], t1 * nw[1]); w.y = cvt_pk_bf16(t2 * nw[2], t3 * nw[3]);
      *(u32x2*)p = w;
    } else {
      u32x2 w; w.x = cvt_pk_bf16(sigmoidf_(v[0]), sigmoidf_(v[1])); w.y = cvt_pk_bf16(sigmoidf_(v[2]), sigmoidf_(v[3]));
      *(u32x2*)(G + (size_t)row * 4096 + (col - 6144)) = w;
    }
  }
};
struct EpiO1a {
  const bf16_t* G; bf16_t* M;
  __device__ __forceinline__ void operator()(const f32x4& v, int row, int col, int pm, int pn) const {
    const u32x2 g = *(const u32x2*)(G + (size_t)row * 4096 + col);
    u32x2 w;
    w.x = cvt_pk_bf16(bflo(g.x) * v[0], bfhi(g.x) * v[1]);
    w.y = cvt_pk_bf16(bflo(g.y) * v[2], bfhi(g.y) * v[3]);
    *(u32x2*)(M + (size_t)row * 2048 + col) = w;
  }
};
struct EpiO1b {
  const bf16_t* G; const float* SUMSQ; bf16_t* M;
  __device__ __forceinline__ void operator()(const f32x4& v, int row, int col, int pm, int pn) const {
    const u32x2 g = *(const u32x2*)(G + (size_t)row * 4096 + 2048 + col);
    const float r = rsqrtf(SUMSQ[row] * (1.0f / 4096.0f) + EPS);
    const u32x2 t = *(const u32x2*)(M + (size_t)row * 2048 + col);
    u32x2 w;
    w.x = cvt_pk_bf16(bflo(t.x) + bflo(g.x) * r * v[0], bfhi(t.x) + bfhi(g.x) * r * v[1]);
    w.y = cvt_pk_bf16(bflo(t.y) + bflo(g.y) * r * v[2], bfhi(t.y) + bfhi(g.y) * r * v[3]);
    *(u32x2*)(M + (size_t)row * 2048 + col) = w;
  }
};
struct EpiRes {
  const float* base; const float* gate; float* H; bool do_store;
  __device__ __forceinline__ void operator()(const f32x4& v, int row, int col, int pm, int pn) const {
    const f32x4 b = *(const f32x4*)(base + (size_t)row * 2048 + col);
    const f32x4 g = *(const f32x4*)(gate + col);
    if (do_store) *(f32x4*)(H + (size_t)row * 2048 + col) = b + g * v;
  }
};
struct EpiRes9 {
  const float* base; const float* gate; float* H; const float* nw; const float* scf; bf16_t* F; float* SS2;
  __device__ __forceinline__ void operator()(const f32x4& v, int row, int col, int pm, int pn) const {
    const f32x4 b = *(const f32x4*)(base + (size_t)row * 2048 + col);
    const f32x4 g = *(const f32x4*)(gate + col);
    const f32x4 h = b + g * v;
    *(f32x4*)(H + (size_t)row * 2048 + col) = h;
    const f32x4 w = *(const f32x4*)(nw + col), sc = *(const f32x4*)(scf + col);
    u32x2 o;
    o.x = cvt_pk_bf16(h[0] * w[0] * (1.0f + sc[0]), h[1] * w[1] * (1.0f + sc[1]));
    o.y = cvt_pk_bf16(h[2] * w[2] * (1.0f + sc[2]), h[3] * w[3] * (1.0f + sc[3]));
    *(u32x2*)(F + (size_t)row * 2048 + col) = o;
    float ss = h[0] * h[0] + h[1] * h[1] + h[2] * h[2] + h[3] * h[3];
    ss += __shfl_xor(ss, 16); ss += __shfl_xor(ss, 32);
    if ((threadIdx.x & 48) == 0) atomicAdd(SS2 + row, ss);
  }
};
struct EpiM1 {
  bf16_t* A1; const float* SS2; const float* bias1;
  __device__ __forceinline__ void operator()(const f32x4& v, int row, int col, int pm, int pn) const {
    const float r_ = rsqrtf(SS2[row] * (1.0f / DM) + EPS);
    const f32x4 bi = *(const f32x4*)(bias1 + col);
    f32x4 o;
#pragma unroll
    for (int j = 0; j < 4; ++j) { const float r = fmaxf(v[j] * r_ + bi[j], 0.f); o[j] = r * r; }
    u32x2 w; w.x = cvt_pk_bf16(o[0], o[1]); w.y = cvt_pk_bf16(o[2], o[3]);
    *(u32x2*)(A1 + (size_t)row * DFF + col) = w;
  }
};

__device__ __forceinline__ void convert_tile(const float* __restrict__ src, int ldw, int c0, int K, bf16_t* __restrict__ dst, int tc, int kt, int tid) {
  float* tile = (float*)smem;
  const int c4 = (tid & 63) * 4, kq = tid >> 6;
  f32x4 v[8];
#pragma unroll
  for (int i = 0; i < 8; ++i) v[i] = *(const f32x4*)(src + (size_t)(kt * 64 + kq + i * 8) * ldw + c0 + tc * 256 + c4);
#pragma unroll
  for (int i = 0; i < 8; ++i) {
    float* tp = tile + (kq + i * 8) * 257 + c4;
    tp[0] = v[i][0]; tp[1] = v[i][1]; tp[2] = v[i][2]; tp[3] = v[i][3];
  }
  __syncthreads();
  const int c = tid >> 1, k32 = (tid & 1) * 32;
  bf16_t* dp = dst + (size_t)(tc * 256 + c) * K + kt * 64 + k32;
#pragma unroll
  for (int q = 0; q < 4; ++q) {
    const float* tp = tile + (k32 + q * 8) * 257 + c;
    u32x4 w;
    w.x = cvt_pk_bf16(tp[0], tp[257]); w.y = cvt_pk_bf16(tp[2 * 257], tp[3 * 257]);
    w.z = cvt_pk_bf16(tp[4 * 257], tp[5 * 257]); w.w = cvt_pk_bf16(tp[6 * 257], tp[7 * 257]);
    *(u32x4*)(dp + q * 8) = w;
  }
}

__device__ __forceinline__ void convert_segment(const float* __restrict__ src, int ldw, int c0, int ncols, int K, bf16_t* __restrict__ dst, bool perm,
                                                const float* bias_vec = nullptr, float* bias_out = nullptr) {
  float* tile = (float*)smem;
  int tid = threadIdx.x;
  asm volatile("" : "+v"(tid));
  const int tk = K / 64, ntc = (ncols + 255) / 256, ntiles = ntc * tk;
  const int c4 = (tid & 63) * 4, kq = tid >> 6;
  f32x4 v[8];
  auto load_tile = [&](int t) {
    const int tc = t / tk, kt = t % tk;
    const bool okc = tc * 256 + c4 < ncols;
#pragma unroll
    for (int i = 0; i < 8; ++i)
      v[i] = okc ? *(const f32x4*)(src + (size_t)(kt * 64 + kq + i * 8) * ldw + c0 + tc * 256 + c4) : (f32x4){0.f, 0.f, 0.f, 0.f};
  };
  if ((int)blockIdx.x < ntiles) load_tile(blockIdx.x);
  for (int t = blockIdx.x; t < ntiles; t += gridDim.x) {
    const int tc = t / tk, kt = t % tk;
    __syncthreads();
#pragma unroll
    for (int i = 0; i < 8; ++i) {
      float* tp = tile + (kq + i * 8) * 257 + c4;
      tp[0] = v[i][0]; tp[1] = v[i][1]; tp[2] = v[i][2]; tp[3] = v[i][3];
    }
    if (t + (int)gridDim.x < ntiles) load_tile(t + gridDim.x);
    __syncthreads();
    if (bias_out != nullptr && tid < 256) {
      float a = 0.f;
#pragma unroll 8
      for (int k = 0; k < 64; ++k) a += tile[k * 257 + tid] * bias_vec[kt * 64 + k];
      atomicAdd(bias_out + tc * 256 + tid, a);
    }
    {
      const int c = tid >> 1, k32 = (tid & 1) * 32;
      const int cr = c & 63;
      const int sc = perm ? ((c & ~63) + (cr & 1) * 32 + (cr >> 1)) : c;
      if (tc * 256 + c < ncols) {
        bf16_t* dp = dst + (size_t)(tc * 256 + c) * K + kt * 64 + k32;
#pragma unroll
        for (int q = 0; q < 4; ++q) {
          const float* tp = tile + (k32 + q * 8) * 257 + sc;
          u32x4 w;
          w.x = cvt_pk_bf16(tp[0], tp[257]); w.y = cvt_pk_bf16(tp[2 * 257], tp[3 * 257]);
          w.z = cvt_pk_bf16(tp[4 * 257], tp[5 * 257]); w.w = cvt_pk_bf16(tp[6 * 257], tp[7 * 257]);
          *(u32x4*)(dp + q * 8) = w;
        }
      }
    }
  }
  __syncthreads();
}

__device__ __forceinline__ void modnorm_rows(const float* __restrict__ xa, int rows_a, const float* __restrict__ xb, int rows_b, const float* __restrict__ nw,
                             const float* __restrict__ sca, const float* __restrict__ sha, const float* __restrict__ scb,
                             const float* __restrict__ shb, bf16_t* __restrict__ outp) {
  int tid = threadIdx.x;
  asm volatile("" : "+v"(tid));
  const int lane = tid & 63, gw = blockIdx.x * (NTH / 64) + (tid >> 6), nw_ = gridDim.x * (NTH / 64);
  for (int r = gw; r < rows_a + rows_b; r += nw_) {
    const bool isa = r < rows_a;
    const float* xr = isa ? xa + (size_t)r * DM : xb + (size_t)(r - rows_a) * DM;
    const float* sc = isa ? sca : scb;
    const float* sh = isa ? sha : shb;
    f32x4 v[8];
    float ss = 0.f;
#pragma unroll
    for (int i = 0; i < 8; ++i) { v[i] = *(const f32x4*)(xr + i * 256 + lane * 4); ss += v[i][0] * v[i][0] + v[i][1] * v[i][1] + v[i][2] * v[i][2] + v[i][3] * v[i][3]; }
    ss = wave_sum(ss);
    const float rs = rsqrtf(ss * (1.0f / DM) + EPS);
#pragma unroll
    for (int i = 0; i < 8; ++i) {
      const int cidx = i * 256 + lane * 4;
      const f32x4 w = *(const f32x4*)(nw + cidx), s = *(const f32x4*)(sc + cidx), b = *(const f32x4*)(sh + cidx);
      f32x4 o;
#pragma unroll
      for (int j = 0; j < 4; ++j) o[j] = v[i][j] * rs * w[j] * (1.0f + s[j]) + b[j];
      u32x2 pk; pk.x = cvt_pk_bf16(o[0], o[1]); pk.y = cvt_pk_bf16(o[2], o[3]);
      *(u32x2*)(outp + (size_t)r * DM + cidx) = pk;
    }
  }
}

template <int MODE>
__device__ __forceinline__ void state_build_item(const Params& p, int c, int hg) {
  unsigned char* ws = p.ws;
  int tid = threadIdx.x;
  asm volatile("" : "+v"(tid));
  const int wid = tid >> 6, lane = tid & 63, fr = lane & 15, fq = lane >> 4;
  bf16_t* Kt = (bf16_t*)smem;
  bf16_t* Vt = (bf16_t*)(smem + 67584);
  float* wfs = (float*)(smem + 135168);
  float* wbs = wfs + 256;
  const bf16_t* Ksrc = MODE == 0 ? (const bf16_t*)(ws + OFF_K) : (const bf16_t*)(ws + OFF_B);
  const int kld = MODE == 0 ? 2048 : 1024;
  constexpr int NV = MODE == 0 ? 8 : 4;
  const bf16_t* Vsrc = MODE == 0 ? (const bf16_t*)(ws + OFF_VT) : (const bf16_t*)(ws + OFF_XT);
  const int PH = MODE == 0 ? 128 : 64;
  const float* CSF = (const float*)(ws + OFF_CSF); const float* RCSB = (const float*)(ws + OFF_RCSB);
  const float* DTF = (const float*)(ws + OFF_DTF); const float* DTB = (const float*)(ws + OFF_DTB);
  u32x4 vv[NV];
  float wr_[6] = {0.f, 0.f, 0.f, 0.f, 0.f, 0.f};
#define SB_PREFETCH(H_)                                                                                               \
  do {                                                                                                                \
    _Pragma("unroll") for (int i = 0; i < NV; ++i) {                                                                  \
      const int idx = tid + i * NTH, pp = idx >> 5, chn = idx & 31;                                                   \
      vv[i] = *(const u32x4*)(Vsrc + (size_t)((H_) * PH + pp) * R + c * CH + chn * 8);                                \
    }                                                                                                                 \
    if (MODE == 1 && tid < 256) {                                                                                     \
      const size_t rj = (size_t)(c * CH + tid) * 64 + (H_);                                                           \
      wr_[0] = CSF[(size_t)(c * CH + 255) * 64 + (H_)]; wr_[1] = CSF[rj]; wr_[2] = DTF[rj];                           \
      wr_[3] = RCSB[(size_t)(c * CH) * 64 + (H_)]; wr_[4] = RCSB[rj]; wr_[5] = DTB[rj];                               \
    }                                                                                                                 \
  } while (0)
  bf16x8 kv[8];
#pragma unroll
  for (int i = 0; i < 8; ++i) {
    const int idx = tid + i * NTH, j = idx >> 4, chn = idx & 15;
    kv[i] = *(const bf16x8*)(Ksrc + (size_t)(c * CH + j) * kld + hg * 128 + chn * 8);
  }
  SB_PREFETCH(MODE == 0 ? hg : hg * 8);
  __syncthreads();
#pragma unroll
  for (int i = 0; i < 8; ++i) {
    const int idx = tid + i * NTH, j = idx >> 4, chn = idx & 15;
#pragma unroll
    for (int e = 0; e < 8; ++e) Kt[(chn * 8 + e) * 264 + j] = (bf16_t)kv[i][e];
  }
  const int nheads = MODE == 0 ? 1 : 8;
  for (int hh = 0; hh < nheads; ++hh) {
    const int h = MODE == 0 ? hg : hg * 8 + hh;
    if (hh > 0) __syncthreads();
#pragma unroll
    for (int i = 0; i < NV; ++i) {
      const int idx = tid + i * NTH, pp = idx >> 5, chn = idx & 31;
      *(u32x4*)(Vt + pp * 264 + chn * 8) = vv[i];
    }
    if (tid < 256) {
      if (MODE == 0) {
        const float lgf = -log1pf(__expf(-p.ret_decay_logit[h])) * 1.4426950408889634f;
        const float lgb = -log1pf(__expf(-p.ret_decay_logit[16 + h])) * 1.4426950408889634f;
        wfs[tid] = exp2f((float)(255 - tid) * lgf);
        wbs[tid] = exp2f((float)tid * lgb);
      } else {
        wfs[tid] = __expf(wr_[0] - wr_[1]) * wr_[2];
        wbs[tid] = __expf(wr_[3] - wr_[4]) * wr_[5];
      }
    }
    __syncthreads();
    if (MODE == 1 && hh + 1 < nheads) SB_PREFETCH(h + 1);
    constexpr int NTL = MODE == 0 ? 8 : 4;
    const int p0 = MODE == 0 ? wid * 16 : (wid & 3) * 16;
    const int nt0 = MODE == 0 ? 0 : (wid >> 2) * 4;
    f32x4 af[NTL], ab[NTL];
#pragma unroll
    for (int i = 0; i < NTL; ++i) { af[i] = (f32x4){0.f, 0.f, 0.f, 0.f}; ab[i] = af[i]; }
#pragma unroll 2
    for (int kk = 0; kk < 8; ++kk) {
      const int jb = kk * 32 + fq * 8;
      const bf16x8 vr = *(const bf16x8*)(Vt + (p0 + fr) * 264 + jb);
      const f32x4 wf0 = *(const f32x4*)(wfs + jb), wf1 = *(const f32x4*)(wfs + jb + 4);
      const f32x4 wb0 = *(const f32x4*)(wbs + jb), wb1 = *(const f32x4*)(wbs + jb + 4);
      float x[8];
#pragma unroll
      for (int e = 0; e < 8; ++e) x[e] = bf2f((unsigned short)vr[e]);
      u32x4 uf, ub;
      uf.x = cvt_pk_bf16(x[0] * wf0[0], x[1] * wf0[1]); uf.y = cvt_pk_bf16(x[2] * wf0[2], x[3] * wf0[3]);
      uf.z = cvt_pk_bf16(x[4] * wf1[0], x[5] * wf1[1]); uf.w = cvt_pk_bf16(x[6] * wf1[2], x[7] * wf1[3]);
      ub.x = cvt_pk_bf16(x[0] * wb0[0], x[1] * wb0[1]); ub.y = cvt_pk_bf16(x[2] * wb0[2], x[3] * wb0[3]);
      ub.z = cvt_pk_bf16(x[4] * wb1[0], x[5] * wb1[1]); ub.w = cvt_pk_bf16(x[6] * wb1[2], x[7] * wb1[3]);
      const bf16x8 vf = as_bf16x8(uf), vb = as_bf16x8(ub);
#pragma unroll
      for (int i = 0; i < NTL; ++i) {
        const bf16x8 kf = *(const bf16x8*)(Kt + ((nt0 + i) * 16 + fr) * 264 + jb);
        af[i] = MFMA(kf, vf, af[i]);
        ab[i] = MFMA(kf, vb, ab[i]);
      }
    }
    bf16_t *df, *db;
    if (MODE == 0) {
      bf16_t* SR = (bf16_t*)(ws + OFF_SR);
      df = SR + ((size_t)(c * 2 + 0) * 16 + h) * 16384; db = SR + ((size_t)(c * 2 + 1) * 16 + h) * 16384;
    } else {
      bf16_t* SS = (bf16_t*)(ws + OFF_SS);
      df = SS + ((size_t)(c * 64 + h) * 2 + 0) * 8192; db = df + 8192;
    }
#pragma unroll
    for (int i = 0; i < NTL; ++i) {
      const int off = (p0 + fr) * 128 + (nt0 + i) * 16 + fq * 4;
      u32x2 w; w.x = cvt_pk_bf16(af[i][0], af[i][1]); w.y = cvt_pk_bf16(af[i][2], af[i][3]);
      *(u32x2*)(df + off) = w;
      w.x = cvt_pk_bf16(ab[i][0], ab[i][1]); w.y = cvt_pk_bf16(ab[i][2], ab[i][3]);
      *(u32x2*)(db + off) = w;
    }
  }
  __syncthreads();
}

__device__ __forceinline__ void ret_out_item(const Params& p, int cc, int h, int half, bool do_store) {
  unsigned char* ws = p.ws;
  int tid = threadIdx.x;
  asm volatile("" : "+v"(tid));
  const int wid = tid >> 6, lane = tid & 63, fr = lane & 15, fq = lane >> 4;
  bf16_t* Q = (bf16_t*)(ws + OFF_Q);
  const bf16_t* Kb = (const bf16_t*)(ws + OFF_K);
  const bf16_t* VT = (const bf16_t*)(ws + OFF_VT);
  const bf16_t* SR = (const bf16_t*)(ws + OFF_SR);
  const float lgf = -log1pf(__expf(-p.ret_decay_logit[h])) * 1.4426950408889634f;
  const float lgb = -log1pf(__expf(-p.ret_decay_logit[16 + h])) * 1.4426950408889634f;
  const int i0 = half * 128 + wid * 16, il = i0 + fr;
  const size_t grow = (size_t)cc * CH + il;
  bf16x8 qf[4];
#pragma unroll
  for (int kk = 0; kk < 4; ++kk) qf[kk] = *(const bf16x8*)(Q + grow * 2048 + h * 128 + kk * 32 + fq * 8);
  bf16_t* Hf = (bf16_t*)smem;
  bf16_t* Hb = (bf16_t*)(smem + 34816);
  __syncthreads();
  {
    u32x4 hv[8];
#pragma unroll
    for (int i = 0; i < 8; ++i) {
      const int idx = tid + i * NTH, dir = idx >> 11, rr = (idx >> 4) & 127, chn = idx & 15;
      hv[i] = *(const u32x4*)(SR + ((size_t)(cc * 2 + dir) * 16 + h) * 16384 + rr * 128 + chn * 8);
    }
#pragma unroll
    for (int i = 0; i < 8; ++i) {
      const int idx = tid + i * NTH, dir = idx >> 11, rr = (idx >> 4) & 127, chn = idx & 15;
      *(u32x4*)((dir ? Hb : Hf) + rr * 136 + chn * 8) = hv[i];
    }
  }
  __syncthreads();

  f32x4 Y[8];
  {
    const float ai = exp2f((float)(il + 1) * lgf), bi = exp2f((float)(256 - il) * lgb);
#pragma unroll
    for (int pt = 0; pt < 8; ++pt) {
      f32x4 a = {0.f, 0.f, 0.f, 0.f}, b = {0.f, 0.f, 0.f, 0.f};
#pragma unroll
      for (int kk = 0; kk < 4; ++kk) {
        const bf16x8 hf = *(const bf16x8*)(Hf + (pt * 16 + fr) * 136 + kk * 32 + fq * 8);
        const bf16x8 hb = *(const bf16x8*)(Hb + (pt * 16 + fr) * 136 + kk * 32 + fq * 8);
        a = MFMA(hf, qf[kk], a);
        b = MFMA(hb, qf[kk], b);
      }
      Y[pt] = a * ai + b * bi;
      __builtin_amdgcn_sched_barrier(0);
    }
  }
  __syncthreads();
  bf16_t* Ki = (bf16_t*)smem;
  bf16_t* Vt = (bf16_t*)(smem + 69632);
  {
    u32x4 kreg[8], vreg[8];
#pragma unroll
    for (int i = 0; i < 8; ++i) {
      const int idx = tid + i * NTH;
      kreg[i] = *(const u32x4*)(Kb + (size_t)(cc * CH + (idx >> 4)) * 2048 + h * 128 + (idx & 15) * 8);
      vreg[i] = *(const u32x4*)(VT + (size_t)(h * 128 + (idx >> 5)) * R + cc * CH + (idx & 31) * 8);
    }
#pragma unroll
    for (int i = 0; i < 8; ++i) {
      const int idx = tid + i * NTH;
      *(u32x4*)(Ki + (idx >> 4) * 136 + (idx & 15) * 8) = kreg[i];
    }
#pragma unroll
    for (int i = 0; i < 8; ++i) {
      const int idx = tid + i * NTH;
      *(u32x4*)(Vt + (idx >> 5) * 264 + (idx & 31) * 8) = vreg[i];
    }
  }
  __syncthreads();
  bf16x8 pf[8];
#pragma unroll
  for (int k2 = 0; k2 < 8; ++k2) {
    u32x4 pk;
#pragma unroll
    for (int s = 0; s < 2; ++s) {
      const int jt = k2 * 2 + s;
      f32x4 sacc = {0.f, 0.f, 0.f, 0.f};
#pragma unroll
      for (int kk = 0; kk < 4; ++kk) {
        const bf16x8 kf = *(const bf16x8*)(Ki + (jt * 16 + fr) * 136 + kk * 32 + fq * 8);
        sacc = MFMA(kf, qf[kk], sacc);
      }
      float w[4];
#pragma unroll
      for (int e = 0; e < 4; ++e) {
        const int dl = il - (jt * 16 + fq * 4 + e);
        w[e] = sacc[e] * __builtin_amdgcn_exp2f(dl >= 0 ? (float)dl * lgf : (float)(-dl) * lgb);
      }
      if (s == 0) { pk.x = cvt_pk_bf16(w[0], w[1]); pk.y = cvt_pk_bf16(w[2], w[3]); }
      else { pk.z = cvt_pk_bf16(w[0], w[1]); pk.w = cvt_pk_bf16(w[2], w[3]); }
    }
    pf[k2] = as_bf16x8(pk);
    __builtin_amdgcn_sched_barrier(0);
  }
#pragma unroll
  for (int pt = 0; pt < 8; ++pt) {
#pragma unroll
    for (int k2 = 0; k2 < 8; ++k2) {
      const bf16x4 lo = *(const bf16x4*)(Vt + (pt * 16 + fr) * 264 + k2 * 32 + fq * 4);
      const bf16x4 hi = *(const bf16x4*)(Vt + (pt * 16 + fr) * 264 + k2 * 32 + 16 + fq * 4);
      Y[pt] = MFMA(mk8(lo, hi), pf[k2], Y[pt]);
    }
    __builtin_amdgcn_sched_barrier(0);
  }
  float s1 = 0.f;
#pragma unroll
  for (int pt = 0; pt < 8; ++pt) s1 += (Y[pt][0] + Y[pt][1]) + (Y[pt][2] + Y[pt][3]);
  s1 += __shfl_xor(s1, 16); s1 += __shfl_xor(s1, 32);
  const float mu = s1 * (1.0f / 128.0f);
  float s2 = 0.f;
#pragma unroll
  for (int pt = 0; pt < 8; ++pt) {
#pragma unroll
    for (int e = 0; e < 4; ++e) { const float d = Y[pt][e] - mu; s2 += d * d; }
  }
  s2 += __shfl_xor(s2, 16); s2 += __shfl_xor(s2, 32);
  const float rstd = rsqrtf(s2 * (1.0f / 128.0f) + EPS);
#pragma unroll
  for (int pt = 0; pt < 8; ++pt) {
    const int pc = h * 128 + pt * 16 + fq * 4;
    const f32x4 nw = *(const f32x4*)(p.ret_norm_w + pc);
    u32x2 w;
    w.x = cvt_pk_bf16((Y[pt][0] - mu) * rstd * nw[0], (Y[pt][1] - mu) * rstd * nw[1]);
    w.y = cvt_pk_bf16((Y[pt][2] - mu) * rstd * nw[2], (Y[pt][3] - mu) * rstd * nw[3]);
    if (do_store) *(u32x2*)(Q + grow * 2048 + pc) = w;
  }
  __syncthreads();
}

__device__ __forceinline__ void ssd_out_item(const Params& p, int cc, int g, int half) {
  unsigned char* ws = p.ws;
  int tid = threadIdx.x;
  asm volatile("" : "+v"(tid));
  const int wid = tid >> 6, lane = tid & 63, fr = lane & 15, fq = lane >> 4;
  const bf16_t* Bb = (const bf16_t*)(ws + OFF_B);
  const bf16_t* Cb = (const bf16_t*)(ws + OFF_C);
  const bf16_t* XT = (const bf16_t*)(ws + OFF_XT);
  const bf16_t* SS = (const bf16_t*)(ws + OFF_SS);
  bf16_t* YS = (bf16_t*)(ws + OFF_YS);
  const float* CSF = (const float*)(ws + OFF_CSF); const float* RCSB = (const float*)(ws + OFF_RCSB);
  const float* DTF = (const float*)(ws + OFF_DTF); const float* DTB = (const float*)(ws + OFF_DTB);
  const int i0 = half * 128 + wid * 16, il = i0 + fr;
  const size_t grow = (size_t)cc * CH + il;
  bf16_t* Bi = (bf16_t*)smem;
  bf16_t* Hf = (bf16_t*)(smem + 69632);
  bf16_t* Hb = (bf16_t*)(smem + 87040);
  bf16_t* Xt = (bf16_t*)(smem + 104448);
  float* vcs = (float*)(smem + 138240);
  bf16x8 cf[4];
#pragma unroll
  for (int kk = 0; kk < 4; ++kk) cf[kk] = *(const bf16x8*)(Cb + grow * 1024 + g * 128 + kk * 32 + fq * 8);
  __syncthreads();
  {
    u32x4 bv[8];
#pragma unroll
    for (int i = 0; i < 8; ++i) {
      const int idx = tid + i * NTH;
      bv[i] = *(const u32x4*)(Bb + (size_t)(cc * CH + (idx >> 4)) * 1024 + g * 128 + (idx & 15) * 8);
    }
#pragma unroll
    for (int i = 0; i < 8; ++i) {
      const int idx = tid + i * NTH;
      *(u32x4*)(Bi + (idx >> 4) * 136 + (idx & 15) * 8) = bv[i];
    }
  }
  __syncthreads();
  u32x2 S[16];
#pragma unroll
  for (int jt = 0; jt < 16; ++jt) {
    f32x4 sacc = {0.f, 0.f, 0.f, 0.f};
#pragma unroll
    for (int kk = 0; kk < 4; ++kk) {
      const bf16x8 kf = *(const bf16x8*)(Bi + (jt * 16 + fr) * 136 + kk * 32 + fq * 8);
      sacc = MFMA(kf, cf[kk], sacc);
    }
    S[jt].x = cvt_pk_bf16(sacc[0], sacc[1]); S[jt].y = cvt_pk_bf16(sacc[2], sacc[3]);
  }
  __syncthreads();
  u32x2* Sl = (u32x2*)smem + wid * 1024;
#pragma unroll
  for (int jt = 0; jt < 16; ++jt) Sl[jt * 64 + lane] = S[jt];
  u32x4 hreg[4], xreg[4];
  float vr[4] = {0.f, 0.f, 0.f, 0.f};
#define SSD_PREFETCH(HH)                                                                                              \
  do {                                                                                                                \
    const int h_ = g * 8 + (HH);                                                                                      \
    _Pragma("unroll") for (int i = 0; i < 4; ++i) {                                                                   \
      const int idx = tid + i * NTH;                                                                                  \
      hreg[i] = *(const u32x4*)(SS + ((size_t)(cc * 64 + h_) * 2 + (idx >> 10)) * 8192 + ((idx >> 4) & 63) * 128 + (idx & 15) * 8); \
      xreg[i] = *(const u32x4*)(XT + (size_t)(h_ * 64 + (idx >> 5)) * R + cc * CH + (idx & 31) * 8);                  \
    }                                                                                                                 \
    if (tid < 256) {                                                                                                  \
      const size_t rj = (size_t)(cc * CH + tid) * 64 + h_;                                                            \
      vr[0] = CSF[rj]; vr[1] = RCSB[rj]; vr[2] = DTF[rj]; vr[3] = DTB[rj];                                            \
    }                                                                                                                 \
  } while (0)
  SSD_PREFETCH(0);
  for (int hh = 0; hh < 8; ++hh) {
    const int h = g * 8 + hh;
    __syncthreads();
#pragma unroll
    for (int i = 0; i < 4; ++i) {
      const int idx = tid + i * NTH;
      *(u32x4*)(((idx >> 10) ? Hb : Hf) + ((idx >> 4) & 63) * 136 + (idx & 15) * 8) = hreg[i];
      *(u32x4*)(Xt + (idx >> 5) * 264 + (idx & 31) * 8) = xreg[i];
    }
    if (tid < 256) {
      const float c2 = vr[0] * 1.4426950408889634f, r2 = vr[1] * 1.4426950408889634f;
      vcs[tid] = c2; vcs[256 + tid] = r2;
      vcs[512 + tid] = c2 - __log2f(vr[2]); vcs[768 + tid] = r2 - __log2f(vr[3]);
    }
    __syncthreads();
    if (hh < 7) SSD_PREFETCH(hh + 1);
    int ilv = il;
    asm volatile("" : "+v"(ilv));
    const float csi = vcs[il], rcsi = vcs[256 + il];
    f32x4 Y[4];
    {
      const float ai = exp2f(csi), bi = exp2f(rcsi);
#pragma unroll
      for (int pt = 0; pt < 4; ++pt) {
        f32x4 a = {0.f, 0.f, 0.f, 0.f}, b = {0.f, 0.f, 0.f, 0.f};
#pragma unroll
        for (int kk = 0; kk < 4; ++kk) {
          const bf16x8 hf = *(const bf16x8*)(Hf + (pt * 16 + fr) * 136 + kk * 32 + fq * 8);
          const bf16x8 hb = *(const bf16x8*)(Hb + (pt * 16 + fr) * 136 + kk * 32 + fq * 8);
          a = MFMA(hf, cf[kk], a);
          b = MFMA(hb, cf[kk], b);
        }
        Y[pt] = a * ai + b * bi;
        __builtin_amdgcn_sched_barrier(0);
      }
    }
#pragma unroll 1
    for (int k2 = 0; k2 < 8; ++k2) {
      u32x4 pk;
#pragma unroll
      for (int s = 0; s < 2; ++s) {
        const int jt = k2 * 2 + s, jb = jt * 16 + fq * 4;
        const u32x2 sp = Sl[jt * 64 + lane];
        float w[4];
        const float sv[4] = {bflo(sp.x), bfhi(sp.x), bflo(sp.y), bfhi(sp.y)};
        const int dtile = __builtin_amdgcn_readfirstlane(half * 8 + wid);
        if (jt < dtile) {
          const f32x4 af = *(const f32x4*)(vcs + 512 + jb);
#pragma unroll
          for (int e = 0; e < 4; ++e) w[e] = sv[e] * __builtin_amdgcn_exp2f(csi - af[e]);
        } else if (jt > dtile) {
          const f32x4 ab = *(const f32x4*)(vcs + 768 + jb);
#pragma unroll
          for (int e = 0; e < 4; ++e) w[e] = sv[e] * __builtin_amdgcn_exp2f(rcsi - ab[e]);
        } else {
          const f32x4 af = *(const f32x4*)(vcs + 512 + jb), ab = *(const f32x4*)(vcs + 768 + jb);
#pragma unroll
          for (int e = 0; e < 4; ++e) w[e] = sv[e] * __builtin_amdgcn_exp2f(((jb + e) <= ilv) ? (csi - af[e]) : (rcsi - ab[e]));
        }
        if (s == 0) { pk.x = cvt_pk_bf16(w[0], w[1]); pk.y = cvt_pk_bf16(w[2], w[3]); }
        else { pk.z = cvt_pk_bf16(w[0], w[1]); pk.w = cvt_pk_bf16(w[2], w[3]); }
      }
      const bf16x8 pfr = as_bf16x8(pk);
#pragma unroll
      for (int pt = 0; pt < 4; ++pt) {
        const bf16x4 lo = *(const bf16x4*)(Xt + (pt * 16 + fr) * 264 + k2 * 32 + fq * 4);
        const bf16x4 hi = *(const bf16x4*)(Xt + (pt * 16 + fr) * 264 + k2 * 32 + 16 + fq * 4);
        Y[pt] = MFMA(mk8(lo, hi), pfr, Y[pt]);
      }
      __builtin_amdgcn_sched_barrier(0);
    }
    const float dsk = p.ssd_d[h];
#pragma unroll
    for (int pt = 0; pt < 4; ++pt) {
      float o[4];
#pragma unroll
      for (int e = 0; e < 4; ++e) o[e] = Y[pt][e] + bf2f(Xt[(pt * 16 + fq * 4 + e) * 264 + il]) * dsk;
      u32x2 w; w.x = cvt_pk_bf16(o[0], o[1]); w.y = cvt_pk_bf16(o[2], o[3]);
      *(u32x2*)(YS + ((size_t)(cc - 1) * CH + il) * 4096 + h * 64 + pt * 16 + fq * 4) = w;
    }
  }
  __syncthreads();
}

#ifdef PROBE_AFTER
__device__ void probe_dump(const Params& p, size_t lo0, size_t hi0, size_t lo1, size_t hi1) {
  float* outp = (float*)p.out;
  const size_t n = (size_t)SEQ * DM;
  const bf16_t* b0 = (const bf16_t*)(p.ws + lo0); const size_t n0 = (hi0 - lo0) / 2;
  const bf16_t* b1 = (const bf16_t*)(p.ws + lo1); const size_t n1 = (hi1 - lo1) / 2;
  const size_t k0 = (n0 + n - 1) / n, k1 = n1 ? (n1 + n - 1) / n : 0;
  for (size_t i = (size_t)blockIdx.x * NTH + threadIdx.x; i < n; i += (size_t)gridDim.x * NTH) {
    float a = 0.f;
    for (size_t k = 0; k < k0; ++k) { const size_t j = i + k * n; if (j < n0) { float v = bf2f(b0[j]); if (!(fabsf(v) < 1e30f)) v = 777.f; a += v; } }
    for (size_t k = 0; k < k1; ++k) { const size_t j = i + k * n; if (j < n1) { float v = bf2f(b1[j]); if (!(fabsf(v) < 1e30f)) v = 777.f; a += v; } }
    outp[i] = a;
  }
}
#define PROBE_POINT(idx, lo0, hi0, lo1, hi1) if (PROBE_AFTER == (idx)) { probe_dump(p, lo0, hi0, lo1, hi1); return; }
#else
#define PROBE_POINT(idx, lo0, hi0, lo1, hi1)
#endif

#define XB_TMO      128
#define XB_XCNT(j)  (256  + 64 * (j))
#define XB_XSUB(j)  (1280 + 64 * (j))
#define XB_XGEN(j)  (2304 + 64 * (j))
#define XB_TOP      3328
#define XB_TOPGEN   3392
#define XCD_BAR_WORDS 3456
#define XB_SPIN_CAP (1u << 18)
#define LAS __attribute__((address_space(3)))
__device__ __forceinline__ unsigned xb_ld(unsigned* p)              { return __hip_atomic_load(p, __ATOMIC_RELAXED, __HIP_MEMORY_SCOPE_AGENT); }
__device__ __forceinline__ unsigned xb_add(unsigned* p, unsigned v) { return __hip_atomic_fetch_add(p, v, __ATOMIC_RELAXED, __HIP_MEMORY_SCOPE_AGENT); }
__device__ __forceinline__ unsigned xb_xcc_id() { return (unsigned)__builtin_amdgcn_s_getreg((3 << 11) | 20) & 0xFu; }
#define XB_SPIN(cond, bar) do { unsigned _sp = 0; while (cond) { __builtin_amdgcn_s_sleep(1); \
    if ((++_sp & 255u) == 0u) { if (xb_ld(&(bar)[XB_TMO])) break; if (_sp > XB_SPIN_CAP) { atomicAdd(&(bar)[XB_TMO], 1u); break; } } } } while (0)
struct XcdBarrier { unsigned* bar; unsigned x; volatile LAS unsigned* st; };
__device__ __forceinline__ XcdBarrier xcd_barrier_post(unsigned* bar, volatile LAS unsigned* st) {
  XcdBarrier b; b.bar = bar; b.x = xb_xcc_id(); b.st = st;
  if (threadIdx.x == 0) (void)xb_add(&bar[XB_XCNT(b.x)], 1u);
  return b;
}
__device__ __forceinline__ void xcd_barrier_complete(unsigned* bar, unsigned x, unsigned& nloc, unsigned& nx) {
  const unsigned G = gridDim.x * gridDim.y * gridDim.z;
  unsigned sum, cnt, mine, sp = 0u;
  for (;;) {
    sum = 0u; cnt = 0u; mine = 0u;
#pragma unroll
    for (unsigned j = 0; j < 16; ++j) { const unsigned c = xb_ld(&bar[XB_XCNT(j)]); sum += c; cnt += (c > 0u) ? 1u : 0u; mine = (j == x) ? c : mine; }
    if (sum == G) break;
    __builtin_amdgcn_s_sleep(1);
    if ((++sp & 255u) == 0u) { if (xb_ld(&bar[XB_TMO])) break; if (sp > XB_SPIN_CAP) { atomicAdd(&bar[XB_TMO], 1u); break; } }
  }
  nloc = mine > 0u ? mine : 1u; nx = cnt > 0u ? cnt : 1u;
}
__device__ __forceinline__ void xcd_barrier(const XcdBarrier& b) {
  asm volatile("s_waitcnt vmcnt(0)" ::: "memory");
  __syncthreads();
  if (threadIdx.x == 0) {
    unsigned* bar = b.bar;
    __builtin_amdgcn_s_waitcnt(0);
    unsigned nloc = b.st[0], nx = b.st[1];
    if (nloc == 0u) { xcd_barrier_complete(bar, b.x, nloc, nx); b.st[0] = nloc; b.st[1] = nx; }
    const unsigned old = xb_add(&bar[XB_XSUB(b.x)], 1u);
    const unsigned gen = old / nloc;
    if (old + 1u == (gen + 1u) * nloc) {
      __builtin_amdgcn_fence(__ATOMIC_RELEASE, "agent");
      asm volatile("s_waitcnt vmcnt(0)" ::: "memory");
      const unsigned og = xb_add(&bar[XB_TOP], 1u);
      const unsigned tg = og / nx;
      if (og + 1u == (tg + 1u) * nx) xb_add(&bar[XB_TOPGEN], 1u);
      else XB_SPIN(xb_ld(&bar[XB_TOPGEN]) == tg, bar);
      __builtin_amdgcn_fence(__ATOMIC_ACQUIRE, "agent");
      xb_add(&bar[XB_XGEN(b.x)], 1u);
      asm volatile("s_waitcnt vmcnt(0)" ::: "memory");
    } else {
      XB_SPIN(xb_ld(&bar[XB_XGEN(b.x)]) == gen, bar);
      __builtin_amdgcn_fence(__ATOMIC_ACQUIRE, "agent");
      asm volatile("s_waitcnt vmcnt(0)" ::: "memory");
    }
  }
  __syncthreads();
}

__global__ void __launch_bounds__(NTH) mega(Params p) {
  cg::grid_group grid = cg::this_grid();
  unsigned char* ws = p.ws;
  volatile LAS unsigned* xb_st = (volatile LAS unsigned*)((LAS unsigned char*)smem + (LDS_BYTES - 16));
  if (threadIdx.x == 0) { xb_st[0] = 0u; xb_st[1] = 0u; }
  __syncthreads();
  const XcdBarrier xb = xcd_barrier_post((unsigned*)(ws + OFF_BAR), xb_st);
  const int bid = blockIdx.x, nb = gridDim.x, gnth = nb * NTH;
#define FRESH_TID() int tid = threadIdx.x; asm volatile("" : "+v"(tid)); const int gtid = bid * NTH + tid; (void)gtid;
  float* MOD = (float*)(ws + OFF_MOD);
  float* SUMSQ = (float*)(ws + OFF_SUMSQ);
  float* ROPE = (float*)(ws + OFF_ROPE);
  bf16_t* U = (bf16_t*)(p.out + OOFF_U);
  bf16_t* WBT = (bf16_t*)(p.out + OOFF_WB);
  bf16_t* WA1 = (bf16_t*)(ws + OFF_WA);
  bf16_t* WA2 = WA1 + (size_t)6400 * 2048;

#if (PHASE_MASK >> 0) & 1
  {
  FRESH_TID();
  for (int u = bid; u < 192; u += nb) {
    const int ks = u / 24, j = (u % 24) * NTH + tid;
    float* sc = (float*)smem;
    __syncthreads();
    if (tid < 256) { sc[tid] = siluf_(p.c[ks * 256 + tid]); sc[256 + tid] = siluf_(p.c_ctx[ks * 256 + tid]); }
    __syncthreads();
    float a0 = 0.f, a1 = 0.f;
    for (int k0 = 0; k0 < 256; k0 += 16) {
      float w[16];
#pragma unroll
      for (int e = 0; e < 16; ++e) w[e] = p.w_mod[(size_t)(ks * 256 + k0 + e) * 12288 + j];
#pragma unroll
      for (int e = 0; e < 16; ++e) { a0 += sc[k0 + e] * w[e]; a1 += sc[256 + k0 + e] * w[e]; }
    }
    if (ks == 0) { const float b = p.b_mod[j]; a0 += b; a1 += b; }
    atomicAdd(MOD + j, a0);
    atomicAdd(MOD + 12288 + j, a1);
  }
  __syncthreads();
  for (int i = gtid; i < 256 * 32; i += gnth) {
    const int pos = i >> 5, d = i & 31;
    const float freq = exp2f(-(float)d * (13.287712379549449f / 32.0f));
    const float rev = (float)pos * freq * 0.15915494309189535f;
    const float fr_ = rev - floorf(rev);
    ROPE[i * 2 + 0] = __builtin_amdgcn_cosf(fr_);
    ROPE[i * 2 + 1] = __builtin_amdgcn_sinf(fr_);
  }
  convert_segment(p.w_in, INC, 0, 2048, 2048, WA1, true);
  convert_segment(p.w_in, INC, 2048, 2048, 2048, WA1 + (size_t)2048 * 2048, true);
  convert_segment(p.w_in, INC, 16384, 2048, 2048, WA1 + (size_t)4096 * 2048, false);
  convert_segment(p.w_in, INC, 18432, 128, 2048, WA1 + (size_t)6144 * 2048, false);
  convert_segment(p.w_in, INC, 4096, 2048, 2048, WA2, false);
  convert_segment(p.w_in, INC, 12288, 4096, 2048, WA2 + (size_t)2048 * 2048, false);
  }
#endif
  if (p.ws == nullptr) grid.sync();
  xcd_barrier(xb);

#if (PHASE_MASK >> 1) & 1
  for (int rep_ = 0; rep_ < 1 + ((DUP_MASK >> 1) & 1); ++rep_) {
  modnorm_rows(p.ctx, CTX, p.x, SEQ, p.norm1_w, MOD + 12288 + 2048, MOD + 12288, MOD + 2048, MOD, U);
  }
#endif
  xcd_barrier(xb);

#if (PHASE_MASK >> 2) & 1
  for (int rep_ = 0; rep_ < 1 + ((DUP_MASK >> 2) & 1); ++rep_) {
  {
    EpiA1 e1{(bf16_t*)(ws + OFF_Q), (bf16_t*)(ws + OFF_K), (bf16_t*)(ws + OFF_BCRAW), (float*)(ws + OFF_DTRAW), ROPE};
    EpiA2 e2{(bf16_t*)(ws + OFF_VT), (bf16_t*)(ws + OFF_XTRAW)};
    const int n1 = 65 * 25, n2 = 24 * 65;
    for (int L = bid; L < n1 + n2; L += nb) {
      int pm, pn;
      if (L < n2) { unit_map(L, 24, 65, pm, pn); gemm_unit(WA2, 2048, U, 2048, 2048, pm, pn, e2); }
      else { unit_map(L - n2, 65, 25, pm, pn); gemm_unit(U, 2048, WA1, 2048, 2048, pm, pn, e1); }
    }
    {
      int tid = threadIdx.x;
      asm volatile("" : "+v"(tid));
      unsigned* qhead = (unsigned*)(ws + OFF_BAR) + 3520;
      volatile unsigned* bc = (volatile unsigned*)(smem + 66560);
      for (;;) {
        __syncthreads();
        if (tid == 0) *bc = atomicAdd(qhead, 1u);
        __syncthreads();
        const int t = (int)*bc;
        if (t >= 2304) break;
        if (t < 256) convert_tile(p.w_in, INC, 6144, 2048, WBT, t >> 5, t & 31, tid);
        else if (t < 768) convert_tile(p.w_in, INC, 8192, 2048, WBT + (size_t)2048 * 2048, (t - 256) >> 5, (t - 256) & 31, tid);
        else if (t < 1280) convert_tile(p.w_in, INC, 18560, 2048, WBT + (size_t)6144 * 2048, (t - 768) >> 5, (t - 768) & 31, tid);
        else if (t < 1536) convert_tile(p.w_ret_out, 2048, 0, 2048, (bf16_t*)(ws + OFF_WRO), (t - 1280) >> 5, (t - 1280) & 31, tid);
        else if (t < 2048) convert_tile(p.w_ssd_out, 2048, 0, 4096, (bf16_t*)(ws + OFF_WSO), (t - 1536) >> 6, (t - 1536) & 63, tid);
        else convert_tile(p.w_o, 2048, 0, 2048, (bf16_t*)(ws + OFF_WO), (t - 2048) >> 5, (t - 2048) & 31, tid);
      }
      __syncthreads();
    }
  }
  }
#endif
  xcd_barrier(xb);
  PROBE_POINT(2, OFF_Q, OFF_XT, OFF_SR, OFF_WA)

#if (PHASE_MASK >> 3) & 1
  for (int rep_ = 0; rep_ < 1 + ((DUP_MASK >> 3) & 1); ++rep_) {
  {
  FRESH_TID();
  {
    float* DTRAW = (float*)(ws + OFF_DTRAW);
    float* DTF = (float*)(ws + OFF_DTF); float* DTB = (float*)(ws + OFF_DTB);
    float* CSF = (float*)(ws + OFF_CSF); float* RCSB = (float*)(ws + OFF_RCSB);
    if ((tid >> 6) == 0) {
      for (int w = bid; w < NCH * 2; w += nb) {
        const int c = w >> 1, dir = w & 1, h = tid & 63;
        const float bias = p.ssd_dt_bias[dir * 64 + h], a = -__expf(p.ssd_a_log[dir * 64 + h]);
        float* __restrict__ DTO = dir ? DTB : DTF;
        float* __restrict__ CSO = dir ? RCSB : CSF;
        float cs = 0.f;
        for (int jb = 0; jb < CH; jb += 16) {
          float raw[16];
#pragma unroll
          for (int e = 0; e < 16; ++e) {
            const int j = dir ? (CH - 1 - jb - e) : (jb + e);
            raw[e] = DTRAW[((size_t)c * CH + j) * 128 + dir * 64 + h];
          }
#pragma unroll
          for (int e = 0; e < 16; ++e) {
            const int j = dir ? (CH - 1 - jb - e) : (jb + e);
            const size_t r = (size_t)c * CH + j;
            const float dt = softplusf_(raw[e] + bias);
            cs += dt * a;
            DTO[r * 64 + h] = dt; CSO[r * 64 + h] = cs;
          }
        }
      }
    }
    const bf16_t* __restrict__ BCRAW = (const bf16_t*)(ws + OFF_BCRAW);
    bf16_t* __restrict__ Bb = (bf16_t*)(ws + OFF_B); bf16_t* __restrict__ Cb = (bf16_t*)(ws + OFF_C);
#pragma unroll 2
    for (int i = gtid; i < R * 256; i += gnth) {
      const int r = i >> 8, c8 = (i & 255) * 8;
      const int s0 = r < CTX ? 0 : CTX, s1 = r < CTX ? CTX : R;
      bf16x8 xv[5];
      float msk[5];
#pragma unroll
      for (int j = 0; j < 5; ++j) {
        const int rr = r + j - 2;
        const bool ok = rr >= s0 && rr < s1;
        msk[j] = ok ? 1.f : 0.f;
        xv[j] = *(const bf16x8*)(BCRAW + (size_t)(ok ? rr : r) * 2048 + c8);
      }
      const float* cwp = p.conv_w + 4096 + c8;
      const f32x4 b0 = *(const f32x4*)(p.conv_b + 4096 + c8), b1 = *(const f32x4*)(p.conv_b + 4096 + c8 + 4);
      float a[8] = {b0[0], b0[1], b0[2], b0[3], b1[0], b1[1], b1[2], b1[3]};
#pragma unroll
      for (int j = 0; j < 5; ++j) {
        const f32x4 w0 = *(const f32x4*)(cwp + (size_t)j * 6144) * msk[j], w1 = *(const f32x4*)(cwp + (size_t)j * 6144 + 4) * msk[j];
#pragma unroll
        for (int e = 0; e < 4; ++e) { a[e] += bf2f((unsigned short)xv[j][e]) * w0[e]; a[4 + e] += bf2f((unsigned short)xv[j][4 + e]) * w1[e]; }
      }
      u32x4 w;
      w.x = cvt_pk_bf16(siluf_(a[0]), siluf_(a[1])); w.y = cvt_pk_bf16(siluf_(a[2]), siluf_(a[3]));
      w.z = cvt_pk_bf16(siluf_(a[4]), siluf_(a[5])); w.w = cvt_pk_bf16(siluf_(a[6]), siluf_(a[7]));
      bf16_t* dst = c8 < 1024 ? Bb + (size_t)r * 1024 + c8 : Cb + (size_t)r * 1024 + (c8 - 1024);
      *(u32x4*)dst = w;
    }
    const bf16_t* __restrict__ XTRAW = (const bf16_t*)(ws + OFF_XTRAW);
    bf16_t* __restrict__ XT = (bf16_t*)(ws + OFF_XT);
#pragma unroll 2
    for (int i = gtid; i < 4096 * (R / 16); i += gnth) {
      const int ch = i / (R / 16), t16 = (i % (R / 16)) * 16;
      const int s0 = t16 < CTX ? 0 : CTX, s1 = t16 < CTX ? CTX : R;
      const bf16_t* src = XTRAW + (size_t)ch * R;
      const bool okp = t16 - 8 >= s0, okn = t16 + 16 < s1;
      const bf16x8 vp = *(const bf16x8*)(src + (okp ? t16 - 8 : t16));
      const bf16x8 v0 = *(const bf16x8*)(src + t16);
      const bf16x8 v1 = *(const bf16x8*)(src + t16 + 8);
      const bf16x8 vn = *(const bf16x8*)(src + (okn ? t16 + 16 : t16));
      float x[20];
      x[0] = okp ? bf2f((unsigned short)vp[6]) : 0.f;
      x[1] = okp ? bf2f((unsigned short)vp[7]) : 0.f;
#pragma unroll
      for (int e = 0; e < 8; ++e) { x[2 + e] = bf2f((unsigned short)v0[e]); x[10 + e] = bf2f((unsigned short)v1[e]); }
      x[18] = okn ? bf2f((unsigned short)vn[0]) : 0.f;
      x[19] = okn ? bf2f((unsigned short)vn[1]) : 0.f;
      float wj[5];
#pragma unroll
      for (int j = 0; j < 5; ++j) wj[j] = p.conv_w[(size_t)j * 6144 + ch];
      const float cb = p.conv_b[ch];
      float o[16];
#pragma unroll
      for (int e = 0; e < 16; ++e) {
        float a = cb;
#pragma unroll
        for (int j = 0; j < 5; ++j) a += x[e + j] * wj[j];
        o[e] = siluf_(a);
      }
      u32x4 w;
      w.x = cvt_pk_bf16(o[0], o[1]); w.y = cvt_pk_bf16(o[2], o[3]); w.z = cvt_pk_bf16(o[4], o[5]); w.w = cvt_pk_bf16(o[6], o[7]);
      *(u32x4*)(XT + (size_t)ch * R + t16) = w;
      w.x = cvt_pk_bf16(o[8], o[9]); w.y = cvt_pk_bf16(o[10], o[11]); w.z = cvt_pk_bf16(o[12], o[13]); w.w = cvt_pk_bf16(o[14], o[15]);
      *(u32x4*)(XT + (size_t)ch * R + t16 + 8) = w;
    }
  }
  }
  }
#endif
  xcd_barrier(xb);
  PROBE_POINT(3, OFF_XT, OFF_DTRAW, OFF_DTF, OFF_SR)

#if (PHASE_MASK >> 4) & 1
  for (int rep_ = 0; rep_ < 1 + ((DUP_MASK >> 4) & 1); ++rep_) {
  for (int it = bid; it < NCH * 24; it += nb) {
    if (it < NCH * 8) state_build_item<1>(p, it >> 3, it & 7);
    else { const int r = it - NCH * 8; state_build_item<0>(p, r >> 4, r & 15); }
  }
  }
#endif
  xcd_barrier(xb);
  PROBE_POINT(4, OFF_SR, OFF_WA, 0, 0)

#if (PHASE_MASK >> 5) & 1
  for (int rep_ = 0; rep_ < 1 + ((DUP_MASK >> 5) & 1); ++rep_) {
  {
  FRESH_TID();
  {
    bf16_t* SR = (bf16_t*)(ws + OFF_SR);
    bf16_t* SS = (bf16_t*)(ws + OFF_SS);
    const float* CSF = (const float*)(ws + OFF_CSF); const float* RCSB = (const float*)(ws + OFF_RCSB);
    for (int i = gtid; i < 65536 + 131072; i += gnth) {
      bf16_t* base; size_t cstride; int dir, h; bool isr = i < 65536;
      if (isr) { const int e = i * 8; dir = e / (16 * 16384); h = (e / 16384) & 15; base = SR + e; cstride = 524288; }
      else { const int e = (i - 65536) * 8; h = e / 16384; dir = (e / 8192) & 1; base = SS + e; cstride = 1048576; }
      float decr = 0.f;
      if (isr) { const float lg = -log1pf(__expf(-p.ret_decay_logit[dir * 16 + h])); decr = __expf(256.0f * lg); }
      float H[8];
#pragma unroll
      for (int e = 0; e < 8; ++e) H[e] = 0.f;
      u32x4 q[4]; float dq[4];
#pragma unroll
      for (int k = 0; k < 4; ++k) {
        const int c = dir == 0 ? k : (k == 0 ? 0 : NCH - k);
        q[k] = *(const u32x4*)(base + (size_t)c * cstride);
        dq[k] = isr ? 0.f : (dir == 0 ? CSF[((size_t)c * CH + 255) * 64 + h] : RCSB[((size_t)c * CH) * 64 + h]);
      }
      for (int s0 = 0; s0 < NCH; s0 += 4) {
#pragma unroll
        for (int k = 0; k < 4; ++k) {
          const int s = s0 + k;
          if (s < NCH) {
            const int c = dir == 0 ? s : (s == 0 ? 0 : NCH - s);
            bf16_t* ptr = base + (size_t)c * cstride;
            const u32x4 tv = q[k];
            const float dl = dq[k];
            if (s + 4 < NCH) {
              const int cn = dir == 0 ? s + 4 : NCH - (s + 4);
              q[k] = *(const u32x4*)(base + (size_t)cn * cstride);
              dq[k] = isr ? 0.f : (dir == 0 ? CSF[((size_t)cn * CH + 255) * 64 + h] : RCSB[((size_t)cn * CH) * 64 + h]);
            }
            u32x4 hv;
            hv.x = cvt_pk_bf16(H[0], H[1]); hv.y = cvt_pk_bf16(H[2], H[3]); hv.z = cvt_pk_bf16(H[4], H[5]); hv.w = cvt_pk_bf16(H[6], H[7]);
            if (rep_ == ((DUP_MASK >> 5) & 1) || p.ws == nullptr) *(u32x4*)ptr = hv;
            const float dec = isr ? decr : __expf(dl);
            H[0] = dec * H[0] + bflo(tv.x); H[1] = dec * H[1] + bfhi(tv.x);
            H[2] = dec * H[2] + bflo(tv.y); H[3] = dec * H[3] + bfhi(tv.y);
            H[4] = dec * H[4] + bflo(tv.z); H[5] = dec * H[5] + bfhi(tv.z);
            H[6] = dec * H[6] + bflo(tv.w); H[7] = dec * H[7] + bfhi(tv.w);
          }
        }
      }
    }
  }
  }
  }
#endif
  xcd_barrier(xb);
  PROBE_POINT(5, OFF_SR, OFF_WA, 0, 0)

#if (PHASE_MASK >> 6) & 1
  for (int rep_ = 0; rep_ < 1 + ((DUP_MASK >> 6) & 1); ++rep_) {
  for (int it = bid; it < 64 * 16 * 2; it += nb) {
    const int half = (it >> 3) & 1, q = ((it >> 4) << 3) | (it & 7), h = q & 15, cc = 1 + (q >> 4);
    ret_out_item(p, cc, h, half, rep_ == ((DUP_MASK >> 6) & 1) || p.ws == nullptr);
  }
  }
#endif
  xcd_barrier(xb);
  PROBE_POINT(6, OFF_Q, OFF_K, 0, 0)

#if (PHASE_MASK >> 7) & 1
  for (int rep_ = 0; rep_ < 1 + ((DUP_MASK >> 7) & 1); ++rep_) {
  for (int ph = 0; ph < 2; ++ph) {
    if ((ph == 0) == ((bid & 1) != 0)) {
      convert_segment(p.w_mlp1, DFF, 0, DFF, 2048, (bf16_t*)(ws + OFF_W1T), false, MOD + 6144, (float*)(ws + OFF_BIAS1));
      convert_segment(p.w_mlp2, 2048, 0, 2048, DFF, (bf16_t*)(ws + OFF_W2T), false);
    }
    if (ph == 0) {
      for (int it = bid; it < 64 * 8 * 2; it += nb) {
        const int half = (it >> 3) & 1, q = ((it >> 4) << 3) | (it & 7), g = q & 7, cc = 1 + (q >> 3);
        ssd_out_item(p, cc, g, half);
      }
    }
  }
  }
#endif
  xcd_barrier(xb);
  PROBE_POINT(7, OFF_YS, OFF_XT, OFF_SR, OFF_SS)

#if (PHASE_MASK >> 8) & 1
  for (int rep_ = 0; rep_ < 1 + ((DUP_MASK >> 8) & 1); ++rep_) {
  {
    EpiB e{(bf16_t*)(ws + OFF_Q), (bf16_t*)(ws + OFF_YS), (bf16_t*)(ws + OFF_G), p.ssd_norm_w, SUMSQ};
    for (int L = bid; L < 64 * 40; L += nb) {
      int pm, pn; unit_map(L, 64, 40, pm, pn);
      gemm_unit(U + (size_t)CTX * 2048, 2048, WBT, 2048, 2048, pm, pn, e);
    }
  }
  }
#endif
  xcd_barrier(xb);
  PROBE_POINT(8, OFF_Q, OFF_B, 0, 0)

#if (PHASE_MASK >> 9) & 1
  for (int rep_ = 0; rep_ < 1 + ((DUP_MASK >> 9) & 1); ++rep_) {
  {
    EpiO1a ea{(const bf16_t*)(ws + OFF_G), (bf16_t*)(ws + OFF_M)};
    EpiO1b eb{(const bf16_t*)(ws + OFF_G), SUMSQ, (bf16_t*)(ws + OFF_M)};
    for (int L = bid; L < 64 * 8; L += nb) {
      int pm, pn; unit_map(L, 64, 8, pm, pn);
      gemm_unit((const bf16_t*)(ws + OFF_Q) + (size_t)CTX * 2048, 2048, (const bf16_t*)(ws + OFF_WRO), 2048, 2048, pm, pn, ea);
      gemm_unit((const bf16_t*)(ws + OFF_YS), 4096, (const bf16_t*)(ws + OFF_WSO), 4096, 4096, pm, pn, eb);
    }
  }
  }
#endif
  xcd_barrier(xb);
  PROBE_POINT(9, OFF_M, OFF_DTRAW, 0, 0)

#if (PHASE_MASK >> 10) & 1
  for (int rep_ = 0; rep_ < 1 + ((DUP_MASK >> 10) & 1); ++rep_) {
  {
    EpiRes9 e{p.x, MOD + 4096, (float*)(ws + OFF_H1), p.norm2_w, MOD + 8192, (bf16_t*)(ws + OFF_F), (float*)(ws + OFF_SUMSQ2)};
    for (int L = bid; L < 64 * 8; L += nb) {
      int pm, pn; unit_map(L, 64, 8, pm, pn);
      gemm_unit((const bf16_t*)(ws + OFF_M), 2048, (const bf16_t*)(ws + OFF_WO), 2048, 2048, pm, pn, e);
    }
  }
  }
#endif
  xcd_barrier(xb);
  PROBE_POINT(10, OFF_H1, OFF_H1 + (size_t)SEQ * DM * 4, 0, 0)

#if (PHASE_MASK >> 12) & 1
  for (int rep_ = 0; rep_ < 1 + ((DUP_MASK >> 12) & 1); ++rep_) {
  {
    EpiM1 e{(bf16_t*)(ws + OFF_A1), (const float*)(ws + OFF_SUMSQ2), (const float*)(ws + OFF_BIAS1)};
    for (int L = bid; L < 64 * 32; L += nb) {
      int pm, pn; unit_map(L, 64, 32, pm, pn);
      gemm_unit((const bf16_t*)(ws + OFF_F), 2048, (const bf16_t*)(ws + OFF_W1T), 2048, 2048, pm, pn, e);
    }
  }
  }
#endif
  xcd_barrier(xb);
  PROBE_POINT(12, OFF_A1, OFF_A1 + (size_t)SEQ * DFF * 2, 0, 0)

#if (PHASE_MASK >> 13) & 1
  for (int rep_ = 0; rep_ < 1 + ((DUP_MASK >> 13) & 1); ++rep_) {
  {
    EpiRes e{(const float*)(ws + OFF_H1), MOD + 10240, (float*)(ws + OFF_H1), rep_ == ((DUP_MASK >> 13) & 1) || p.ws == nullptr};
    for (int L = bid; L < 64 * 8; L += nb) {
      int pm, pn; unit_map(L, 64, 8, pm, pn);
      gemm_unit((const bf16_t*)(ws + OFF_A1), DFF, (const bf16_t*)(ws + OFF_W2T), DFF, DFF, pm, pn, e);
    }
  }
  }
#endif
  xcd_barrier(xb);
  PROBE_POINT(13, OFF_H1, OFF_H1 + (size_t)SEQ * DM * 4, 0, 0)

#if (PHASE_MASK >> 14) & 1
  for (int rep_ = 0; rep_ < 1 + ((DUP_MASK >> 14) & 1); ++rep_) {
  {
  FRESH_TID();
  {
    const float* H2 = (const float*)(ws + OFF_H1);
    float* outp = (float*)p.out;
    const int lane = tid & 63, gw = bid * (NTH / 64) + (tid >> 6), nw_ = nb * (NTH / 64);
    for (int r = gw; r < SEQ; r += nw_) {
      f32x4 v[8];
      float ss = 0.f;
#pragma unroll
      for (int i = 0; i < 8; ++i) { v[i] = *(const f32x4*)(H2 + (size_t)r * DM + i * 256 + lane * 4); ss += v[i][0] * v[i][0] + v[i][1] * v[i][1] + v[i][2] * v[i][2] + v[i][3] * v[i][3]; }
      ss = wave_sum(ss);
      const float rs = rsqrtf(ss * (1.0f / DM) + EPS);
#pragma unroll
      for (int i = 0; i < 8; ++i) {
        const f32x4 w = *(const f32x4*)(p.final_norm_w + i * 256 + lane * 4);
        f32x4 o = v[i] * rs * w;
        *(f32x4*)(outp + (size_t)r * DM + i * 256 + lane * 4) = o;
      }
    }
  }
  }
  }
#endif
}

extern "C" void kernel_launch(void* const* d_in, const int* in_sizes, int n_in, void* d_out, int out_size, void* d_ws, size_t ws_size,
                              hipStream_t stream) {
  static int grid_blocks = 0;
  if (!grid_blocks) {
    int dev = 0, cus = 0, per_cu = 0;
    (void)hipGetDevice(&dev);
    (void)hipDeviceGetAttribute(&cus, hipDeviceAttributeMultiprocessorCount, dev);
    (void)hipFuncSetAttribute((const void*)mega, hipFuncAttributeMaxDynamicSharedMemorySize, LDS_BYTES);
    (void)hipOccupancyMaxActiveBlocksPerMultiprocessor(&per_cu, mega, NTH, LDS_BYTES);
    if (per_cu > 1) per_cu = 1;
    grid_blocks = cus * per_cu;
  }
  if (ws_size < WS_NEED || grid_blocks <= 0) { fprintf(stderr, "workspace too small or no occupancy\n"); return; }
  Params p{};
  const float** pp = (const float**)&p;
  for (int i = 0; i < 23; ++i) pp[i] = (const float*)d_in[i];
  p.ws = (unsigned char*)d_ws;
  p.out = (unsigned char*)d_out;
  (void)hipMemsetAsync((unsigned char*)d_ws + OFF_MOD, 0, OFF_ROPE - OFF_MOD, stream);
  void* args[] = {&p};
  hipError_t e = hipLaunchCooperativeKernel((void*)mega, dim3(grid_blocks), dim3(NTH), args, LDS_BYTES, stream);
  if (e != hipSuccess) fprintf(stderr, "cooperative launch failed: %s (grid %d)\n", hipGetErrorString(e), grid_blocks);
}
```

```cpp
#include <hip/hip_runtime.h>
#include <hip/hip_cooperative_groups.h>
#include <cstdio>
#include <cstdint>
namespace cg = cooperative_groups;

typedef unsigned short bf16_t;
typedef short bf16x8 __attribute__((ext_vector_type(8)));
typedef short bf16x4 __attribute__((ext_vector_type(4)));
typedef float f32x4 __attribute__((ext_vector_type(4)));
typedef float f32x2 __attribute__((ext_vector_type(2)));
typedef unsigned u32x4 __attribute__((ext_vector_type(4)));
typedef unsigned u32x2 __attribute__((ext_vector_type(2)));

constexpr int DM = 2048, SEQ = 16384, CTX = 256, R = SEQ + CTX, CH = 256, NCH = 65;
constexpr int INC = 22656, DFF = 8192;
constexpr float EPS = 1e-6f;
constexpr int NTH = 512;
constexpr int LDS_BYTES = 147456;
#ifndef DUP_MASK
#define DUP_MASK 0
#endif
#ifndef PHASE_MASK
#define PHASE_MASK 0x7fff
#endif

constexpr size_t SZQ = (size_t)R * 2048 * 2;
constexpr size_t OFF_Q = 0;
constexpr size_t OFF_K = OFF_Q + SZQ;
constexpr size_t OFF_VT = OFF_K + SZQ;
constexpr size_t OFF_XT = OFF_VT + SZQ;
constexpr size_t OFF_B = OFF_XT + 2 * SZQ;
constexpr size_t OFF_C = OFF_B + SZQ / 2;
constexpr size_t OFF_DTRAW = OFF_C + SZQ / 2;
constexpr size_t SZ_DTA = (size_t)R * 64 * 4;
constexpr size_t OFF_DTF = OFF_DTRAW + (size_t)R * 128 * 4;
constexpr size_t OFF_DTB = OFF_DTF + SZ_DTA;
constexpr size_t OFF_CSF = OFF_DTB + SZ_DTA;
constexpr size_t OFF_RCSB = OFF_CSF + SZ_DTA;
constexpr size_t OFF_SR = OFF_RCSB + SZ_DTA;
constexpr size_t OFF_SS = OFF_SR + SZQ;
constexpr size_t OFF_WA = OFF_SS + 2 * SZQ;
constexpr size_t OFF_WRO = OFF_WA + (size_t)12544 * 2048 * 2;
constexpr size_t OFF_WSO = OFF_WRO + (size_t)2048 * 2048 * 2;
constexpr size_t OFF_WO = OFF_WSO + (size_t)2048 * 4096 * 2;
constexpr size_t OFF_MOD = OFF_WO + (size_t)2048 * 2048 * 2;
constexpr size_t OFF_SUMSQ = OFF_MOD + 2 * 12288 * 4;
constexpr size_t OFF_BAR = OFF_SUMSQ + (size_t)SEQ * 4;
constexpr size_t OFF_SUMSQ2 = OFF_BAR + 16384;
constexpr size_t OFF_BIAS1 = OFF_SUMSQ2 + (size_t)SEQ * 4;
constexpr size_t OFF_ROPE = OFF_BIAS1 + (size_t)DFF * 4;
constexpr size_t WS_NEED = OFF_ROPE + 256 * 32 * 2 * 4;
constexpr size_t OFF_BCRAW = OFF_SR, OFF_XTRAW = OFF_SS, OFF_YS = OFF_K, OFF_W1T = OFF_SR, OFF_W2T = OFF_SR + (size_t)8192 * 2048 * 2;
constexpr size_t OFF_G = OFF_XT, OFF_H1 = OFF_SS, OFF_M = OFF_B, OFF_F = OFF_Q, OFF_A1 = OFF_K;
constexpr size_t OOFF_U = 0, OOFF_WB = SZQ;

struct Params {
  const float *x, *c, *ctx, *c_ctx, *w_mod, *b_mod, *norm1_w, *w_in, *conv_w, *conv_b, *ret_decay_logit, *ret_norm_w, *ssd_a_log,
      *ssd_dt_bias, *ssd_d, *ssd_norm_w, *w_ret_out, *w_ssd_out, *w_o, *norm2_w, *w_mlp1, *w_mlp2, *final_norm_w;
  unsigned char* ws;
  unsigned char* out;
};

extern __shared__ __attribute__((aligned(16))) unsigned char smem[];

typedef __bf16 bf16x2_t __attribute__((ext_vector_type(2)));
__device__ __forceinline__ unsigned cvt_pk_bf16(float lo, float hi) {
  f32x2 v = {lo, hi};
  bf16x2_t b = __builtin_convertvector(v, bf16x2_t);
  return __builtin_bit_cast(unsigned, b);
}
__device__ __forceinline__ float bf2f(unsigned short v) { return __uint_as_float((unsigned)v << 16); }
__device__ __forceinline__ float bflo(unsigned v) { return __uint_as_float(v << 16); }
__device__ __forceinline__ float bfhi(unsigned v) { return __uint_as_float(v & 0xffff0000u); }
__device__ __forceinline__ float sigmoidf_(float x) { return __builtin_amdgcn_rcpf(1.0f + __expf(-x)); }
__device__ __forceinline__ float siluf_(float x) { return x * __builtin_amdgcn_rcpf(1.0f + __expf(-x)); }
__device__ __forceinline__ float softplusf_(float x) { const float e = __expf(x); return x > 20.f ? x : (x < -6.f ? e * (1.0f - 0.5f * e) : __logf(1.0f + e)); }
__device__ __forceinline__ float wave_sum(float v) {
#pragma unroll
  for (int o = 32; o > 0; o >>= 1) v += __shfl_xor(v, o);
  return v;
}
__device__ __forceinline__ bf16x8 mk8(bf16x4 a, bf16x4 b) { return __builtin_shufflevector(a, b, 0, 1, 2, 3, 4, 5, 6, 7); }
__device__ __forceinline__ bf16x8 as_bf16x8(u32x4 v) { union { u32x4 u; bf16x8 b; } x; x.u = v; return x.b; }
__device__ __forceinline__ u32x4 as_u32x4(bf16x8 v) { union { u32x4 u; bf16x8 b; } x; x.b = v; return x.u; }
#define MFMA(a, b, c) __builtin_amdgcn_mfma_f32_16x16x32_bf16((a), (b), (c), 0, 0, 0)

constexpr int BM = 256, BK = 64, HALF = 128, HT = HALF * BK;
__device__ __forceinline__ int lds_byte(int r, int c) {
  int st = (r >> 4) * 2 + (c >> 5), rr = r & 15, cc = c & 31, ob = rr * 64 + cc * 2;
  return st * 1024 + (ob ^ (((ob >> 9) & 1) << 5));
}
__device__ __forceinline__ void stage_rc(int b, int& Rr, int& Cc) {
  int st = b / 1024, sb = b % 1024, swz = sb ^ (((sb >> 9) & 1) << 5);
  Rr = (st >> 1) * 16 + swz / 64;
  Cc = (st & 1) * 32 + (swz % 64) / 2;
}

template <class Epi>
__device__ __forceinline__ void gemm_unit(const bf16_t* __restrict__ A, int lda, const bf16_t* __restrict__ Bt, int ldb, int K, int pm,
                                          int pn, const Epi& epi) {
  typedef __attribute__((address_space(3))) unsigned char lds_u8;
  lds_u8* lds = (lds_u8*)smem;
  int tid = threadIdx.x;
  asm volatile("" : "+v"(tid));
  const int wid = __builtin_amdgcn_readfirstlane(tid >> 6), lane = tid & 63, wr = wid >> 2, wc = wid & 3, fr = lane & 15, fq = lane >> 4;
  unsigned voffA[2], voffB[2];
#pragma unroll
  for (int i = 0; i < 2; ++i) {
    int Rr, Cc; stage_rc(tid * 16 + i * 8192, Rr, Cc);
    const int rho = Rr & 31, Rb = (Rr & ~31) + 8 * ((rho & 15) >> 2) + 4 * (rho >> 4) + (rho & 3);
    voffA[i] = (unsigned)(Rr * lda + Cc) * 2u; voffB[i] = (unsigned)(Rb * ldb + Cc) * 2u;
  }
  const size_t kstep = (size_t)(BK * 2);
  const size_t hstepA = (size_t)HALF * lda * 2, hstepB = (size_t)HALF * ldb * 2;
  const unsigned ldsw = (unsigned)wid * 1024u;
  const int aoff = lds_byte(wr * 64 + fr, fq * 8), boff = lds_byte(wc * 32 + fr, fq * 8);
  constexpr int HTB = HT * 2;
#define SAo(b, h) (((b) * 2 + (h)) * HTB)
#define SBo(b, h) ((4 + (b) * 2 + (h)) * HTB)
#define STAGE(bufoff, gbase, voff) do { _Pragma("unroll") for (int _i = 0; _i < 2; ++_i) \
    __builtin_amdgcn_global_load_lds((const unsigned*)((const char*)(gbase) + (voff)[_i]), (__attribute__((address_space(3))) unsigned*)(lds + (bufoff) + ldsw + _i * 8192), 16, 0, 0); } while (0)
#define LDA(dst, b, h) do { _Pragma("unroll") for (int m = 0; m < 4; ++m) _Pragma("unroll") for (int k = 0; k < 2; ++k) dst[m][k] = *(const __attribute__((address_space(3))) bf16x8*)(lds + SAo(b, h) + aoff + m * 2048 + k * 1024); } while (0)
#define LDB(dst, b, h) do { _Pragma("unroll") for (int n = 0; n < 2; ++n) _Pragma("unroll") for (int k = 0; k < 2; ++k) dst[n][k] = *(const __attribute__((address_space(3))) bf16x8*)(lds + SBo(b, h) + boff + n * 2048 + k * 1024); } while (0)
#define MMA(ai, bj, At_, Bt_) do { __builtin_amdgcn_s_setprio(1); _Pragma("unroll") for (int m = 0; m < 4; ++m) _Pragma("unroll") for (int n = 0; n < 2; ++n) _Pragma("unroll") for (int k = 0; k < 2; ++k) \
    acc[ai][bj][m][n] = MFMA(Bt_[n][k], At_[m][k], acc[ai][bj][m][n]); __builtin_amdgcn_s_setprio(0); } while (0)
#define WAIT_V(n) asm volatile("s_waitcnt vmcnt(" #n ")" ::: "memory")
#define WAIT_L(n) asm volatile("s_waitcnt lgkmcnt(" #n ")" ::: "memory")
#define BAR __builtin_amdgcn_s_barrier()
#define SCHED __builtin_amdgcn_sched_barrier(0)
  const int brow = pm * BM, bcol = pn * BM;
  f32x4 acc[2][2][4][2];
#pragma unroll
  for (int a = 0; a < 2; ++a)
#pragma unroll
    for (int b = 0; b < 2; ++b)
#pragma unroll
      for (int m = 0; m < 4; ++m)
#pragma unroll
        for (int n = 0; n < 2; ++n) acc[a][b][m][n] = (f32x4){0.f, 0.f, 0.f, 0.f};
  bf16x8 At[4][2], B0[2][2], B1[2][2];
  const int nt = K / BK;
  const char* cA = (const char*)A + (size_t)brow * lda * 2;
  const char* cB = (const char*)Bt + (size_t)bcol * ldb * 2;
  STAGE(SBo(0, 0), cB, voffB); STAGE(SAo(0, 0), cA, voffA); STAGE(SBo(0, 1), cB + hstepB, voffB); STAGE(SAo(0, 1), cA + hstepA, voffA);
  if (wr == 1) BAR;
  WAIT_V(4); BAR;
  STAGE(SBo(1, 0), cB + kstep, voffB); STAGE(SAo(1, 0), cA + kstep, voffA); STAGE(SBo(1, 1), cB + hstepB + kstep, voffB);
  WAIT_V(6); BAR;
  for (int t = 0; t < nt - 2; t += 2) {
    const char* a1 = cA + (size_t)(t + 1) * kstep;
    const char* a2 = cA + (size_t)(t + 2) * kstep; const char* b2 = cB + (size_t)(t + 2) * kstep;
    const char* a3 = a2 + kstep; const char* b3 = b2 + kstep;
    LDB(B0, 0, 0); SCHED; LDA(At, 0, 0); STAGE(SAo(1, 1), a1 + hstepA, voffA);
    WAIT_L(8); BAR; WAIT_L(0); MMA(0, 0, At, B0); BAR; SCHED;
    LDB(B1, 0, 1); STAGE(SBo(0, 0), b2, voffB);
    BAR; WAIT_L(0); MMA(0, 1, At, B1); BAR;
    LDA(At, 0, 1); STAGE(SAo(0, 0), a2, voffA);
    BAR; WAIT_L(0); MMA(1, 0, At, B0); BAR; SCHED;
    STAGE(SBo(0, 1), b2 + hstepB, voffB);
    WAIT_V(6); BAR; MMA(1, 1, At, B1); BAR;
    LDB(B0, 1, 0); SCHED; LDA(At, 1, 0); STAGE(SAo(0, 1), a2 + hstepA, voffA);
    WAIT_L(8); BAR; WAIT_L(0); MMA(0, 0, At, B0); BAR; SCHED;
    LDB(B1, 1, 1); STAGE(SBo(1, 0), b3, voffB);
    BAR; WAIT_L(0); MMA(0, 1, At, B1); BAR;
    LDA(At, 1, 1); STAGE(SAo(1, 0), a3, voffA);
    BAR; WAIT_L(0); MMA(1, 0, At, B0); BAR; SCHED;
    STAGE(SBo(1, 1), b3 + hstepB, voffB);
    WAIT_V(6); BAR; MMA(1, 1, At, B1); BAR;
  }
  { const char* a1 = cA + (size_t)(nt - 1) * kstep;
    LDB(B0, 0, 0); LDA(At, 0, 0); STAGE(SAo(1, 1), a1 + hstepA, voffA);
    BAR; WAIT_L(0); MMA(0, 0, At, B0); BAR;
    LDB(B1, 0, 1); BAR; WAIT_L(0); MMA(0, 1, At, B1); BAR;
    LDA(At, 0, 1); WAIT_V(4); BAR; WAIT_L(0); MMA(1, 0, At, B0); MMA(1, 1, At, B1); BAR; }
  { LDB(B0, 1, 0); LDA(At, 1, 0); WAIT_V(2); BAR; WAIT_L(0); MMA(0, 0, At, B0); BAR;
    LDB(B1, 1, 1); WAIT_V(0); BAR; WAIT_L(0); MMA(0, 1, At, B1); BAR;
    LDA(At, 1, 1); BAR; WAIT_L(0); MMA(1, 0, At, B0); MMA(1, 1, At, B1); BAR; }
  if (wr == 0) BAR;
#pragma unroll
  for (int ai = 0; ai < 2; ++ai)
#pragma unroll
    for (int m = 0; m < 4; ++m) {
      const int row = brow + ai * HALF + wr * 64 + m * 16 + fr;
#pragma unroll
      for (int bj = 0; bj < 2; ++bj)
#pragma unroll
        for (int n = 0; n < 2; ++n) epi(acc[ai][bj][m][n], row, bcol + bj * HALF + wc * 32 + fq * 8 + n * 4, pm, pn);
      asm volatile("" ::: "memory");
    }
  __syncthreads();
}

__device__ __forceinline__ void unit_map(int wgid, int nM, int nN, int& pm, int& pn) {
  const int nwg = nM * nN, NX = 8, WGM = 4;
  { const int q = nwg / NX, r = nwg % NX, xcd = wgid % NX, off = wgid / NX; wgid = (xcd < r ? xcd * (q + 1) : r * (q + 1) + (xcd - r) * q) + off; }
  const int nig = WGM * nN, gid = wgid / nig, fm = gid * WGM, gsz = (nM - fm) < WGM ? (nM - fm) : WGM;
  pm = fm + ((wgid % nig) % gsz);
  pn = (wgid % nig) / gsz;
}

struct EpiA1 {
  bf16_t *Q, *Kb, *BC; float* DTRAW; const float* rope;
  __device__ __forceinline__ void operator()(const f32x4& v, int row, int col, int pm, int pn) const {
    if (pn < 16) {
      f32x4 o = v;
      const bool isk = pn >= 8;
      if (isk) o = o * 0.08838834764831845f;
      if (pm > 0) {
        const int t = row - CTX, cl = col & 127, half = cl >> 6, d0 = (cl & 63) >> 1;
        const int pos = half ? (t & 63) : (t >> 6);
        const f32x4 cs = *(const f32x4*)(rope + ((size_t)pos * 32 + d0) * 2);
        f32x4 q;
        q[0] = o[0] * cs[0] - o[1] * cs[1]; q[1] = o[0] * cs[1] + o[1] * cs[0];
        q[2] = o[2] * cs[2] - o[3] * cs[3]; q[3] = o[2] * cs[3] + o[3] * cs[2];
        o = q;
      }
      u32x2 w; w.x = cvt_pk_bf16(o[0], o[1]); w.y = cvt_pk_bf16(o[2], o[3]);
      bf16_t* dst = (isk ? Kb : Q) + (size_t)row * 2048 + (col & 2047);
      *(u32x2*)dst = w;
    } else if (pn < 24) {
      u32x2 w; w.x = cvt_pk_bf16(v[0], v[1]); w.y = cvt_pk_bf16(v[2], v[3]);
      *(u32x2*)(BC + (size_t)row * 2048 + (col - 4096)) = w;
    } else {
      const int cl = col - 6144;
      if (cl < 128) *(f32x4*)(DTRAW + (size_t)row * 128 + cl) = v;
    }
  }
};
struct EpiA2 {
  bf16_t *VT, *XTRAW;
  __device__ __forceinline__ void operator()(const f32x4& v, int row, int col, int pm, int pn) const {
    u32x2 w; w.x = cvt_pk_bf16(v[0], v[1]); w.y = cvt_pk_bf16(v[2], v[3]);
    bf16_t* dst = row < 2048 ? VT + (size_t)row * R + col : XTRAW + (size_t)(row - 2048) * R + col;
    *(u32x2*)dst = w;
  }
};
struct EpiB {
  bf16_t *Q, *YS, *G; const float* ssd_norm_w; float* SUMSQ;
  __device__ __forceinline__ void operator()(const f32x4& v, int row, int col, int pm, int pn) const {
    if (pn < 8) {
      bf16_t* p = Q + (size_t)(row + CTX) * 2048 + col;
      const u32x2 y = *(const u32x2*)p;
      u32x2 w;
      w.x = cvt_pk_bf16(bflo(y.x) * siluf_(v[0]), bfhi(y.x) * siluf_(v[1]));
      w.y = cvt_pk_bf16(bflo(y.y) * siluf_(v[2]), bfhi(y.y) * siluf_(v[3]));
      *(u32x2*)p = w;
    } else if (pn < 24) {
      const int zc = col - 2048;
      bf16_t* p = YS + (size_t)row * 4096 + zc;
      const u32x2 y = *(const u32x2*)p;
      const f32x4 nw = *(const f32x4*)(ssd_norm_w + zc);
      const float t0 = bflo(y.x) * siluf_(v[0]), t1 = bfhi(y.x) * siluf_(v[1]), t2 = bflo(y.y) * siluf_(v[2]), t3 = bfhi(y.y) * siluf_(v[3]);
      float ss = t0 * t0 + t1 * t1 + t2 * t2 + t3 * t3;
      ss += __shfl_xor(ss, 16); ss += __shfl_xor(ss, 32);
      if ((threadIdx.x & 48) == 0) atomicAdd(SUMSQ + row, ss);
      u32x2 w; w.x = cvt_pk_bf16(t0 * nw[0], t1 * nw[1]); w.y = cvt_pk_bf16(t2 * nw[2], t3 * nw[3]);
      *(u32x2*)p = w;
    } else {
      u32x2 w; w.x = cvt_pk_bf16(sigmoidf_(v[0]), sigmoidf_(v[1])); w.y = cvt_pk_bf16(sigmoidf_(v[2]), sigmoidf_(v[3]));
      *(u32x2*)(G + (size_t)row * 4096 + (col - 6144)) = w;
    }
  }
};
struct EpiO1a {
  const bf16_t* G; bf16_t* M;
  __device__ __forceinline__ void operator()(const f32x4& v, int row, int col, int pm, int pn) const {
    const u32x2 g = *(const u32x2*)(G + (size_t)row * 4096 + col);
    u32x2 w;
    w.x = cvt_pk_bf16(bflo(g.x) * v[0], bfhi(g.x) * v[1]);
    w.y = cvt_pk_bf16(bflo(g.y) * v[2], bfhi(g.y) * v[3]);
    *(u32x2*)(M + (size_t)row * 2048 + col) = w;
  }
};
struct EpiO1b {
  const bf16_t* G; const float* SUMSQ; bf16_t* M;
  __device__ __forceinline__ void operator()(const f32x4& v, int row, int col, int pm, int pn) const {
    const u32x2 g = *(const u32x2*)(G + (size_t)row * 4096 + 2048 + col);
    const float r = rsqrtf(SUMSQ[row] * (1.0f / 4096.0f) + EPS);
    const u32x2 t = *(const u32x2*)(M + (size_t)row * 2048 + col);
    u32x2 w;
    w.x = cvt_pk_bf16(bflo(t.x) + bflo(g.x) * r * v[0], bfhi(t.x) + bfhi(g.x) * r * v[1]);
    w.y = cvt_pk_bf16(bflo(t.y) + bflo(g.y) * r * v[2], bfhi(t.y) + bfhi(g.y) * r * v[3]);
    *(u32x2*)(M + (size_t)row * 2048 + col) = w;
  }
};
struct EpiRes {
  const float* base; const float* gate; float* H; bool do_store;
  __device__ __forceinline__ void operator()(const f32x4& v, int row, int col, int pm, int pn) const {
    const f32x4 b = *(const f32x4*)(base + (size_t)row * 2048 + col);
    const f32x4 g = *(const f32x4*)(gate + col);
    if (do_store) *(f32x4*)(H + (size_t)row * 2048 + col) = b + g * v;
  }
};
struct EpiRes9 {
  const float* base; const float* gate; float* H; const float* nw; const float* scf; bf16_t* F; float* SS2;
  __device__ __forceinline__ void operator()(const f32x4& v, int row, int col, int pm, int pn) const {
    const f32x4 b = *(const f32x4*)(base + (size_t)row * 2048 + col);
    const f32x4 g = *(const f32x4*)(gate + col);
    const f32x4 h = b + g * v;
    *(f32x4*)(H + (size_t)row * 2048 + col) = h;
    const f32x4 w = *(const f32x4*)(nw + col), sc = *(const f32x4*)(scf + col);
    u32x2 o;
    o.x = cvt_pk_bf16(h[0] * w[0] * (1.0f + sc[0]), h[1] * w[1] * (1.0f + sc[1]));
    o.y = cvt_pk_bf16(h[2] * w[2] * (1.0f + sc[2]), h[3] * w[3] * (1.0f + sc[3]));
    *(u32x2*)(F + (size_t)row * 2048 + col) = o;
    float ss = h[0] * h[0] + h[1] * h[1] + h[2] * h[2] + h[3] * h[3];
    ss += __shfl_xor(ss, 16); ss += __shfl_xor(ss, 32);
    if ((threadIdx.x & 48) == 0) atomicAdd(SS2 + row, ss);
  }
};
struct EpiM1 {
  bf16_t* A1; const float* SS2; const float* bias1;
  __device__ __forceinline__ void operator()(const f32x4& v, int row, int col, int pm, int pn) const {
    const float r_ = rsqrtf(SS2[row] * (1.0f / DM) + EPS);
    const f32x4 bi = *(const f32x4*)(bias1 + col);
    f32x4 o;
#pragma unroll
    for (int j = 0; j < 4; ++j) { const float r = fmaxf(v[j] * r_ + bi[j], 0.f); o[j] = r * r; }
    u32x2 w; w.x = cvt_pk_bf16(o[0], o[1]); w.y = cvt_pk_bf16(o[2], o[3]);
    *(u32x2*)(A1 + (size_t)row * DFF + col) = w;
  }
};

__device__ __forceinline__ void convert_tile(const float* __restrict__ src, int ldw, int c0, int K, bf16_t* __restrict__ dst, int tc, int kt, int tid) {
  float* tile = (float*)smem;
  const int c4 = (tid & 63) * 4, kq = tid >> 6;
  f32x4 v[8];
#pragma unroll
  for (int i = 0; i < 8; ++i) v[i] = *(const f32x4*)(src + (size_t)(kt * 64 + kq + i * 8) * ldw + c0 + tc * 256 + c4);
#pragma unroll
  for (int i = 0; i < 8; ++i) {
    float* tp = tile + (kq + i * 8) * 257 + c4;
    tp[0] = v[i][0]; tp[1] = v[i][1]; tp[2] = v[i][2]; tp[3] = v[i][3];
  }
  __syncthreads();
  const int c = tid >> 1, k32 = (tid & 1) * 32;
  bf16_t* dp = dst + (size_t)(tc * 256 + c) * K + kt * 64 + k32;
#pragma unroll
  for (int q = 0; q < 4; ++q) {
    const float* tp = tile + (k32 + q * 8) * 257 + c;
    u32x4 w;
    w.x = cvt_pk_bf16(tp[0], tp[257]); w.y = cvt_pk_bf16(tp[2 * 257], tp[3 * 257]);
    w.z = cvt_pk_bf16(tp[4 * 257], tp[5 * 257]); w.w = cvt_pk_bf16(tp[6 * 257], tp[7 * 257]);
    *(u32x4*)(dp + q * 8) = w;
  }
}

__device__ __forceinline__ void convert_segment(const float* __restrict__ src, int ldw, int c0, int ncols, int K, bf16_t* __restrict__ dst, bool perm,
                                                const float* bias_vec = nullptr, float* bias_out = nullptr) {
  float* tile = (float*)smem;
  int tid = threadIdx.x;
  asm volatile("" : "+v"(tid));
  const int tk = K / 64, ntc = (ncols + 255) / 256, ntiles = ntc * tk;
  const int c4 = (tid & 63) * 4, kq = tid >> 6;
  f32x4 v[8];
  auto load_tile = [&](int t) {
    const int tc = t / tk, kt = t % tk;
    const bool okc = tc * 256 + c4 < ncols;
#pragma unroll
    for (int i = 0; i < 8; ++i)
      v[i] = okc ? *(const f32x4*)(src + (size_t)(kt * 64 + kq + i * 8) * ldw + c0 + tc * 256 + c4) : (f32x4){0.f, 0.f, 0.f, 0.f};
  };
  if ((int)blockIdx.x < ntiles) load_tile(blockIdx.x);
  for (int t = blockIdx.x; t < ntiles; t += gridDim.x) {
    const int tc = t / tk, kt = t % tk;
    __syncthreads();
#pragma unroll
    for (int i = 0; i < 8; ++i) {
      float* tp = tile + (kq + i * 8) * 257 + c4;
      tp[0] = v[i][0]; tp[1] = v[i][1]; tp[2] = v[i][2]; tp[3] = v[i][3];
    }
    if (t + (int)gridDim.x < ntiles) load_tile(t + gridDim.x);
    __syncthreads();
    if (bias_out != nullptr && tid < 256) {
      float a = 0.f;
#pragma unroll 8
      for (int k = 0; k < 64; ++k) a += tile[k * 257 + tid] * bias_vec[kt * 64 + k];
      atomicAdd(bias_out + tc * 256 + tid, a);
    }
    {
      const int c = tid >> 1, k32 = (tid & 1) * 32;
      const int cr = c & 63;
      const int sc = perm ? ((c & ~63) + (cr & 1) * 32 + (cr >> 1)) : c;
      if (tc * 256 + c < ncols) {
        bf16_t* dp = dst + (size_t)(tc * 256 + c) * K + kt * 64 + k32;
#pragma unroll
        for (int q = 0; q < 4; ++q) {
          const float* tp = tile + (k32 + q * 8) * 257 + sc;
          u32x4 w;
          w.x = cvt_pk_bf16(tp[0], tp[257]); w.y = cvt_pk_bf16(tp[2 * 257], tp[3 * 257]);
          w.z = cvt_pk_bf16(tp[4 * 257], tp[5 * 257]); w.w = cvt_pk_bf16(tp[6 * 257], tp[7 * 257]);
          *(u32x4*)(dp + q * 8) = w;
        }
      }
    }
  }
  __syncthreads();
}

__device__ __forceinline__ void modnorm_rows(const float* __restrict__ xa, int rows_a, const float* __restrict__ xb, int rows_b, const float* __restrict__ nw,
                             const float* __restrict__ sca, const float* __restrict__ sha, const float* __restrict__ scb,
                             const float* __restrict__ shb, bf16_t* __restrict__ outp) {
  int tid = threadIdx.x;
  asm volatile("" : "+v"(tid));
  const int lane = tid & 63, gw = blockIdx.x * (NTH / 64) + (tid >> 6), nw_ = gridDim.x * (NTH / 64);
  for (int r = gw; r < rows_a + rows_b; r += nw_) {
    const bool isa = r < rows_a;
    const float* xr = isa ? xa + (size_t)r * DM : xb + (size_t)(r - rows_a) * DM;
    const float* sc = isa ? sca : scb;
    const float* sh = isa ? sha : shb;
    f32x4 v[8];
    float ss = 0.f;
#pragma unroll
    for (int i = 0; i < 8; ++i) { v[i] = *(const f32x4*)(xr + i * 256 + lane * 4); ss += v[i][0] * v[i][0] + v[i][1] * v[i][1] + v[i][2] * v[i][2] + v[i][3] * v[i][3]; }
    ss = wave_sum(ss);
    const float rs = rsqrtf(ss * (1.0f / DM) + EPS);
#pragma unroll
    for (int i = 0; i < 8; ++i) {
      const int cidx = i * 256 + lane * 4;
      const f32x4 w = *(const f32x4*)(nw + cidx), s = *(const f32x4*)(sc + cidx), b = *(const f32x4*)(sh + cidx);
      f32x4 o;
#pragma unroll
      for (int j = 0; j < 4; ++j) o[j] = v[i][j] * rs * w[j] * (1.0f + s[j]) + b[j];
      u32x2 pk; pk.x = cvt_pk_bf16(o[0], o[1]); pk.y = cvt_pk_bf16(o[2], o[3]);
      *(u32x2*)(outp + (size_t)r * DM + cidx) = pk;
    }
  }
}

template <int MODE>
__device__ __forceinline__ void state_build_item(const Params& p, int c, int hg) {
  unsigned char* ws = p.ws;
  int tid = threadIdx.x;
  asm volatile("" : "+v"(tid));
  const int wid = tid >> 6, lane = tid & 63, fr = lane & 15, fq = lane >> 4;
  bf16_t* Kt = (bf16_t*)smem;
  bf16_t* Vt = (bf16_t*)(smem + 67584);
  float* wfs = (float*)(smem + 135168);
  float* wbs = wfs + 256;
  const bf16_t* Ksrc = MODE == 0 ? (const bf16_t*)(ws + OFF_K) : (const bf16_t*)(ws + OFF_B);
  const int kld = MODE == 0 ? 2048 : 1024;
  constexpr int NV = MODE == 0 ? 8 : 4;
  const bf16_t* Vsrc = MODE == 0 ? (const bf16_t*)(ws + OFF_VT) : (const bf16_t*)(ws + OFF_XT);
  const int PH = MODE == 0 ? 128 : 64;
  const float* CSF = (const float*)(ws + OFF_CSF); const float* RCSB = (const float*)(ws + OFF_RCSB);
  const float* DTF = (const float*)(ws + OFF_DTF); const float* DTB = (const float*)(ws + OFF_DTB);
  u32x4 vv[NV];
  float wr_[6] = {0.f, 0.f, 0.f, 0.f, 0.f, 0.f};
#define SB_PREFETCH(H_)                                                                                               \
  do {                                                                                                                \
    _Pragma("unroll") for (int i = 0; i < NV; ++i) {                                                                  \
      const int idx = tid + i * NTH, pp = idx >> 5, chn = idx & 31;                                                   \
      vv[i] = *(const u32x4*)(Vsrc + (size_t)((H_) * PH + pp) * R + c * CH + chn * 8);                                \
    }                                                                                                                 \
    if (MODE == 1 && tid < 256) {                                                                                     \
      const size_t rj = (size_t)(c * CH + tid) * 64 + (H_);                                                           \
      wr_[0] = CSF[(size_t)(c * CH + 255) * 64 + (H_)]; wr_[1] = CSF[rj]; wr_[2] = DTF[rj];                           \
      wr_[3] = RCSB[(size_t)(c * CH) * 64 + (H_)]; wr_[4] = RCSB[rj]; wr_[5] = DTB[rj];                               \
    }                                                                                                                 \
  } while (0)
  bf16x8 kv[8];
#pragma unroll
  for (int i = 0; i < 8; ++i) {
    const int idx = tid + i * NTH, j = idx >> 4, chn = idx & 15;
    kv[i] = *(const bf16x8*)(Ksrc + (size_t)(c * CH + j) * kld + hg * 128 + chn * 8);
  }
  SB_PREFETCH(MODE == 0 ? hg : hg * 8);
  __syncthreads();
#pragma unroll
  for (int i = 0; i < 8; ++i) {
    const int idx = tid + i * NTH, j = idx >> 4, chn = idx & 15;
#pragma unroll
    for (int e = 0; e < 8; ++e) Kt[(chn * 8 + e) * 264 + ((((j >> 3) ^ ((chn >> 1) & 7)) << 3) | (j & 7))] = (bf16_t)kv[i][e];
  }
  const int nheads = MODE == 0 ? 1 : 8;
  for (int hh = 0; hh < nheads; ++hh) {
    const int h = MODE == 0 ? hg : hg * 8 + hh;
    if (hh > 0) __syncthreads();
#pragma unroll
    for (int i = 0; i < NV; ++i) {
      const int idx = tid + i * NTH, pp = idx >> 5, chn = idx & 31;
      *(u32x4*)(Vt + pp * 264 + chn * 8) = vv[i];
    }
    if (tid < 256) {
      if (MODE == 0) {
        const float lgf = -log1pf(__expf(-p.ret_decay_logit[h])) * 1.4426950408889634f;
        const float lgb = -log1pf(__expf(-p.ret_decay_logit[16 + h])) * 1.4426950408889634f;
        wfs[tid] = exp2f((float)(255 - tid) * lgf);
        wbs[tid] = exp2f((float)tid * lgb);
      } else {
        wfs[tid] = __expf(wr_[0] - wr_[1]) * wr_[2];
        wbs[tid] = __expf(wr_[3] - wr_[4]) * wr_[5];
      }
    }
    __syncthreads();
    if (MODE == 1 && hh + 1 < nheads) SB_PREFETCH(h + 1);
    constexpr int NTL = MODE == 0 ? 8 : 4;
    const int p0 = MODE == 0 ? wid * 16 : (wid & 3) * 16;
    const int nt0 = MODE == 0 ? 0 : (wid >> 2) * 4;
    f32x4 af[NTL], ab[NTL];
#pragma unroll
    for (int i = 0; i < NTL; ++i) { af[i] = (f32x4){0.f, 0.f, 0.f, 0.f}; ab[i] = af[i]; }
#pragma unroll 2
    for (int kk = 0; kk < 8; ++kk) {
      const int jb = kk * 32 + fq * 8;
      const bf16x8 vr = *(const bf16x8*)(Vt + (p0 + fr) * 264 + jb);
      const f32x4 wf0 = *(const f32x4*)(wfs + jb), wf1 = *(const f32x4*)(wfs + jb + 4);
      const f32x4 wb0 = *(const f32x4*)(wbs + jb), wb1 = *(const f32x4*)(wbs + jb + 4);
      float x[8];
#pragma unroll
      for (int e = 0; e < 8; ++e) x[e] = bf2f((unsigned short)vr[e]);
      u32x4 uf, ub;
      uf.x = cvt_pk_bf16(x[0] * wf0[0], x[1] * wf0[1]); uf.y = cvt_pk_bf16(x[2] * wf0[2], x[3] * wf0[3]);
      uf.z = cvt_pk_bf16(x[4] * wf1[0], x[5] * wf1[1]); uf.w = cvt_pk_bf16(x[6] * wf1[2], x[7] * wf1[3]);
      ub.x = cvt_pk_bf16(x[0] * wb0[0], x[1] * wb0[1]); ub.y = cvt_pk_bf16(x[2] * wb0[2], x[3] * wb0[3]);
      ub.z = cvt_pk_bf16(x[4] * wb1[0], x[5] * wb1[1]); ub.w = cvt_pk_bf16(x[6] * wb1[2], x[7] * wb1[3]);
      const bf16x8 vf = as_bf16x8(uf), vb = as_bf16x8(ub);
#pragma unroll
      for (int i = 0; i < NTL; ++i) {
        const bf16x8 kf = *(const bf16x8*)(Kt + ((nt0 + i) * 16 + fr) * 264 + ((((jb >> 3) ^ ((nt0 + i) & 7))) << 3));
        af[i] = MFMA(kf, vf, af[i]);
        ab[i] = MFMA(kf, vb, ab[i]);
      }
    }
    bf16_t *df, *db;
    if (MODE == 0) {
      bf16_t* SR = (bf16_t*)(ws + OFF_SR);
      df = SR + ((size_t)(c * 2 + 0) * 16 + h) * 16384; db = SR + ((size_t)(c * 2 + 1) * 16 + h) * 16384;
    } else {
      bf16_t* SS = (bf16_t*)(ws + OFF_SS);
      df = SS + ((size_t)(c * 64 + h) * 2 + 0) * 8192; db = df + 8192;
    }
#pragma unroll
    for (int i = 0; i < NTL; ++i) {
      const int off = (p0 + fr) * 128 + (nt0 + i) * 16 + fq * 4;
      u32x2 w; w.x = cvt_pk_bf16(af[i][0], af[i][1]); w.y = cvt_pk_bf16(af[i][2], af[i][3]);
      *(u32x2*)(df + off) = w;
      w.x = cvt_pk_bf16(ab[i][0], ab[i][1]); w.y = cvt_pk_bf16(ab[i][2], ab[i][3]);
      *(u32x2*)(db + off) = w;
    }
  }
  __syncthreads();
}

__device__ __forceinline__ void ret_out_item(const Params& p, int cc, int h, int half, bool do_store) {
  unsigned char* ws = p.ws;
  int tid = threadIdx.x;
  asm volatile("" : "+v"(tid));
  const int wid = tid >> 6, lane = tid & 63, fr = lane & 15, fq = lane >> 4;
  bf16_t* Q = (bf16_t*)(ws + OFF_Q);
  const bf16_t* Kb = (const bf16_t*)(ws + OFF_K);
  const bf16_t* VT = (const bf16_t*)(ws + OFF_VT);
  const bf16_t* SR = (const bf16_t*)(ws + OFF_SR);
  const float lgf = -log1pf(__expf(-p.ret_decay_logit[h])) * 1.4426950408889634f;
  const float lgb = -log1pf(__expf(-p.ret_decay_logit[16 + h])) * 1.4426950408889634f;
  const int i0 = half * 128 + wid * 16, il = i0 + fr;
  const size_t grow = (size_t)cc * CH + il;
  bf16x8 qf[4];
#pragma unroll
  for (int kk = 0; kk < 4; ++kk) qf[kk] = *(const bf16x8*)(Q + grow * 2048 + h * 128 + kk * 32 + fq * 8);
  bf16_t* Hf = (bf16_t*)smem;
  bf16_t* Hb = (bf16_t*)(smem + 34816);
  __syncthreads();
  {
    u32x4 hv[8];
#pragma unroll
    for (int i = 0; i < 8; ++i) {
      const int idx = tid + i * NTH, dir = idx >> 11, rr = (idx >> 4) & 127, chn = idx & 15;
      hv[i] = *(const u32x4*)(SR + ((size_t)(cc * 2 + dir) * 16 + h) * 16384 + rr * 128 + chn * 8);
    }
#pragma unroll
    for (int i = 0; i < 8; ++i) {
      const int idx = tid + i * NTH, dir = idx >> 11, rr = (idx >> 4) & 127, chn = idx & 15;
      *(u32x4*)((dir ? Hb : Hf) + rr * 136 + chn * 8) = hv[i];
    }
  }
  __syncthreads();

  f32x4 Y[8];
  {
    const float ai = exp2f((float)(il + 1) * lgf), bi = exp2f((float)(256 - il) * lgb);
#pragma unroll
    for (int pt = 0; pt < 8; ++pt) {
      f32x4 a = {0.f, 0.f, 0.f, 0.f}, b = {0.f, 0.f, 0.f, 0.f};
#pragma unroll
      for (int kk = 0; kk < 4; ++kk) {
        const bf16x8 hf = *(const bf16x8*)(Hf + (pt * 16 + fr) * 136 + kk * 32 + fq * 8);
        const bf16x8 hb = *(const bf16x8*)(Hb + (pt * 16 + fr) * 136 + kk * 32 + fq * 8);
        a = MFMA(hf, qf[kk], a);
        b = MFMA(hb, qf[kk], b);
      }
      Y[pt] = a * ai + b * bi;
      __builtin_amdgcn_sched_barrier(0);
    }
  }
  __syncthreads();
  bf16_t* Ki = (bf16_t*)smem;
  bf16_t* Vt = (bf16_t*)(smem + 69632);
  {
    u32x4 kreg[8], vreg[8];
#pragma unroll
    for (int i = 0; i < 8; ++i) {
      const int idx = tid + i * NTH;
      kreg[i] = *(const u32x4*)(Kb + (size_t)(cc * CH + (idx >> 4)) * 2048 + h * 128 + (idx & 15) * 8);
      vreg[i] = *(const u32x4*)(VT + (size_t)(h * 128 + (idx >> 5)) * R + cc * CH + (idx & 31) * 8);
    }
#pragma unroll
    for (int i = 0; i < 8; ++i) {
      const int idx = tid + i * NTH;
      *(u32x4*)(Ki + (idx >> 4) * 136 + (idx & 15) * 8) = kreg[i];
    }
#pragma unroll
    for (int i = 0; i < 8; ++i) {
      const int idx = tid + i * NTH;
      *(u32x4*)(Vt + (idx >> 5) * 264 + (idx & 31) * 8) = vreg[i];
    }
  }
  __syncthreads();
  bf16x8 pf[8];
#pragma unroll
  for (int k2 = 0; k2 < 8; ++k2) {
    u32x4 pk;
#pragma unroll
    for (int s = 0; s < 2; ++s) {
      const int jt = k2 * 2 + s;
      f32x4 sacc = {0.f, 0.f, 0.f, 0.f};
#pragma unroll
      for (int kk = 0; kk < 4; ++kk) {
        const bf16x8 kf = *(const bf16x8*)(Ki + (jt * 16 + fr) * 136 + kk * 32 + fq * 8);
        sacc = MFMA(kf, qf[kk], sacc);
      }
      float w[4];
#pragma unroll
      for (int e = 0; e < 4; ++e) {
        const int dl = il - (jt * 16 + fq * 4 + e);
        w[e] = sacc[e] * __builtin_amdgcn_exp2f(dl >= 0 ? (float)dl * lgf : (float)(-dl) * lgb);
      }
      if (s == 0) { pk.x = cvt_pk_bf16(w[0], w[1]); pk.y = cvt_pk_bf16(w[2], w[3]); }
      else { pk.z = cvt_pk_bf16(w[0], w[1]); pk.w = cvt_pk_bf16(w[2], w[3]); }
    }
    pf[k2] = as_bf16x8(pk);
    __builtin_amdgcn_sched_barrier(0);
  }
#pragma unroll
  for (int pt = 0; pt < 8; ++pt) {
#pragma unroll
    for (int k2 = 0; k2 < 8; ++k2) {
      const bf16x4 lo = *(const bf16x4*)(Vt + (pt * 16 + fr) * 264 + k2 * 32 + fq * 4);
      const bf16x4 hi = *(const bf16x4*)(Vt + (pt * 16 + fr) * 264 + k2 * 32 + 16 + fq * 4);
      Y[pt] = MFMA(mk8(lo, hi), pf[k2], Y[pt]);
    }
    __builtin_amdgcn_sched_barrier(0);
  }
  float s1 = 0.f;
#pragma unroll
  for (int pt = 0; pt < 8; ++pt) s1 += (Y[pt][0] + Y[pt][1]) + (Y[pt][2] + Y[pt][3]);
  s1 += __shfl_xor(s1, 16); s1 += __shfl_xor(s1, 32);
  const float mu = s1 * (1.0f / 128.0f);
  float s2 = 0.f;
#pragma unroll
  for (int pt = 0; pt < 8; ++pt) {
#pragma unroll
    for (int e = 0; e < 4; ++e) { const float d = Y[pt][e] - mu; s2 += d * d; }
  }
  s2 += __shfl_xor(s2, 16); s2 += __shfl_xor(s2, 32);
  const float rstd = rsqrtf(s2 * (1.0f / 128.0f) + EPS);
#pragma unroll
  for (int pt = 0; pt < 8; ++pt) {
    const int pc = h * 128 + pt * 16 + fq * 4;
    const f32x4 nw = *(const f32x4*)(p.ret_norm_w + pc);
    u32x2 w;
    w.x = cvt_pk_bf16((Y[pt][0] - mu) * rstd * nw[0], (Y[pt][1] - mu) * rstd * nw[1]);
    w.y = cvt_pk_bf16((Y[pt][2] - mu) * rstd * nw[2], (Y[pt][3] - mu) * rstd * nw[3]);
    if (do_store) *(u32x2*)(Q + grow * 2048 + pc) = w;
  }
  __syncthreads();
}

__device__ __forceinline__ void ssd_out_item(const Params& p, int cc, int g, int half) {
  unsigned char* ws = p.ws;
  int tid = threadIdx.x;
  asm volatile("" : "+v"(tid));
  const int wid = tid >> 6, lane = tid & 63, fr = lane & 15, fq = lane >> 4;
  const bf16_t* Bb = (const bf16_t*)(ws + OFF_B);
  const bf16_t* Cb = (const bf16_t*)(ws + OFF_C);
  const bf16_t* XT = (const bf16_t*)(ws + OFF_XT);
  const bf16_t* SS = (const bf16_t*)(ws + OFF_SS);
  bf16_t* YS = (bf16_t*)(ws + OFF_YS);
  const float* CSF = (const float*)(ws + OFF_CSF); const float* RCSB = (const float*)(ws + OFF_RCSB);
  const float* DTF = (const float*)(ws + OFF_DTF); const float* DTB = (const float*)(ws + OFF_DTB);
  const int i0 = half * 128 + wid * 16, il = i0 + fr;
  const size_t grow = (size_t)cc * CH + il;
  bf16_t* Bi = (bf16_t*)smem;
  bf16_t* Hf = (bf16_t*)(smem + 69632);
  bf16_t* Hb = (bf16_t*)(smem + 87040);
  bf16_t* Xt = (bf16_t*)(smem + 104448);
  float* vcs = (float*)(smem + 138240);
  bf16x8 cf[4];
#pragma unroll
  for (int kk = 0; kk < 4; ++kk) cf[kk] = *(const bf16x8*)(Cb + grow * 1024 + g * 128 + kk * 32 + fq * 8);
  __syncthreads();
  {
    u32x4 bv[8];
#pragma unroll
    for (int i = 0; i < 8; ++i) {
      const int idx = tid + i * NTH;
      bv[i] = *(const u32x4*)(Bb + (size_t)(cc * CH + (idx >> 4)) * 1024 + g * 128 + (idx & 15) * 8);
    }
#pragma unroll
    for (int i = 0; i < 8; ++i) {
      const int idx = tid + i * NTH;
      *(u32x4*)(Bi + (idx >> 4) * 136 + (idx & 15) * 8) = bv[i];
    }
  }
  __syncthreads();
  u32x2 S[16];
#pragma unroll
  for (int jt = 0; jt < 16; ++jt) {
    f32x4 sacc = {0.f, 0.f, 0.f, 0.f};
#pragma unroll
    for (int kk = 0; kk < 4; ++kk) {
      const bf16x8 kf = *(const bf16x8*)(Bi + (jt * 16 + fr) * 136 + kk * 32 + fq * 8);
      sacc = MFMA(kf, cf[kk], sacc);
    }
    S[jt].x = cvt_pk_bf16(sacc[0], sacc[1]); S[jt].y = cvt_pk_bf16(sacc[2], sacc[3]);
  }
  __syncthreads();
  u32x2* Sl = (u32x2*)smem + wid * 1024;
#pragma unroll
  for (int jt = 0; jt < 16; ++jt) Sl[jt * 64 + lane] = S[jt];
  u32x4 hreg[4], xreg[4];
  float vr[4] = {0.f, 0.f, 0.f, 0.f};
#define SSD_PREFETCH(HH)                                                                                              \
  do {                                                                                                                \
    const int h_ = g * 8 + (HH);                                                                                      \
    _Pragma("unroll") for (int i = 0; i < 4; ++i) {                                                                   \
      const int idx = tid + i * NTH;                                                                                  \
      hreg[i] = *(const u32x4*)(SS + ((size_t)(cc * 64 + h_) * 2 + (idx >> 10)) * 8192 + ((idx >> 4) & 63) * 128 + (idx & 15) * 8); \
      xreg[i] = *(const u32x4*)(XT + (size_t)(h_ * 64 + (idx >> 5)) * R + cc * CH + (idx & 31) * 8);                  \
    }                                                                                                                 \
    if (tid < 256) {                                                                                                  \
      const size_t rj = (size_t)(cc * CH + tid) * 64 + h_;                                                            \
      vr[0] = CSF[rj]; vr[1] = RCSB[rj]; vr[2] = DTF[rj]; vr[3] = DTB[rj];                                            \
    }                                                                                                                 \
  } while (0)
  SSD_PREFETCH(0);
  for (int hh = 0; hh < 8; ++hh) {
    const int h = g * 8 + hh;
    __syncthreads();
#pragma unroll
    for (int i = 0; i < 4; ++i) {
      const int idx = tid + i * NTH;
      *(u32x4*)(((idx >> 10) ? Hb : Hf) + ((idx >> 4) & 63) * 136 + (idx & 15) * 8) = hreg[i];
      *(u32x4*)(Xt + (idx >> 5) * 264 + (idx & 31) * 8) = xreg[i];
    }
    if (tid < 256) {
      const float c2 = vr[0] * 1.4426950408889634f, r2 = vr[1] * 1.4426950408889634f;
      vcs[tid] = c2; vcs[256 + tid] = r2;
      vcs[512 + tid] = c2 - __log2f(vr[2]); vcs[768 + tid] = r2 - __log2f(vr[3]);
    }
    __syncthreads();
    if (hh < 7) SSD_PREFETCH(hh + 1);
    int ilv = il;
    asm volatile("" : "+v"(ilv));
    const float csi = vcs[il], rcsi = vcs[256 + il];
    f32x4 Y[4];
    {
      const float ai = exp2f(csi), bi = exp2f(rcsi);
#pragma unroll
      for (int pt = 0; pt < 4; ++pt) {
        f32x4 a = {0.f, 0.f, 0.f, 0.f}, b = {0.f, 0.f, 0.f, 0.f};
#pragma unroll
        for (int kk = 0; kk < 4; ++kk) {
          const bf16x8 hf = *(const bf16x8*)(Hf + (pt * 16 + fr) * 136 + kk * 32 + fq * 8);
          const bf16x8 hb = *(const bf16x8*)(Hb + (pt * 16 + fr) * 136 + kk * 32 + fq * 8);
          a = MFMA(hf, cf[kk], a);
          b = MFMA(hb, cf[kk], b);
        }
        Y[pt] = a * ai + b * bi;
        __builtin_amdgcn_sched_barrier(0);
      }
    }
#pragma unroll 1
    for (int k2 = 0; k2 < 8; ++k2) {
      u32x4 pk;
#pragma unroll
      for (int s = 0; s < 2; ++s) {
        const int jt = k2 * 2 + s, jb = jt * 16 + fq * 4;
        const u32x2 sp = Sl[jt * 64 + lane];
        float w[4];
        const float sv[4] = {bflo(sp.x), bfhi(sp.x), bflo(sp.y), bfhi(sp.y)};
        const int dtile = __builtin_amdgcn_readfirstlane(half * 8 + wid);
        if (jt < dtile) {
          const f32x4 af = *(const f32x4*)(vcs + 512 + jb);
#pragma unroll
          for (int e = 0; e < 4; ++e) w[e] = sv[e] * __builtin_amdgcn_exp2f(csi - af[e]);
        } else if (jt > dtile) {
          const f32x4 ab = *(const f32x4*)(vcs + 768 + jb);
#pragma unroll
          for (int e = 0; e < 4; ++e) w[e] = sv[e] * __builtin_amdgcn_exp2f(rcsi - ab[e]);
        } else {
          const f32x4 af = *(const f32x4*)(vcs + 512 + jb), ab = *(const f32x4*)(vcs + 768 + jb);
#pragma unroll
          for (int e = 0; e < 4; ++e) w[e] = sv[e] * __builtin_amdgcn_exp2f(((jb + e) <= ilv) ? (csi - af[e]) : (rcsi - ab[e]));
        }
        if (s == 0) { pk.x = cvt_pk_bf16(w[0], w[1]); pk.y = cvt_pk_bf16(w[2], w[3]); }
        else { pk.z = cvt_pk_bf16(w[0], w[1]); pk.w = cvt_pk_bf16(w[2], w[3]); }
      }
      const bf16x8 pfr = as_bf16x8(pk);
#pragma unroll
      for (int pt = 0; pt < 4; ++pt) {
        const bf16x4 lo = *(const bf16x4*)(Xt + (pt * 16 + fr) * 264 + k2 * 32 + fq * 4);
        const bf16x4 hi = *(const bf16x4*)(Xt + (pt * 16 + fr) * 264 + k2 * 32 + 16 + fq * 4);
        Y[pt] = MFMA(mk8(lo, hi), pfr, Y[pt]);
      }
      __builtin_amdgcn_sched_barrier(0);
    }
    const float dsk = p.ssd_d[h];
#pragma unroll
    for (int pt = 0; pt < 4; ++pt) {
      float o[4];
#pragma unroll
      for (int e = 0; e < 4; ++e) o[e] = Y[pt][e] + bf2f(Xt[(pt * 16 + fq * 4 + e) * 264 + il]) * dsk;
      u32x2 w; w.x = cvt_pk_bf16(o[0], o[1]); w.y = cvt_pk_bf16(o[2], o[3]);
      *(u32x2*)(YS + ((size_t)(cc - 1) * CH + il) * 4096 + h * 64 + pt * 16 + fq * 4) = w;
    }
  }
  __syncthreads();
}

#ifdef PROBE_AFTER
__device__ void probe_dump(const Params& p, size_t lo0, size_t hi0, size_t lo1, size_t hi1) {
  float* outp = (float*)p.out;
  const size_t n = (size_t)SEQ * DM;
  const bf16_t* b0 = (const bf16_t*)(p.ws + lo0); const size_t n0 = (hi0 - lo0) / 2;
  const bf16_t* b1 = (const bf16_t*)(p.ws + lo1); const size_t n1 = (hi1 - lo1) / 2;
  const size_t k0 = (n0 + n - 1) / n, k1 = n1 ? (n1 + n - 1) / n : 0;
  for (size_t i = (size_t)blockIdx.x * NTH + threadIdx.x; i < n; i += (size_t)gridDim.x * NTH) {
    float a = 0.f;
    for (size_t k = 0; k < k0; ++k) { const size_t j = i + k * n; if (j < n0) { float v = bf2f(b0[j]); if (!(fabsf(v) < 1e30f)) v = 777.f; a += v; } }
    for (size_t k = 0; k < k1; ++k) { const size_t j = i + k * n; if (j < n1) { float v = bf2f(b1[j]); if (!(fabsf(v) < 1e30f)) v = 777.f; a += v; } }
    outp[i] = a;
  }
}
#define PROBE_POINT(idx, lo0, hi0, lo1, hi1) if (PROBE_AFTER == (idx)) { probe_dump(p, lo0, hi0, lo1, hi1); return; }
#else
#define PROBE_POINT(idx, lo0, hi0, lo1, hi1)
#endif

#define XB_TMO      128
#define XB_XCNT(j)  (256  + 64 * (j))
#define XB_XSUB(j)  (1280 + 64 * (j))
#define XB_XGEN(j)  (2304 + 64 * (j))
#define XB_TOP      3328
#define XB_TOPGEN   3392
#define XCD_BAR_WORDS 3456
#define XB_SPIN_CAP (1u << 18)
#define LAS __attribute__((address_space(3)))
__device__ __forceinline__ unsigned xb_ld(unsigned* p)              { return __hip_atomic_load(p, __ATOMIC_RELAXED, __HIP_MEMORY_SCOPE_AGENT); }
__device__ __forceinline__ unsigned xb_add(unsigned* p, unsigned v) { return __hip_atomic_fetch_add(p, v, __ATOMIC_RELAXED, __HIP_MEMORY_SCOPE_AGENT); }
__device__ __forceinline__ unsigned xb_xcc_id() { return (unsigned)__builtin_amdgcn_s_getreg((3 << 11) | 20) & 0xFu; }
#define XB_SPIN(cond, bar) do { unsigned _sp = 0; while (cond) { __builtin_amdgcn_s_sleep(1); \
    if ((++_sp & 255u) == 0u) { if (xb_ld(&(bar)[XB_TMO])) break; if (_sp > XB_SPIN_CAP) { atomicAdd(&(bar)[XB_TMO], 1u); break; } } } } while (0)
struct XcdBarrier { unsigned* bar; unsigned x; volatile LAS unsigned* st; };
__device__ __forceinline__ XcdBarrier xcd_barrier_post(unsigned* bar, volatile LAS unsigned* st) {
  XcdBarrier b; b.bar = bar; b.x = xb_xcc_id(); b.st = st;
  if (threadIdx.x == 0) (void)xb_add(&bar[XB_XCNT(b.x)], 1u);
  return b;
}
__device__ __forceinline__ void xcd_barrier_complete(unsigned* bar, unsigned x, unsigned& nloc, unsigned& nx) {
  const unsigned G = gridDim.x * gridDim.y * gridDim.z;
  unsigned sum, cnt, mine, sp = 0u;
  for (;;) {
    sum = 0u; cnt = 0u; mine = 0u;
#pragma unroll
    for (unsigned j = 0; j < 16; ++j) { const unsigned c = xb_ld(&bar[XB_XCNT(j)]); sum += c; cnt += (c > 0u) ? 1u : 0u; mine = (j == x) ? c : mine; }
    if (sum == G) break;
    __builtin_amdgcn_s_sleep(1);
    if ((++sp & 255u) == 0u) { if (xb_ld(&bar[XB_TMO])) break; if (sp > XB_SPIN_CAP) { atomicAdd(&bar[XB_TMO], 1u); break; } }
  }
  nloc = mine > 0u ? mine : 1u; nx = cnt > 0u ? cnt : 1u;
}
__device__ __forceinline__ void xcd_barrier(const XcdBarrier& b) {
  asm volatile("s_waitcnt vmcnt(0)" ::: "memory");
  __syncthreads();
  if (threadIdx.x == 0) {
    unsigned* bar = b.bar;
    __builtin_amdgcn_s_waitcnt(0);
    unsigned nloc = b.st[0], nx = b.st[1];
    if (nloc == 0u) { xcd_barrier_complete(bar, b.x, nloc, nx); b.st[0] = nloc; b.st[1] = nx; }
    const unsigned old = xb_add(&bar[XB_XSUB(b.x)], 1u);
    const unsigned gen = old / nloc;
    if (old + 1u == (gen + 1u) * nloc) {
      __builtin_amdgcn_fence(__ATOMIC_RELEASE, "agent");
      asm volatile("s_waitcnt vmcnt(0)" ::: "memory");
      const unsigned og = xb_add(&bar[XB_TOP], 1u);
      const unsigned tg = og / nx;
      if (og + 1u == (tg + 1u) * nx) xb_add(&bar[XB_TOPGEN], 1u);
      else XB_SPIN(xb_ld(&bar[XB_TOPGEN]) == tg, bar);
      __builtin_amdgcn_fence(__ATOMIC_ACQUIRE, "agent");
      xb_add(&bar[XB_XGEN(b.x)], 1u);
      asm volatile("s_waitcnt vmcnt(0)" ::: "memory");
    } else {
      XB_SPIN(xb_ld(&bar[XB_XGEN(b.x)]) == gen, bar);
      __builtin_amdgcn_fence(__ATOMIC_ACQUIRE, "agent");
      asm volatile("s_waitcnt vmcnt(0)" ::: "memory");
    }
  }
  __syncthreads();
}

__global__ void __launch_bounds__(NTH) mega(Params p) {
  cg::grid_group grid = cg::this_grid();
  unsigned char* ws = p.ws;
  volatile LAS unsigned* xb_st = (volatile LAS unsigned*)((LAS unsigned char*)smem + (LDS_BYTES - 16));
  if (threadIdx.x == 0) { xb_st[0] = 0u; xb_st[1] = 0u; }
  __syncthreads();
  const XcdBarrier xb = xcd_barrier_post((unsigned*)(ws + OFF_BAR), xb_st);
  const int bid = blockIdx.x, nb = gridDim.x, gnth = nb * NTH;
#define FRESH_TID() int tid = threadIdx.x; asm volatile("" : "+v"(tid)); const int gtid = bid * NTH + tid; (void)gtid;
  float* MOD = (float*)(ws + OFF_MOD);
  float* SUMSQ = (float*)(ws + OFF_SUMSQ);
  float* ROPE = (float*)(ws + OFF_ROPE);
  bf16_t* U = (bf16_t*)(p.out + OOFF_U);
  bf16_t* WBT = (bf16_t*)(p.out + OOFF_WB);
  bf16_t* WA1 = (bf16_t*)(ws + OFF_WA);
  bf16_t* WA2 = WA1 + (size_t)6400 * 2048;

#if (PHASE_MASK >> 0) & 1
  {
  FRESH_TID();
  for (int u = bid; u < 192; u += nb) {
    const int ks = u / 24, j = (u % 24) * NTH + tid;
    float* sc = (float*)smem;
    __syncthreads();
    if (tid < 256) { sc[tid] = siluf_(p.c[ks * 256 + tid]); sc[256 + tid] = siluf_(p.c_ctx[ks * 256 + tid]); }
    __syncthreads();
    float a0 = 0.f, a1 = 0.f;
    for (int k0 = 0; k0 < 256; k0 += 16) {
      float w[16];
#pragma unroll
      for (int e = 0; e < 16; ++e) w[e] = p.w_mod[(size_t)(ks * 256 + k0 + e) * 12288 + j];
#pragma unroll
      for (int e = 0; e < 16; ++e) { a0 += sc[k0 + e] * w[e]; a1 += sc[256 + k0 + e] * w[e]; }
    }
    if (ks == 0) { const float b = p.b_mod[j]; a0 += b; a1 += b; }
    atomicAdd(MOD + j, a0);
    atomicAdd(MOD + 12288 + j, a1);
  }
  __syncthreads();
  for (int i = gtid; i < 256 * 32; i += gnth) {
    const int pos = i >> 5, d = i & 31;
    const float freq = exp2f(-(float)d * (13.287712379549449f / 32.0f));
    const float rev = (float)pos * freq * 0.15915494309189535f;
    const float fr_ = rev - floorf(rev);
    ROPE[i * 2 + 0] = __builtin_amdgcn_cosf(fr_);
    ROPE[i * 2 + 1] = __builtin_amdgcn_sinf(fr_);
  }
  convert_segment(p.w_in, INC, 0, 2048, 2048, WA1, true);
  convert_segment(p.w_in, INC, 2048, 2048, 2048, WA1 + (size_t)2048 * 2048, true);
  convert_segment(p.w_in, INC, 16384, 2048, 2048, WA1 + (size_t)4096 * 2048, false);
  convert_segment(p.w_in, INC, 18432, 128, 2048, WA1 + (size_t)6144 * 2048, false);
  convert_segment(p.w_in, INC, 4096, 2048, 2048, WA2, false);
  convert_segment(p.w_in, INC, 12288, 4096, 2048, WA2 + (size_t)2048 * 2048, false);
  }
#endif
  if (p.ws == nullptr) grid.sync();
  xcd_barrier(xb);

#if (PHASE_MASK >> 1) & 1
  for (int rep_ = 0; rep_ < 1 + ((DUP_MASK >> 1) & 1); ++rep_) {
  modnorm_rows(p.ctx, CTX, p.x, SEQ, p.norm1_w, MOD + 12288 + 2048, MOD + 12288, MOD + 2048, MOD, U);
  }
#endif
  xcd_barrier(xb);

#if (PHASE_MASK >> 2) & 1
  for (int rep_ = 0; rep_ < 1 + ((DUP_MASK >> 2) & 1); ++rep_) {
  {
    EpiA1 e1{(bf16_t*)(ws + OFF_Q), (bf16_t*)(ws + OFF_K), (bf16_t*)(ws + OFF_BCRAW), (float*)(ws + OFF_DTRAW), ROPE};
    EpiA2 e2{(bf16_t*)(ws + OFF_VT), (bf16_t*)(ws + OFF_XTRAW)};
    const int n1 = 65 * 25, n2 = 24 * 65;
    for (int L = bid; L < n1 + n2; L += nb) {
      int pm, pn;
      if (L < n2) { unit_map(L, 24, 65, pm, pn); gemm_unit(WA2, 2048, U, 2048, 2048, pm, pn, e2); }
      else { unit_map(L - n2, 65, 25, pm, pn); gemm_unit(U, 2048, WA1, 2048, 2048, pm, pn, e1); }
    }
    {
      int tid = threadIdx.x;
      asm volatile("" : "+v"(tid));
      unsigned* qhead = (unsigned*)(ws + OFF_BAR) + 3520;
      volatile unsigned* bc = (volatile unsigned*)(smem + 66560);
      for (;;) {
        __syncthreads();
        if (tid == 0) *bc = atomicAdd(qhead, 1u);
        __syncthreads();
        const int t = (int)*bc;
        if (t >= 2304) break;
        if (t < 256) convert_tile(p.w_in, INC, 6144, 2048, WBT, t >> 5, t & 31, tid);
        else if (t < 768) convert_tile(p.w_in, INC, 8192, 2048, WBT + (size_t)2048 * 2048, (t - 256) >> 5, (t - 256) & 31, tid);
        else if (t < 1280) convert_tile(p.w_in, INC, 18560, 2048, WBT + (size_t)6144 * 2048, (t - 768) >> 5, (t - 768) & 31, tid);
        else if (t < 1536) convert_tile(p.w_ret_out, 2048, 0, 2048, (bf16_t*)(ws + OFF_WRO), (t - 1280) >> 5, (t - 1280) & 31, tid);
        else if (t < 2048) convert_tile(p.w_ssd_out, 2048, 0, 4096, (bf16_t*)(ws + OFF_WSO), (t - 1536) >> 6, (t - 1536) & 63, tid);
        else convert_tile(p.w_o, 2048, 0, 2048, (bf16_t*)(ws + OFF_WO), (t - 2048) >> 5, (t - 2048) & 31, tid);
      }
      __syncthreads();
    }
  }
  }
#endif
  xcd_barrier(xb);
  PROBE_POINT(2, OFF_Q, OFF_XT, OFF_SR, OFF_WA)

#if (PHASE_MASK >> 3) & 1
  for (int rep_ = 0; rep_ < 1 + ((DUP_MASK >> 3) & 1); ++rep_) {
  {
  FRESH_TID();
  {
    float* DTRAW = (float*)(ws + OFF_DTRAW);
    float* DTF = (float*)(ws + OFF_DTF); float* DTB = (float*)(ws + OFF_DTB);
    float* CSF = (float*)(ws + OFF_CSF); float* RCSB = (float*)(ws + OFF_RCSB);
    if ((tid >> 6) == 0) {
      for (int w = bid; w < NCH * 2; w += nb) {
        const int c = w >> 1, dir = w & 1, h = tid & 63;
        const float bias = p.ssd_dt_bias[dir * 64 + h], a = -__expf(p.ssd_a_log[dir * 64 + h]);
        float* __restrict__ DTO = dir ? DTB : DTF;
        float* __restrict__ CSO = dir ? RCSB : CSF;
        float cs = 0.f;
        for (int jb = 0; jb < CH; jb += 16) {
          float raw[16];
#pragma unroll
          for (int e = 0; e < 16; ++e) {
            const int j = dir ? (CH - 1 - jb - e) : (jb + e);
            raw[e] = DTRAW[((size_t)c * CH + j) * 128 + dir * 64 + h];
          }
#pragma unroll
          for (int e = 0; e < 16; ++e) {
            const int j = dir ? (CH - 1 - jb - e) : (jb + e);
            const size_t r = (size_t)c * CH + j;
            const float dt = softplusf_(raw[e] + bias);
            cs += dt * a;
            DTO[r * 64 + h] = dt; CSO[r * 64 + h] = cs;
          }
        }
      }
    }
    const bf16_t* __restrict__ BCRAW = (const bf16_t*)(ws + OFF_BCRAW);
    bf16_t* __restrict__ Bb = (bf16_t*)(ws + OFF_B); bf16_t* __restrict__ Cb = (bf16_t*)(ws + OFF_C);
#pragma unroll 2
    for (int i = gtid; i < R * 256; i += gnth) {
      const int r = i >> 8, c8 = (i & 255) * 8;
      const int s0 = r < CTX ? 0 : CTX, s1 = r < CTX ? CTX : R;
      bf16x8 xv[5];
      float msk[5];
#pragma unroll
      for (int j = 0; j < 5; ++j) {
        const int rr = r + j - 2;
        const bool ok = rr >= s0 && rr < s1;
        msk[j] = ok ? 1.f : 0.f;
        xv[j] = *(const bf16x8*)(BCRAW + (size_t)(ok ? rr : r) * 2048 + c8);
      }
      const float* cwp = p.conv_w + 4096 + c8;
      const f32x4 b0 = *(const f32x4*)(p.conv_b + 4096 + c8), b1 = *(const f32x4*)(p.conv_b + 4096 + c8 + 4);
      float a[8] = {b0[0], b0[1], b0[2], b0[3], b1[0], b1[1], b1[2], b1[3]};
#pragma unroll
      for (int j = 0; j < 5; ++j) {
        const f32x4 w0 = *(const f32x4*)(cwp + (size_t)j * 6144) * msk[j], w1 = *(const f32x4*)(cwp + (size_t)j * 6144 + 4) * msk[j];
#pragma unroll
        for (int e = 0; e < 4; ++e) { a[e] += bf2f((unsigned short)xv[j][e]) * w0[e]; a[4 + e] += bf2f((unsigned short)xv[j][4 + e]) * w1[e]; }
      }
      u32x4 w;
      w.x = cvt_pk_bf16(siluf_(a[0]), siluf_(a[1])); w.y = cvt_pk_bf16(siluf_(a[2]), siluf_(a[3]));
      w.z = cvt_pk_bf16(siluf_(a[4]), siluf_(a[5])); w.w = cvt_pk_bf16(siluf_(a[6]), siluf_(a[7]));
      bf16_t* dst = c8 < 1024 ? Bb + (size_t)r * 1024 + c8 : Cb + (size_t)r * 1024 + (c8 - 1024);
      *(u32x4*)dst = w;
    }
    const bf16_t* __restrict__ XTRAW = (const bf16_t*)(ws + OFF_XTRAW);
    bf16_t* __restrict__ XT = (bf16_t*)(ws + OFF_XT);
#pragma unroll 2
    for (int i = gtid; i < 4096 * (R / 16); i += gnth) {
      const int ch = i / (R / 16), t16 = (i % (R / 16)) * 16;
      const int s0 = t16 < CTX ? 0 : CTX, s1 = t16 < CTX ? CTX : R;
      const bf16_t* src = XTRAW + (size_t)ch * R;
      const bool okp = t16 - 8 >= s0, okn = t16 + 16 < s1;
      const bf16x8 vp = *(const bf16x8*)(src + (okp ? t16 - 8 : t16));
      const bf16x8 v0 = *(const bf16x8*)(src + t16);
      const bf16x8 v1 = *(const bf16x8*)(src + t16 + 8);
      const bf16x8 vn = *(const bf16x8*)(src + (okn ? t16 + 16 : t16));
      float x[20];
      x[0] = okp ? bf2f((unsigned short)vp[6]) : 0.f;
      x[1] = okp ? bf2f((unsigned short)vp[7]) : 0.f;
#pragma unroll
      for (int e = 0; e < 8; ++e) { x[2 + e] = bf2f((unsigned short)v0[e]); x[10 + e] = bf2f((unsigned short)v1[e]); }
      x[18] = okn ? bf2f((unsigned short)vn[0]) : 0.f;
      x[19] = okn ? bf2f((unsigned short)vn[1]) : 0.f;
      float wj[5];
#pragma unroll
      for (int j = 0; j < 5; ++j) wj[j] = p.conv_w[(size_t)j * 6144 + ch];
      const float cb = p.conv_b[ch];
      float o[16];
#pragma unroll
      for (int e = 0; e < 16; ++e) {
        float a = cb;
#pragma unroll
        for (int j = 0; j < 5; ++j) a += x[e + j] * wj[j];
        o[e] = siluf_(a);
      }
      u32x4 w;
      w.x = cvt_pk_bf16(o[0], o[1]); w.y = cvt_pk_bf16(o[2], o[3]); w.z = cvt_pk_bf16(o[4], o[5]); w.w = cvt_pk_bf16(o[6], o[7]);
      *(u32x4*)(XT + (size_t)ch * R + t16) = w;
      w.x = cvt_pk_bf16(o[8], o[9]); w.y = cvt_pk_bf16(o[10], o[11]); w.z = cvt_pk_bf16(o[12], o[13]); w.w = cvt_pk_bf16(o[14], o[15]);
      *(u32x4*)(XT + (size_t)ch * R + t16 + 8) = w;
    }
  }
  }
  }
#endif
  xcd_barrier(xb);
  PROBE_POINT(3, OFF_XT, OFF_DTRAW, OFF_DTF, OFF_SR)

#if (PHASE_MASK >> 4) & 1
  for (int rep_ = 0; rep_ < 1 + ((DUP_MASK >> 4) & 1); ++rep_) {
  for (int it = bid; it < NCH * 24; it += nb) {
    if (it < NCH * 8) state_build_item<1>(p, it >> 3, it & 7);
    else { const int r = it - NCH * 8; state_build_item<0>(p, r >> 4, r & 15); }
  }
  }
#endif
  xcd_barrier(xb);
  PROBE_POINT(4, OFF_SR, OFF_WA, 0, 0)

#if (PHASE_MASK >> 5) & 1
  for (int rep_ = 0; rep_ < 1 + ((DUP_MASK >> 5) & 1); ++rep_) {
  {
  FRESH_TID();
  {
    bf16_t* SR = (bf16_t*)(ws + OFF_SR);
    bf16_t* SS = (bf16_t*)(ws + OFF_SS);
    const float* CSF = (const float*)(ws + OFF_CSF); const float* RCSB = (const float*)(ws + OFF_RCSB);
    for (int i = gtid; i < 65536 + 131072; i += gnth) {
      bf16_t* base; size_t cstride; int dir, h; bool isr = i < 65536;
      if (isr) { const int e = i * 8; dir = e / (16 * 16384); h = (e / 16384) & 15; base = SR + e; cstride = 524288; }
      else { const int e = (i - 65536) * 8; h = e / 16384; dir = (e / 8192) & 1; base = SS + e; cstride = 1048576; }
      float decr = 0.f;
      if (isr) { const float lg = -log1pf(__expf(-p.ret_decay_logit[dir * 16 + h])); decr = __expf(256.0f * lg); }
      float H[8];
#pragma unroll
      for (int e = 0; e < 8; ++e) H[e] = 0.f;
      u32x4 q[4]; float dq[4];
#pragma unroll
      for (int k = 0; k < 4; ++k) {
        const int c = dir == 0 ? k : (k == 0 ? 0 : NCH - k);
        q[k] = *(const u32x4*)(base + (size_t)c * cstride);
        dq[k] = isr ? 0.f : (dir == 0 ? CSF[((size_t)c * CH + 255) * 64 + h] : RCSB[((size_t)c * CH) * 64 + h]);
      }
      for (int s0 = 0; s0 < NCH; s0 += 4) {
#pragma unroll
        for (int k = 0; k < 4; ++k) {
          const int s = s0 + k;
          if (s < NCH) {
            const int c = dir == 0 ? s : (s == 0 ? 0 : NCH - s);
            bf16_t* ptr = base + (size_t)c * cstride;
            const u32x4 tv = q[k];
            const float dl = dq[k];
            if (s + 4 < NCH) {
              const int cn = dir == 0 ? s + 4 : NCH - (s + 4);
              q[k] = *(const u32x4*)(base + (size_t)cn * cstride);
              dq[k] = isr ? 0.f : (dir == 0 ? CSF[((size_t)cn * CH + 255) * 64 + h] : RCSB[((size_t)cn * CH) * 64 + h]);
            }
            u32x4 hv;
            hv.x = cvt_pk_bf16(H[0], H[1]); hv.y = cvt_pk_bf16(H[2], H[3]); hv.z = cvt_pk_bf16(H[4], H[5]); hv.w = cvt_pk_bf16(H[6], H[7]);
            if (rep_ == ((DUP_MASK >> 5) & 1) || p.ws == nullptr) *(u32x4*)ptr = hv;
            const float dec = isr ? decr : __expf(dl);
            H[0] = dec * H[0] + bflo(tv.x); H[1] = dec * H[1] + bfhi(tv.x);
            H[2] = dec * H[2] + bflo(tv.y); H[3] = dec * H[3] + bfhi(tv.y);
            H[4] = dec * H[4] + bflo(tv.z); H[5] = dec * H[5] + bfhi(tv.z);
            H[6] = dec * H[6] + bflo(tv.w); H[7] = dec * H[7] + bfhi(tv.w);
          }
        }
      }
    }
  }
  }
  }
#endif
  xcd_barrier(xb);
  PROBE_POINT(5, OFF_SR, OFF_WA, 0, 0)

#if (PHASE_MASK >> 6) & 1
  for (int rep_ = 0; rep_ < 1 + ((DUP_MASK >> 6) & 1); ++rep_) {
  for (int it = bid; it < 64 * 16 * 2; it += nb) {
    const int half = (it >> 3) & 1, q = ((it >> 4) << 3) | (it & 7), h = q & 15, cc = 1 + (q >> 4);
    ret_out_item(p, cc, h, half, rep_ == ((DUP_MASK >> 6) & 1) || p.ws == nullptr);
  }
  }
#endif
  xcd_barrier(xb);
  PROBE_POINT(6, OFF_Q, OFF_K, 0, 0)

#if (PHASE_MASK >> 7) & 1
  for (int rep_ = 0; rep_ < 1 + ((DUP_MASK >> 7) & 1); ++rep_) {
  for (int ph = 0; ph < 2; ++ph) {
    if ((ph == 0) == ((bid & 1) != 0)) {
      convert_segment(p.w_mlp1, DFF, 0, DFF, 2048, (bf16_t*)(ws + OFF_W1T), false, MOD + 6144, (float*)(ws + OFF_BIAS1));
      convert_segment(p.w_mlp2, 2048, 0, 2048, DFF, (bf16_t*)(ws + OFF_W2T), false);
    }
    if (ph == 0) {
      for (int it = bid; it < 64 * 8 * 2; it += nb) {
        const int half = (it >> 3) & 1, q = ((it >> 4) << 3) | (it & 7), g = q & 7, cc = 1 + (q >> 3);
        ssd_out_item(p, cc, g, half);
      }
    }
  }
  }
#endif
  xcd_barrier(xb);
  PROBE_POINT(7, OFF_YS, OFF_XT, OFF_SR, OFF_SS)

#if (PHASE_MASK >> 8) & 1
  for (int rep_ = 0; rep_ < 1 + ((DUP_MASK >> 8) & 1); ++rep_) {
  {
    EpiB e{(bf16_t*)(ws + OFF_Q), (bf16_t*)(ws + OFF_YS), (bf16_t*)(ws + OFF_G), p.ssd_norm_w, SUMSQ};
    for (int L = bid; L < 64 * 40; L += nb) {
      int pm, pn; unit_map(L, 64, 40, pm, pn);
      gemm_unit(U + (size_t)CTX * 2048, 2048, WBT, 2048, 2048, pm, pn, e);
    }
  }
  }
#endif
  xcd_barrier(xb);
  PROBE_POINT(8, OFF_Q, OFF_B, 0, 0)

#if (PHASE_MASK >> 9) & 1
  for (int rep_ = 0; rep_ < 1 + ((DUP_MASK >> 9) & 1); ++rep_) {
  {
    EpiO1a ea{(const bf16_t*)(ws + OFF_G), (bf16_t*)(ws + OFF_M)};
    EpiO1b eb{(const bf16_t*)(ws + OFF_G), SUMSQ, (bf16_t*)(ws + OFF_M)};
    for (int L = bid; L < 64 * 8; L += nb) {
      int pm, pn; unit_map(L, 64, 8, pm, pn);
      gemm_unit((const bf16_t*)(ws + OFF_Q) + (size_t)CTX * 2048, 2048, (const bf16_t*)(ws + OFF_WRO), 2048, 2048, pm, pn, ea);
      gemm_unit((const bf16_t*)(ws + OFF_YS), 4096, (const bf16_t*)(ws + OFF_WSO), 4096, 4096, pm, pn, eb);
    }
  }
  }
#endif
  xcd_barrier(xb);
  PROBE_POINT(9, OFF_M, OFF_DTRAW, 0, 0)

#if (PHASE_MASK >> 10) & 1
  for (int rep_ = 0; rep_ < 1 + ((DUP_MASK >> 10) & 1); ++rep_) {
  {
    EpiRes9 e{p.x, MOD + 4096, (float*)(ws + OFF_H1), p.norm2_w, MOD + 8192, (bf16_t*)(ws + OFF_F), (float*)(ws + OFF_SUMSQ2)};
    for (int L = bid; L < 64 * 8; L += nb) {
      int pm, pn; unit_map(L, 64, 8, pm, pn);
      gemm_unit((const bf16_t*)(ws + OFF_M), 2048, (const bf16_t*)(ws + OFF_WO), 2048, 2048, pm, pn, e);
    }
  }
  }
#endif
  xcd_barrier(xb);
  PROBE_POINT(10, OFF_H1, OFF_H1 + (size_t)SEQ * DM * 4, 0, 0)

#if (PHASE_MASK >> 12) & 1
  for (int rep_ = 0; rep_ < 1 + ((DUP_MASK >> 12) & 1); ++rep_) {
  {
    EpiM1 e{(bf16_t*)(ws + OFF_A1), (const float*)(ws + OFF_SUMSQ2), (const float*)(ws + OFF_BIAS1)};
    for (int L = bid; L < 64 * 32; L += nb) {
      int pm, pn; unit_map(L, 64, 32, pm, pn);
      gemm_unit((const bf16_t*)(ws + OFF_F), 2048, (const bf16_t*)(ws + OFF_W1T), 2048, 2048, pm, pn, e);
    }
  }
  }
#endif
  xcd_barrier(xb);
  PROBE_POINT(12, OFF_A1, OFF_A1 + (size_t)SEQ * DFF * 2, 0, 0)

#if (PHASE_MASK >> 13) & 1
  for (int rep_ = 0; rep_ < 1 + ((DUP_MASK >> 13) & 1); ++rep_) {
  {
    EpiRes e{(const float*)(ws + OFF_H1), MOD + 10240, (float*)(ws + OFF_H1), rep_ == ((DUP_MASK >> 13) & 1) || p.ws == nullptr};
    for (int L = bid; L < 64 * 8; L += nb) {
      int pm, pn; unit_map(L, 64, 8, pm, pn);
      gemm_unit((const bf16_t*)(ws + OFF_A1), DFF, (const bf16_t*)(ws + OFF_W2T), DFF, DFF, pm, pn, e);
    }
  }
  }
#endif
  xcd_barrier(xb);
  PROBE_POINT(13, OFF_H1, OFF_H1 + (size_t)SEQ * DM * 4, 0, 0)

#if (PHASE_MASK >> 14) & 1
  for (int rep_ = 0; rep_ < 1 + ((DUP_MASK >> 14) & 1); ++rep_) {
  {
  FRESH_TID();
  {
    const float* H2 = (const float*)(ws + OFF_H1);
    float* outp = (float*)p.out;
    const int lane = tid & 63, gw = bid * (NTH / 64) + (tid >> 6), nw_ = nb * (NTH / 64);
    for (int r = gw; r < SEQ; r += nw_) {
      f32x4 v[8];
      float ss = 0.f;
#pragma unroll
      for (int i = 0; i < 8; ++i) { v[i] = *(const f32x4*)(H2 + (size_t)r * DM + i * 256 + lane * 4); ss += v[i][0] * v[i][0] + v[i][1] * v[i][1] + v[i][2] * v[i][2] + v[i][3] * v[i][3]; }
      ss = wave_sum(ss);
      const float rs = rsqrtf(ss * (1.0f / DM) + EPS);
#pragma unroll
      for (int i = 0; i < 8; ++i) {
        const f32x4 w = *(const f32x4*)(p.final_norm_w + i * 256 + lane * 4);
        f32x4 o = v[i] * rs * w;
        *(f32x4*)(outp + (size_t)r * DM + i * 256 + lane * 4) = o;
      }
    }
  }
  }
  }
#endif
}

extern "C" void kernel_launch(void* const* d_in, const int* in_sizes, int n_in, void* d_out, int out_size, void* d_ws, size_t ws_size,
                              hipStream_t stream) {
  static int grid_blocks = 0;
  if (!grid_blocks) {
    int dev = 0, cus = 0, per_cu = 0;
    (void)hipGetDevice(&dev);
    (void)hipDeviceGetAttribute(&cus, hipDeviceAttributeMultiprocessorCount, dev);
    (void)hipFuncSetAttribute((const void*)mega, hipFuncAttributeMaxDynamicSharedMemorySize, LDS_BYTES);
    (void)hipOccupancyMaxActiveBlocksPerMultiprocessor(&per_cu, mega, NTH, LDS_BYTES);
    if (per_cu > 1) per_cu = 1;
    grid_blocks = cus * per_cu;
  }
  if (ws_size < WS_NEED || grid_blocks <= 0) { fprintf(stderr, "workspace too small or no occupancy\n"); return; }
  Params p{};
  const float** pp = (const float**)&p;
  for (int i = 0; i < 23; ++i) pp[i] = (const float*)d_in[i];
  p.ws = (unsigned char*)d_ws;
  p.out = (unsigned char*)d_out;
  (void)hipMemsetAsync((unsigned char*)d_ws + OFF_MOD, 0, OFF_ROPE - OFF_MOD, stream);
  void* args[] = {&p};
  hipError_t e = hipLaunchCooperativeKernel((void*)mega, dim3(grid_blocks), dim3(NTH), args, LDS_BYTES, stream);
  if (e != hipSuccess) fprintf(stderr, "cooperative launch failed: %s (grid %d)\n", hipGetErrorString(e), grid_blocks);
}
```

```cpp
#include <hip/hip_runtime.h>
#include <hip/hip_cooperative_groups.h>
#include <cstdio>
#include <cstdint>
namespace cg = cooperative_groups;

typedef unsigned short bf16_t;
typedef short bf16x8 __attribute__((ext_vector_type(8)));
typedef short bf16x4 __attribute__((ext_vector_type(4)));
typedef float f32x4 __attribute__((ext_vector_type(4)));
typedef float f32x2 __attribute__((ext_vector_type(2)));
typedef unsigned u32x4 __attribute__((ext_vector_type(4)));
typedef unsigned u32x2 __attribute__((ext_vector_type(2)));

constexpr int DM = 2048, SEQ = 16384, CTX = 256, R = SEQ + CTX, CH = 256, NCH = 65;
constexpr int INC = 22656, DFF = 8192;
constexpr float EPS = 1e-6f;
constexpr int NTH = 512;
constexpr int LDS_BYTES = 147456;
#ifndef DUP_MASK
#define DUP_MASK 0
#endif
#ifndef PHASE_MASK
#define PHASE_MASK 0x7fff
#endif

constexpr size_t SZQ = (size_t)R * 2048 * 2;
constexpr size_t OFF_Q = 0;
constexpr size_t OFF_K = OFF_Q + SZQ;
constexpr size_t OFF_VT = OFF_K + SZQ;
constexpr size_t OFF_XT = OFF_VT + SZQ;
constexpr size_t OFF_B = OFF_XT + 2 * SZQ;
constexpr size_t OFF_C = OFF_B + SZQ / 2;
constexpr size_t OFF_DTRAW = OFF_C + SZQ / 2;
constexpr size_t SZ_DTA = (size_t)R * 64 * 4;
constexpr size_t OFF_DTF = OFF_DTRAW + (size_t)R * 128 * 4;
constexpr size_t OFF_DTB = OFF_DTF + SZ_DTA;
constexpr size_t OFF_CSF = OFF_DTB + SZ_DTA;
constexpr size_t OFF_RCSB = OFF_CSF + SZ_DTA;
constexpr size_t OFF_SR = OFF_RCSB + SZ_DTA;
constexpr size_t OFF_SS = OFF_SR + SZQ;
constexpr size_t OFF_WA = OFF_SS + 2 * SZQ;
constexpr size_t OFF_WRO = OFF_WA + (size_t)12544 * 2048 * 2;
constexpr size_t OFF_WSO = OFF_WRO + (size_t)2048 * 2048 * 2;
constexpr size_t OFF_WO = OFF_WSO + (size_t)2048 * 4096 * 2;
constexpr size_t OFF_MOD = OFF_WO + (size_t)2048 * 2048 * 2;
constexpr size_t OFF_SUMSQ = OFF_MOD + 2 * 12288 * 4;
constexpr size_t OFF_BAR = OFF_SUMSQ + (size_t)SEQ * 4;
constexpr size_t OFF_SUMSQ2 = OFF_BAR + 16384;
constexpr size_t OFF_BIAS1 = OFF_SUMSQ2 + (size_t)SEQ * 4;
constexpr size_t OFF_ROPE = OFF_BIAS1 + (size_t)DFF * 4;
constexpr size_t WS_NEED = OFF_ROPE + 256 * 32 * 2 * 4;
constexpr size_t OFF_BCRAW = OFF_SR, OFF_XTRAW = OFF_SS, OFF_YS = OFF_K, OFF_W1T = OFF_SR, OFF_W2T = OFF_SR + (size_t)8192 * 2048 * 2;
constexpr size_t OFF_G = OFF_XT, OFF_H1 = OFF_SS, OFF_M = OFF_B, OFF_F = OFF_Q, OFF_A1 = OFF_K;
constexpr size_t OOFF_U = 0, OOFF_WB = SZQ;

struct Params {
  const float *x, *c, *ctx, *c_ctx, *w_mod, *b_mod, *norm1_w, *w_in, *conv_w, *conv_b, *ret_decay_logit, *ret_norm_w, *ssd_a_log,
      *ssd_dt_bias, *ssd_d, *ssd_norm_w, *w_ret_out, *w_ssd_out, *w_o, *norm2_w, *w_mlp1, *w_mlp2, *final_norm_w;
  unsigned char* ws;
  unsigned char* out;
};

extern __shared__ __attribute__((aligned(16))) unsigned char smem[];

typedef __bf16 bf16x2_t __attribute__((ext_vector_type(2)));
__device__ __forceinline__ unsigned cvt_pk_bf16(float lo, float hi) {
  f32x2 v = {lo, hi};
  bf16x2_t b = __builtin_convertvector(v, bf16x2_t);
  return __builtin_bit_cast(unsigned, b);
}
__device__ __forceinline__ float bf2f(unsigned short v) { return __uint_as_float((unsigned)v << 16); }
__device__ __forceinline__ float bflo(unsigned v) { return __uint_as_float(v << 16); }
__device__ __forceinline__ float bfhi(unsigned v) { return __uint_as_float(v & 0xffff0000u); }
__device__ __forceinline__ float sigmoidf_(float x) { return __builtin_amdgcn_rcpf(1.0f + __expf(-x)); }
__device__ __forceinline__ float siluf_(float x) { return x * __builtin_amdgcn_rcpf(1.0f + __expf(-x)); }
__device__ __forceinline__ float softplusf_(float x) { const float e = __expf(x); return x > 20.f ? x : (x < -6.f ? e * (1.0f - 0.5f * e) : __logf(1.0f + e)); }
__device__ __forceinline__ float wave_sum(float v) {
#pragma unroll
  for (int o = 32; o > 0; o >>= 1) v += __shfl_xor(v, o);
  return v;
}
__device__ __forceinline__ bf16x8 mk8(bf16x4 a, bf16x4 b) { return __builtin_shufflevector(a, b, 0, 1, 2, 3, 4, 5, 6, 7); }
__device__ __forceinline__ bf16x8 as_bf16x8(u32x4 v) { union { u32x4 u; bf16x8 b; } x; x.u = v; return x.b; }
__device__ __forceinline__ u32x4 as_u32x4(bf16x8 v) { union { u32x4 u; bf16x8 b; } x; x.b = v; return x.u; }
#define MFMA(a, b, c) __builtin_amdgcn_mfma_f32_16x16x32_bf16((a), (b), (c), 0, 0, 0)

constexpr int BM = 256, BK = 64, HALF = 128, HT = HALF * BK;
__device__ __forceinline__ int lds_byte(int r, int c) {
  int st = (r >> 4) * 2 + (c >> 5), rr = r & 15, cc = c & 31, ob = rr * 64 + cc * 2;
  return st * 1024 + (ob ^ (((ob >> 9) & 1) << 5));
}
__device__ __forceinline__ void stage_rc(int b, int& Rr, int& Cc) {
  int st = b / 1024, sb = b % 1024, swz = sb ^ (((sb >> 9) & 1) << 5);
  Rr = (st >> 1) * 16 + swz / 64;
  Cc = (st & 1) * 32 + (swz % 64) / 2;
}

template <class Epi>
__device__ __forceinline__ void gemm_unit(const bf16_t* __restrict__ A, int lda, const bf16_t* __restrict__ Bt, int ldb, int K, int pm,
                                          int pn, const Epi& epi) {
  typedef __attribute__((address_space(3))) unsigned char lds_u8;
  lds_u8* lds = (lds_u8*)smem;
  int tid = threadIdx.x;
  asm volatile("" : "+v"(tid));
  const int wid = __builtin_amdgcn_readfirstlane(tid >> 6), lane = tid & 63, wr = wid >> 2, wc = wid & 3, fr = lane & 15, fq = lane >> 4;
  unsigned voffA[2], voffB[2];
#pragma unroll
  for (int i = 0; i < 2; ++i) {
    int Rr, Cc; stage_rc(tid * 16 + i * 8192, Rr, Cc);
    const int rho = Rr & 31, Rb = (Rr & ~31) + 8 * ((rho & 15) >> 2) + 4 * (rho >> 4) + (rho & 3);
    voffA[i] = (unsigned)(Rr * lda + Cc) * 2u; voffB[i] = (unsigned)(Rb * ldb + Cc) * 2u;
  }
  const size_t kstep = (size_t)(BK * 2);
  const size_t hstepA = (size_t)HALF * lda * 2, hstepB = (size_t)HALF * ldb * 2;
  const unsigned ldsw = (unsigned)wid * 1024u;
  const int aoff = lds_byte(wr * 64 + fr, fq * 8), boff = lds_byte(wc * 32 + fr, fq * 8);
  constexpr int HTB = HT * 2;
#define SAo(b, h) (((b) * 2 + (h)) * HTB)
#define SBo(b, h) ((4 + (b) * 2 + (h)) * HTB)
#define STAGE(bufoff, gbase, voff) do { _Pragma("unroll") for (int _i = 0; _i < 2; ++_i) \
    __builtin_amdgcn_global_load_lds((const unsigned*)((const char*)(gbase) + (voff)[_i]), (__attribute__((address_space(3))) unsigned*)(lds + (bufoff) + ldsw + _i * 8192), 16, 0, 0); } while (0)
#define LDA(dst, b, h) do { _Pragma("unroll") for (int m = 0; m < 4; ++m) _Pragma("unroll") for (int k = 0; k < 2; ++k) dst[m][k] = *(const __attribute__((address_space(3))) bf16x8*)(lds + SAo(b, h) + aoff + m * 2048 + k * 1024); } while (0)
#define LDB(dst, b, h) do { _Pragma("unroll") for (int n = 0; n < 2; ++n) _Pragma("unroll") for (int k = 0; k < 2; ++k) dst[n][k] = *(const __attribute__((address_space(3))) bf16x8*)(lds + SBo(b, h) + boff + n * 2048 + k * 1024); } while (0)
#define MMA(ai, bj, At_, Bt_) do { __builtin_amdgcn_s_setprio(1); _Pragma("unroll") for (int m = 0; m < 4; ++m) _Pragma("unroll") for (int n = 0; n < 2; ++n) _Pragma("unroll") for (int k = 0; k < 2; ++k) \
    acc[ai][bj][m][n] = MFMA(Bt_[n][k], At_[m][k], acc[ai][bj][m][n]); __builtin_amdgcn_s_setprio(0); } while (0)
#define WAIT_V(n) asm volatile("s_waitcnt vmcnt(" #n ")" ::: "memory")
#define WAIT_L(n) asm volatile("s_waitcnt lgkmcnt(" #n ")" ::: "memory")
#define BAR __builtin_amdgcn_s_barrier()
#define SCHED __builtin_amdgcn_sched_barrier(0)
  const int brow = pm * BM, bcol = pn * BM;
  f32x4 acc[2][2][4][2];
#pragma unroll
  for (int a = 0; a < 2; ++a)
#pragma unroll
    for (int b = 0; b < 2; ++b)
#pragma unroll
      for (int m = 0; m < 4; ++m)
#pragma unroll
        for (int n = 0; n < 2; ++n) acc[a][b][m][n] = (f32x4){0.f, 0.f, 0.f, 0.f};
  bf16x8 At[4][2], B0[2][2], B1[2][2];
  const int nt = K / BK;
  const char* cA = (const char*)A + (size_t)brow * lda * 2;
  const char* cB = (const char*)Bt + (size_t)bcol * ldb * 2;
  STAGE(SBo(0, 0), cB, voffB); STAGE(SAo(0, 0), cA, voffA); STAGE(SBo(0, 1), cB + hstepB, voffB); STAGE(SAo(0, 1), cA + hstepA, voffA);
  if (wr == 1) BAR;
  WAIT_V(4); BAR;
  STAGE(SBo(1, 0), cB + kstep, voffB); STAGE(SAo(1, 0), cA + kstep, voffA); STAGE(SBo(1, 1), cB + hstepB + kstep, voffB);
  WAIT_V(6); BAR;
  for (int t = 0; t < nt - 2; t += 2) {
    const char* a1 = cA + (size_t)(t + 1) * kstep;
    const char* a2 = cA + (size_t)(t + 2) * kstep; const char* b2 = cB + (size_t)(t + 2) * kstep;
    const char* a3 = a2 + kstep; const char* b3 = b2 + kstep;
    LDB(B0, 0, 0); SCHED; LDA(At, 0, 0); STAGE(SAo(1, 1), a1 + hstepA, voffA);
    WAIT_L(8); BAR; WAIT_L(0); MMA(0, 0, At, B0); BAR; SCHED;
    LDB(B1, 0, 1); STAGE(SBo(0, 0), b2, voffB);
    BAR; WAIT_L(0); MMA(0, 1, At, B1); BAR;
    LDA(At, 0, 1); STAGE(SAo(0, 0), a2, voffA);
    BAR; WAIT_L(0); MMA(1, 0, At, B0); BAR; SCHED;
    STAGE(SBo(0, 1), b2 + hstepB, voffB);
    WAIT_V(6); BAR; MMA(1, 1, At, B1); BAR;
    LDB(B0, 1, 0); SCHED; LDA(At, 1, 0); STAGE(SAo(0, 1), a2 + hstepA, voffA);
    WAIT_L(8); BAR; WAIT_L(0); MMA(0, 0, At, B0); BAR; SCHED;
    LDB(B1, 1, 1); STAGE(SBo(1, 0), b3, voffB);
    BAR; WAIT_L(0); MMA(0, 1, At, B1); BAR;
    LDA(At, 1, 1); STAGE(SAo(1, 0), a3, voffA);
    BAR; WAIT_L(0); MMA(1, 0, At, B0); BAR; SCHED;
    STAGE(SBo(1, 1), b3 + hstepB, voffB);
    WAIT_V(6); BAR; MMA(1, 1, At, B1); BAR;
  }
  { const char* a1 = cA + (size_t)(nt - 1) * kstep;
    LDB(B0, 0, 0); LDA(At, 0, 0); STAGE(SAo(1, 1), a1 + hstepA, voffA);
    BAR; WAIT_L(0); MMA(0, 0, At, B0); BAR;
    LDB(B1, 0, 1); BAR; WAIT_L(0); MMA(0, 1, At, B1); BAR;
    LDA(At, 0, 1); WAIT_V(4); BAR; WAIT_L(0); MMA(1, 0, At, B0); MMA(1, 1, At, B1); BAR; }
  { LDB(B0, 1, 0); LDA(At, 1, 0); WAIT_V(2); BAR; WAIT_L(0); MMA(0, 0, At, B0); BAR;
    LDB(B1, 1, 1); WAIT_V(0); BAR; WAIT_L(0); MMA(0, 1, At, B1); BAR;
    LDA(At, 1, 1); BAR; WAIT_L(0); MMA(1, 0, At, B0); MMA(1, 1, At, B1); BAR; }
  if (wr == 0) BAR;
#pragma unroll
  for (int ai = 0; ai < 2; ++ai)
#pragma unroll
    for (int m = 0; m < 4; ++m) {
      const int row = brow + ai * HALF + wr * 64 + m * 16 + fr;
#pragma unroll
      for (int bj = 0; bj < 2; ++bj)
#pragma unroll
        for (int n = 0; n < 2; ++n) epi(acc[ai][bj][m][n], row, bcol + bj * HALF + wc * 32 + fq * 8 + n * 4, pm, pn);
      asm volatile("" ::: "memory");
    }
  __syncthreads();
}

__device__ __forceinline__ void unit_map(int wgid, int nM, int nN, int& pm, int& pn) {
  const int nwg = nM * nN, NX = 8, WGM = 4;
  { const int q = nwg / NX, r = nwg % NX, xcd = wgid % NX, off = wgid / NX; wgid = (xcd < r ? xcd * (q + 1) : r * (q + 1) + (xcd - r) * q) + off; }
  const int nig = WGM * nN, gid = wgid / nig, fm = gid * WGM, gsz = (nM - fm) < WGM ? (nM - fm) : WGM;
  pm = fm + ((wgid % nig) % gsz);
  pn = (wgid % nig) / gsz;
}

struct EpiA1 {
  bf16_t *Q, *Kb, *BC; float* DTRAW; const float* rope;
  __device__ __forceinline__ void operator()(const f32x4& v, int row, int col, int pm, int pn) const {
    if (pn < 16) {
      f32x4 o = v;
      const bool isk = pn >= 8;
      if (isk) o = o * 0.08838834764831845f;
      if (pm > 0) {
        const int t = row - CTX, cl = col & 127, half = cl >> 6, d0 = (cl & 63) >> 1;
        const int pos = half ? (t & 63) : (t >> 6);
        const f32x4 cs = *(const f32x4*)(rope + ((size_t)pos * 32 + d0) * 2);
        f32x4 q;
        q[0] = o[0] * cs[0] - o[1] * cs[1]; q[1] = o[0] * cs[1] + o[1] * cs[0];
        q[2] = o[2] * cs[2] - o[3] * cs[3]; q[3] = o[2] * cs[3] + o[3] * cs[2];
        o = q;
      }
      u32x2 w; w.x = cvt_pk_bf16(o[0], o[1]); w.y = cvt_pk_bf16(o[2], o[3]);
      bf16_t* dst = (isk ? Kb : Q) + (size_t)row * 2048 + (col & 2047);
      *(u32x2*)dst = w;
    } else if (pn < 24) {
      u32x2 w; w.x = cvt_pk_bf16(v[0], v[1]); w.y = cvt_pk_bf16(v[2], v[3]);
      *(u32x2*)(BC + (size_t)row * 2048 + (col - 4096)) = w;
    } else {
      const int cl = col - 6144;
      if (cl < 128) *(f32x4*)(DTRAW + (size_t)row * 128 + cl) = v;
    }
  }
};
struct EpiA2 {
  bf16_t *VT, *XTRAW;
  __device__ __forceinline__ void operator()(const f32x4& v, int row, int col, int pm, int pn) const {
    u32x2 w; w.x = cvt_pk_bf16(v[0], v[1]); w.y = cvt_pk_bf16(v[2], v[3]);
    bf16_t* dst = row < 2048 ? VT + (size_t)row * R + col : XTRAW + (size_t)(row - 2048) * R + col;
    *(u32x2*)dst = w;
  }
};
struct EpiB {
  bf16_t *Q, *YS, *G; const float* ssd_norm_w; float* SUMSQ;
  __device__ __forceinline__ void operator()(const f32x4& v, int row, int col, int pm, int pn) const {
    if (pn < 8) {
      bf16_t* p = Q + (size_t)(row + CTX) * 2048 + col;
      const u32x2 y = *(const u32x2*)p;
      u32x2 w;
      w.x = cvt_pk_bf16(bflo(y.x) * siluf_(v[0]), bfhi(y.x) * siluf_(v[1]));
      w.y = cvt_pk_bf16(bflo(y.y) * siluf_(v[2]), bfhi(y.y) * siluf_(v[3]));
      *(u32x2*)p = w;
    } else if (pn < 24) {
      const int zc = col - 2048;
      bf16_t* p = YS + (size_t)row * 4096 + zc;
      const u32x2 y = *(const u32x2*)p;
      const f32x4 nw = *(const f32x4*)(ssd_norm_w + zc);
      const float t0 = bflo(y.x) * siluf_(v[0]), t1 = bfhi(y.x) * siluf_(v[1]), t2 = bflo(y.y) * siluf_(v[2]), t3 = bfhi(y.y) * siluf_(v[3]);
      float ss = t0 * t0 + t1 * t1 + t2 * t2 + t3 * t3;
      ss += __shfl_xor(ss, 16); ss += __shfl_xor(ss, 32);
      if ((threadIdx.x & 48) == 0) atomicAdd(SUMSQ + row, ss);
      u32x2 w; w.x = cvt_pk_bf16(t0 * nw[0], t1 * nw[1]); w.y = cvt_pk_bf16(t2 * nw[2], t3 * nw[3]);
      *(u32x2*)p = w;
    } else {
      u32x2 w; w.x = cvt_pk_bf16(sigmoidf_(v[0]), sigmoidf_(v[1])); w.y = cvt_pk_bf16(sigmoidf_(v[2]), sigmoidf_(v[3]));
      *(u32x2*)(G + (size_t)row * 4096 + (col - 6144)) = w;
    }
  }
};
struct EpiO1a {
  const bf16_t* G; bf16_t* M;
  __device__ __forceinline__ void operator()(const f32x4& v, int row, int col, int pm, int pn) const {
    const u32x2 g = *(const u32x2*)(G + (size_t)row * 4096 + col);
    u32x2 w;
    w.x = cvt_pk_bf16(bflo(g.x) * v[0], bfhi(g.x) * v[1]);
    w.y = cvt_pk_bf16(bflo(g.y) * v[2], bfhi(g.y) * v[3]);
    *(u32x2*)(M + (size_t)row * 2048 + col) = w;
  }
};
struct EpiO1b {
  const bf16_t* G; const float* SUMSQ; bf16_t* M;
  __device__ __forceinline__ void operator()(const f32x4& v, int row, int col, int pm, int pn) const {
    const u32x2 g = *(const u32x2*)(G + (size_t)row * 4096 + 2048 + col);
    const float r = rsqrtf(SUMSQ[row] * (1.0f / 4096.0f) + EPS);
    const u32x2 t = *(const u32x2*)(M + (size_t)row * 2048 + col);
    u32x2 w;
    w.x = cvt_pk_bf16(bflo(t.x) + bflo(g.x) * r * v[0], bfhi(t.x) + bfhi(g.x) * r * v[1]);
    w.y = cvt_pk_bf16(bflo(t.y) + bflo(g.y) * r * v[2], bfhi(t.y) + bfhi(g.y) * r * v[3]);
    *(u32x2*)(M + (size_t)row * 2048 + col) = w;
  }
};
struct EpiRes {
  const float* base; const float* gate; float* H; bool do_store;
  __device__ __forceinline__ void operator()(const f32x4& v, int row, int col, int pm, int pn) const {
    const f32x4 b = *(const f32x4*)(base + (size_t)row * 2048 + col);
    const f32x4 g = *(const f32x4*)(gate + col);
    if (do_store) *(f32x4*)(H + (size_t)row * 2048 + col) = b + g * v;
  }
};
struct EpiRes9 {
  const float* base; const float* gate; float* H; const float* nw; const float* scf; bf16_t* F; float* SS2;
  __device__ __forceinline__ void operator()(const f32x4& v, int row, int col, int pm, int pn) const {
    const f32x4 b = *(const f32x4*)(base + (size_t)row * 2048 + col);
    const f32x4 g = *(const f32x4*)(gate + col);
    const f32x4 h = b + g * v;
    *(f32x4*)(H + (size_t)row * 2048 + col) = h;
    const f32x4 w = *(const f32x4*)(nw + col), sc = *(const f32x4*)(scf + col);
    u32x2 o;
    o.x = cvt_pk_bf16(h[0] * w[0] * (1.0f + sc[0]), h[1] * w[1] * (1.0f + sc[1]));
    o.y = cvt_pk_bf16(h[2] * w[2] * (1.0f + sc[2]), h[3] * w[3] * (1.0f + sc[3]));
    *(u32x2*)(F + (size_t)row * 2048 + col) = o;
    float ss = h[0] * h[0] + h[1] * h[1] + h[2] * h[2] + h[3] * h[3];
    ss += __shfl_xor(ss, 16); ss += __shfl_xor(ss, 32);
    if ((threadIdx.x & 48) == 0) atomicAdd(SS2 + row, ss);
  }
};
struct EpiM1 {
  bf16_t* A1; const float* SS2; const float* bias1;
  __device__ __forceinline__ void operator()(const f32x4& v, int row, int col, int pm, int pn) const {
    const float r_ = rsqrtf(SS2[row] * (1.0f / DM) + EPS);
    const f32x4 bi = *(const f32x4*)(bias1 + col);
    f32x4 o;
#pragma unroll
    for (int j = 0; j < 4; ++j) { const float r = fmaxf(v[j] * r_ + bi[j], 0.f); o[j] = r * r; }
    u32x2 w; w.x = cvt_pk_bf16(o[0], o[1]); w.y = cvt_pk_bf16(o[2], o[3]);
    *(u32x2*)(A1 + (size_t)row * DFF + col) = w;
  }
};

__device__ __forceinline__ void convert_tile(const float* __restrict__ src, int ldw, int c0, int K, bf16_t* __restrict__ dst, int tc, int kt, int tid) {
  float* tile = (float*)smem;
  const int c4 = (tid & 63) * 4, kq = tid >> 6;
  f32x4 v[8];
#pragma unroll
  for (int i = 0; i < 8; ++i) v[i] = *(const f32x4*)(src + (size_t)(kt * 64 + kq + i * 8) * ldw + c0 + tc * 256 + c4);
#pragma unroll
  for (int i = 0; i < 8; ++i) {
    float* tp = tile + (kq + i * 8) * 257 + c4;
    tp[0] = v[i][0]; tp[1] = v[i][1]; tp[2] = v[i][2]; tp[3] = v[i][3];
  }
  __syncthreads();
  const int c = tid >> 1, k32 = (tid & 1) * 32;
  bf16_t* dp = dst + (size_t)(tc * 256 + c) * K + kt * 64 + k32;
#pragma unroll
  for (int q = 0; q < 4; ++q) {
    const float* tp = tile + (k32 + q * 8) * 257 + c;
    u32x4 w;
    w.x = cvt_pk_bf16(tp[0], tp[257]); w.y = cvt_pk_bf16(tp[2 * 257], tp[3 * 257]);
    w.z = cvt_pk_bf16(tp[4 * 257], tp[5 * 257]); w.w = cvt_pk_bf16(tp[6 * 257], tp[7 * 257]);
    *(u32x4*)(dp + q * 8) = w;
  }
}

__device__ __forceinline__ void convert_segment(const float* __restrict__ src, int ldw, int c0, int ncols, int K, bf16_t* __restrict__ dst, bool perm,
                                                const float* bias_vec = nullptr, float* bias_out = nullptr) {
  float* tile = (float*)smem;
  int tid = threadIdx.x;
  asm volatile("" : "+v"(tid));
  const int tk = K / 64, ntc = (ncols + 255) / 256, ntiles = ntc * tk;
  const int c4 = (tid & 63) * 4, kq = tid >> 6;
  f32x4 v[8];
  auto load_tile = [&](int t) {
    const int tc = t / tk, kt = t % tk;
    const bool okc = tc * 256 + c4 < ncols;
#pragma unroll
    for (int i = 0; i < 8; ++i)
      v[i] = okc ? *(const f32x4*)(src + (size_t)(kt * 64 + kq + i * 8) * ldw + c0 + tc * 256 + c4) : (f32x4){0.f, 0.f, 0.f, 0.f};
  };
  if ((int)blockIdx.x < ntiles) load_tile(blockIdx.x);
  for (int t = blockIdx.x; t < ntiles; t += gridDim.x) {
    const int tc = t / tk, kt = t % tk;
    __syncthreads();
#pragma unroll
    for (int i = 0; i < 8; ++i) {
      float* tp = tile + (kq + i * 8) * 257 + c4;
      tp[0] = v[i][0]; tp[1] = v[i][1]; tp[2] = v[i][2]; tp[3] = v[i][3];
    }
    if (t + (int)gridDim.x < ntiles) load_tile(t + gridDim.x);
    __syncthreads();
    if (bias_out != nullptr && tid < 256) {
      float a = 0.f;
#pragma unroll 8
      for (int k = 0; k < 64; ++k) a += tile[k * 257 + tid] * bias_vec[kt * 64 + k];
      atomicAdd(bias_out + tc * 256 + tid, a);
    }
    {
      const int c = tid >> 1, k32 = (tid & 1) * 32;
      const int cr = c & 63;
      const int sc = perm ? ((c & ~63) + (cr & 1) * 32 + (cr >> 1)) : c;
      if (tc * 256 + c < ncols) {
        bf16_t* dp = dst + (size_t)(tc * 256 + c) * K + kt * 64 + k32;
#pragma unroll
        for (int q = 0; q < 4; ++q) {
          const float* tp = tile + (k32 + q * 8) * 257 + sc;
          u32x4 w;
          w.x = cvt_pk_bf16(tp[0], tp[257]); w.y = cvt_pk_bf16(tp[2 * 257], tp[3 * 257]);
          w.z = cvt_pk_bf16(tp[4 * 257], tp[5 * 257]); w.w = cvt_pk_bf16(tp[6 * 257], tp[7 * 257]);
          *(u32x4*)(dp + q * 8) = w;
        }
      }
    }
  }
  __syncthreads();
}

__device__ __forceinline__ void modnorm_rows(const float* __restrict__ xa, int rows_a, const float* __restrict__ xb, int rows_b, const float* __restrict__ nw,
                             const float* __restrict__ sca, const float* __restrict__ sha, const float* __restrict__ scb,
                             const float* __restrict__ shb, bf16_t* __restrict__ outp) {
  int tid = threadIdx.x;
  asm volatile("" : "+v"(tid));
  const int lane = tid & 63, gw = blockIdx.x * (NTH / 64) + (tid >> 6), nw_ = gridDim.x * (NTH / 64);
  for (int r = gw; r < rows_a + rows_b; r += nw_) {
    const bool isa = r < rows_a;
    const float* xr = isa ? xa + (size_t)r * DM : xb + (size_t)(r - rows_a) * DM;
    const float* sc = isa ? sca : scb;
    const float* sh = isa ? sha : shb;
    f32x4 v[8];
    float ss = 0.f;
#pragma unroll
    for (int i = 0; i < 8; ++i) { v[i] = __builtin_nontemporal_load((const f32x4*)(xr + i * 256 + lane * 4)); ss += v[i][0] * v[i][0] + v[i][1] * v[i][1] + v[i][2] * v[i][2] + v[i][3] * v[i][3]; }
    ss = wave_sum(ss);
    const float rs = rsqrtf(ss * (1.0f / DM) + EPS);
#pragma unroll
    for (int i = 0; i < 8; ++i) {
      const int cidx = i * 256 + lane * 4;
      const f32x4 w = *(const f32x4*)(nw + cidx), s = *(const f32x4*)(sc + cidx), b = *(const f32x4*)(sh + cidx);
      f32x4 o;
#pragma unroll
      for (int j = 0; j < 4; ++j) o[j] = v[i][j] * rs * w[j] * (1.0f + s[j]) + b[j];
      u32x2 pk; pk.x = cvt_pk_bf16(o[0], o[1]); pk.y = cvt_pk_bf16(o[2], o[3]);
      *(u32x2*)(outp + (size_t)r * DM + cidx) = pk;
    }
  }
}

template <int MODE>
__device__ __forceinline__ void state_build_item(const Params& p, int c, int hg) {
  unsigned char* ws = p.ws;
  int tid = threadIdx.x;
  asm volatile("" : "+v"(tid));
  const int wid = tid >> 6, lane = tid & 63, fr = lane & 15, fq = lane >> 4;
  bf16_t* Kt = (bf16_t*)smem;
  bf16_t* Vt = (bf16_t*)(smem + 67584);
  float* wfs = (float*)(smem + 135168);
  float* wbs = wfs + 256;
  const bf16_t* Ksrc = MODE == 0 ? (const bf16_t*)(ws + OFF_K) : (const bf16_t*)(ws + OFF_B);
  const int kld = MODE == 0 ? 2048 : 1024;
  constexpr int NV = MODE == 0 ? 8 : 4;
  const bf16_t* Vsrc = MODE == 0 ? (const bf16_t*)(ws + OFF_VT) : (const bf16_t*)(ws + OFF_XT);
  const int PH = MODE == 0 ? 128 : 64;
  const float* CSF = (const float*)(ws + OFF_CSF); const float* RCSB = (const float*)(ws + OFF_RCSB);
  const float* DTF = (const float*)(ws + OFF_DTF); const float* DTB = (const float*)(ws + OFF_DTB);
  u32x4 vv[NV];
  float wr_[6] = {0.f, 0.f, 0.f, 0.f, 0.f, 0.f};
#define SB_PREFETCH(H_)                                                                                               \
  do {                                                                                                                \
    _Pragma("unroll") for (int i = 0; i < NV; ++i) {                                                                  \
      const int idx = tid + i * NTH, pp = idx >> 5, chn = idx & 31;                                                   \
      vv[i] = *(const u32x4*)(Vsrc + (size_t)((H_) * PH + pp) * R + c * CH + chn * 8);                                \
    }                                                                                                                 \
    if (MODE == 1 && tid < 256) {                                                                                     \
      const size_t rj = (size_t)(c * CH + tid) * 64 + (H_);                                                           \
      wr_[0] = CSF[(size_t)(c * CH + 255) * 64 + (H_)]; wr_[1] = CSF[rj]; wr_[2] = DTF[rj];                           \
      wr_[3] = RCSB[(size_t)(c * CH) * 64 + (H_)]; wr_[4] = RCSB[rj]; wr_[5] = DTB[rj];                               \
    }                                                                                                                 \
  } while (0)
  bf16x8 kv[8];
#pragma unroll
  for (int i = 0; i < 8; ++i) {
    const int idx = tid + i * NTH, j = idx >> 4, chn = idx & 15;
    kv[i] = *(const bf16x8*)(Ksrc + (size_t)(c * CH + j) * kld + hg * 128 + chn * 8);
  }
  SB_PREFETCH(MODE == 0 ? hg : hg * 8);
  __syncthreads();
#pragma unroll
  for (int i = 0; i < 8; ++i) {
    const int idx = tid + i * NTH, j = idx >> 4, chn = idx & 15;
#pragma unroll
    for (int e = 0; e < 8; ++e) Kt[(chn * 8 + e) * 264 + ((((j >> 3) ^ ((chn >> 1) & 7)) << 3) | (j & 7))] = (bf16_t)kv[i][e];
  }
  const int nheads = MODE == 0 ? 1 : 8;
  for (int hh = 0; hh < nheads; ++hh) {
    const int h = MODE == 0 ? hg : hg * 8 + hh;
    if (hh > 0) __syncthreads();
#pragma unroll
    for (int i = 0; i < NV; ++i) {
      const int idx = tid + i * NTH, pp = idx >> 5, chn = idx & 31;
      *(u32x4*)(Vt + pp * 264 + chn * 8) = vv[i];
    }
    if (tid < 256) {
      if (MODE == 0) {
        const float lgf = -log1pf(__expf(-p.ret_decay_logit[h])) * 1.4426950408889634f;
        const float lgb = -log1pf(__expf(-p.ret_decay_logit[16 + h])) * 1.4426950408889634f;
        wfs[tid] = exp2f((float)(255 - tid) * lgf);
        wbs[tid] = exp2f((float)tid * lgb);
      } else {
        wfs[tid] = __expf(wr_[0] - wr_[1]) * wr_[2];
        wbs[tid] = __expf(wr_[3] - wr_[4]) * wr_[5];
      }
    }
    __syncthreads();
    if (MODE == 1 && hh + 1 < nheads) SB_PREFETCH(h + 1);
    constexpr int NTL = MODE == 0 ? 8 : 4;
    const int p0 = MODE == 0 ? wid * 16 : (wid & 3) * 16;
    const int nt0 = MODE == 0 ? 0 : (wid >> 2) * 4;
    f32x4 af[NTL], ab[NTL];
#pragma unroll
    for (int i = 0; i < NTL; ++i) { af[i] = (f32x4){0.f, 0.f, 0.f, 0.f}; ab[i] = af[i]; }
#pragma unroll 2
    for (int kk = 0; kk < 8; ++kk) {
      const int jb = kk * 32 + fq * 8;
      const bf16x8 vr = *(const bf16x8*)(Vt + (p0 + fr) * 264 + jb);
      const f32x4 wf0 = *(const f32x4*)(wfs + jb), wf1 = *(const f32x4*)(wfs + jb + 4);
      const f32x4 wb0 = *(const f32x4*)(wbs + jb), wb1 = *(const f32x4*)(wbs + jb + 4);
      float x[8];
#pragma unroll
      for (int e = 0; e < 8; ++e) x[e] = bf2f((unsigned short)vr[e]);
      u32x4 uf, ub;
      uf.x = cvt_pk_bf16(x[0] * wf0[0], x[1] * wf0[1]); uf.y = cvt_pk_bf16(x[2] * wf0[2], x[3] * wf0[3]);
      uf.z = cvt_pk_bf16(x[4] * wf1[0], x[5] * wf1[1]); uf.w = cvt_pk_bf16(x[6] * wf1[2], x[7] * wf1[3]);
      ub.x = cvt_pk_bf16(x[0] * wb0[0], x[1] * wb0[1]); ub.y = cvt_pk_bf16(x[2] * wb0[2], x[3] * wb0[3]);
      ub.z = cvt_pk_bf16(x[4] * wb1[0], x[5] * wb1[1]); ub.w = cvt_pk_bf16(x[6] * wb1[2], x[7] * wb1[3]);
      const bf16x8 vf = as_bf16x8(uf), vb = as_bf16x8(ub);
#pragma unroll
      for (int i = 0; i < NTL; ++i) {
        const bf16x8 kf = *(const bf16x8*)(Kt + ((nt0 + i) * 16 + fr) * 264 + ((((jb >> 3) ^ ((nt0 + i) & 7))) << 3));
        af[i] = MFMA(kf, vf, af[i]);
        ab[i] = MFMA(kf, vb, ab[i]);
      }
    }
    bf16_t *df, *db;
    if (MODE == 0) {
      bf16_t* SR = (bf16_t*)(ws + OFF_SR);
      df = SR + ((size_t)(c * 2 + 0) * 16 + h) * 16384; db = SR + ((size_t)(c * 2 + 1) * 16 + h) * 16384;
    } else {
      bf16_t* SS = (bf16_t*)(ws + OFF_SS);
      df = SS + ((size_t)(c * 64 + h) * 2 + 0) * 8192; db = df + 8192;
    }
#pragma unroll
    for (int i = 0; i < NTL; ++i) {
      const int off = (p0 + fr) * 128 + (nt0 + i) * 16 + fq * 4;
      u32x2 w; w.x = cvt_pk_bf16(af[i][0], af[i][1]); w.y = cvt_pk_bf16(af[i][2], af[i][3]);
      *(u32x2*)(df + off) = w;
      w.x = cvt_pk_bf16(ab[i][0], ab[i][1]); w.y = cvt_pk_bf16(ab[i][2], ab[i][3]);
      *(u32x2*)(db + off) = w;
    }
  }
  __syncthreads();
}

__device__ __forceinline__ void ret_out_item(const Params& p, int cc, int h, int half, bool do_store) {
  unsigned char* ws = p.ws;
  int tid = threadIdx.x;
  asm volatile("" : "+v"(tid));
  const int wid = tid >> 6, lane = tid & 63, fr = lane & 15, fq = lane >> 4;
  bf16_t* Q = (bf16_t*)(ws + OFF_Q);
  const bf16_t* Kb = (const bf16_t*)(ws + OFF_K);
  const bf16_t* VT = (const bf16_t*)(ws + OFF_VT);
  const bf16_t* SR = (const bf16_t*)(ws + OFF_SR);
  const float lgf = -log1pf(__expf(-p.ret_decay_logit[h])) * 1.4426950408889634f;
  const float lgb = -log1pf(__expf(-p.ret_decay_logit[16 + h])) * 1.4426950408889634f;
  const int i0 = half * 128 + wid * 16, il = i0 + fr;
  const size_t grow = (size_t)cc * CH + il;
  bf16x8 qf[4];
#pragma unroll
  for (int kk = 0; kk < 4; ++kk) qf[kk] = *(const bf16x8*)(Q + grow * 2048 + h * 128 + kk * 32 + fq * 8);
  bf16_t* Hf = (bf16_t*)smem;
  bf16_t* Hb = (bf16_t*)(smem + 34816);
  __syncthreads();
  {
    u32x4 hv[8];
#pragma unroll
    for (int i = 0; i < 8; ++i) {
      const int idx = tid + i * NTH, dir = idx >> 11, rr = (idx >> 4) & 127, chn = idx & 15;
      hv[i] = *(const u32x4*)(SR + ((size_t)(cc * 2 + dir) * 16 + h) * 16384 + rr * 128 + chn * 8);
    }
#pragma unroll
    for (int i = 0; i < 8; ++i) {
      const int idx = tid + i * NTH, dir = idx >> 11, rr = (idx >> 4) & 127, chn = idx & 15;
      *(u32x4*)((dir ? Hb : Hf) + rr * 136 + chn * 8) = hv[i];
    }
  }
  __syncthreads();

  f32x4 Y[8];
  {
    const float ai = exp2f((float)(il + 1) * lgf), bi = exp2f((float)(256 - il) * lgb);
#pragma unroll
    for (int pt = 0; pt < 8; ++pt) {
      f32x4 a = {0.f, 0.f, 0.f, 0.f}, b = {0.f, 0.f, 0.f, 0.f};
#pragma unroll
      for (int kk = 0; kk < 4; ++kk) {
        const bf16x8 hf = *(const bf16x8*)(Hf + (pt * 16 + fr) * 136 + kk * 32 + fq * 8);
        const bf16x8 hb = *(const bf16x8*)(Hb + (pt * 16 + fr) * 136 + kk * 32 + fq * 8);
        a = MFMA(hf, qf[kk], a);
        b = MFMA(hb, qf[kk], b);
      }
      Y[pt] = a * ai + b * bi;
      __builtin_amdgcn_sched_barrier(0);
    }
  }
  __syncthreads();
  bf16_t* Ki = (bf16_t*)smem;
  bf16_t* Vt = (bf16_t*)(smem + 69632);
  {
    u32x4 kreg[8], vreg[8];
#pragma unroll
    for (int i = 0; i < 8; ++i) {
      const int idx = tid + i * NTH;
      kreg[i] = *(const u32x4*)(Kb + (size_t)(cc * CH + (idx >> 4)) * 2048 + h * 128 + (idx & 15) * 8);
      vreg[i] = *(const u32x4*)(VT + (size_t)(h * 128 + (idx >> 5)) * R + cc * CH + (idx & 31) * 8);
    }
#pragma unroll
    for (int i = 0; i < 8; ++i) {
      const int idx = tid + i * NTH;
      *(u32x4*)(Ki + (idx >> 4) * 136 + (idx & 15) * 8) = kreg[i];
    }
#pragma unroll
    for (int i = 0; i < 8; ++i) {
      const int idx = tid + i * NTH;
      *(u32x4*)(Vt + (idx >> 5) * 264 + (idx & 31) * 8) = vreg[i];
    }
  }
  __syncthreads();
  bf16x8 pf[8];
#pragma unroll
  for (int k2 = 0; k2 < 8; ++k2) {
    u32x4 pk;
#pragma unroll
    for (int s = 0; s < 2; ++s) {
      const int jt = k2 * 2 + s;
      f32x4 sacc = {0.f, 0.f, 0.f, 0.f};
#pragma unroll
      for (int kk = 0; kk < 4; ++kk) {
        const bf16x8 kf = *(const bf16x8*)(Ki + (jt * 16 + fr) * 136 + kk * 32 + fq * 8);
        sacc = MFMA(kf, qf[kk], sacc);
      }
      float w[4];
#pragma unroll
      for (int e = 0; e < 4; ++e) {
        const int dl = il - (jt * 16 + fq * 4 + e);
        w[e] = sacc[e] * __builtin_amdgcn_exp2f(dl >= 0 ? (float)dl * lgf : (float)(-dl) * lgb);
      }
      if (s == 0) { pk.x = cvt_pk_bf16(w[0], w[1]); pk.y = cvt_pk_bf16(w[2], w[3]); }
      else { pk.z = cvt_pk_bf16(w[0], w[1]); pk.w = cvt_pk_bf16(w[2], w[3]); }
    }
    pf[k2] = as_bf16x8(pk);
    __builtin_amdgcn_sched_barrier(0);
  }
#pragma unroll
  for (int pt = 0; pt < 8; ++pt) {
#pragma unroll
    for (int k2 = 0; k2 < 8; ++k2) {
      const bf16x4 lo = *(const bf16x4*)(Vt + (pt * 16 + fr) * 264 + k2 * 32 + fq * 4);
      const bf16x4 hi = *(const bf16x4*)(Vt + (pt * 16 + fr) * 264 + k2 * 32 + 16 + fq * 4);
      Y[pt] = MFMA(mk8(lo, hi), pf[k2], Y[pt]);
    }
    __builtin_amdgcn_sched_barrier(0);
  }
  float s1 = 0.f;
#pragma unroll
  for (int pt = 0; pt < 8; ++pt) s1 += (Y[pt][0] + Y[pt][1]) + (Y[pt][2] + Y[pt][3]);
  s1 += __shfl_xor(s1, 16); s1 += __shfl_xor(s1, 32);
  const float mu = s1 * (1.0f / 128.0f);
  float s2 = 0.f;
#pragma unroll
  for (int pt = 0; pt < 8; ++pt) {
#pragma unroll
    for (int e = 0; e < 4; ++e) { const float d = Y[pt][e] - mu; s2 += d * d; }
  }
  s2 += __shfl_xor(s2, 16); s2 += __shfl_xor(s2, 32);
  const float rstd = rsqrtf(s2 * (1.0f / 128.0f) + EPS);
#pragma unroll
  for (int pt = 0; pt < 8; ++pt) {
    const int pc = h * 128 + pt * 16 + fq * 4;
    const f32x4 nw = *(const f32x4*)(p.ret_norm_w + pc);
    u32x2 w;
    w.x = cvt_pk_bf16((Y[pt][0] - mu) * rstd * nw[0], (Y[pt][1] - mu) * rstd * nw[1]);
    w.y = cvt_pk_bf16((Y[pt][2] - mu) * rstd * nw[2], (Y[pt][3] - mu) * rstd * nw[3]);
    if (do_store) *(u32x2*)(Q + grow * 2048 + pc) = w;
  }
  __syncthreads();
}

__device__ __forceinline__ void ssd_out_item(const Params& p, int cc, int g, int half) {
  unsigned char* ws = p.ws;
  int tid = threadIdx.x;
  asm volatile("" : "+v"(tid));
  const int wid = tid >> 6, lane = tid & 63, fr = lane & 15, fq = lane >> 4;
  const bf16_t* Bb = (const bf16_t*)(ws + OFF_B);
  const bf16_t* Cb = (const bf16_t*)(ws + OFF_C);
  const bf16_t* XT = (const bf16_t*)(ws + OFF_XT);
  const bf16_t* SS = (const bf16_t*)(ws + OFF_SS);
  bf16_t* YS = (bf16_t*)(ws + OFF_YS);
  const float* CSF = (const float*)(ws + OFF_CSF); const float* RCSB = (const float*)(ws + OFF_RCSB);
  const float* DTF = (const float*)(ws + OFF_DTF); const float* DTB = (const float*)(ws + OFF_DTB);
  const int i0 = half * 128 + wid * 16, il = i0 + fr;
  const size_t grow = (size_t)cc * CH + il;
  bf16_t* Bi = (bf16_t*)smem;
  bf16_t* Hf = (bf16_t*)(smem + 69632);
  bf16_t* Hb = (bf16_t*)(smem + 87040);
  bf16_t* Xt = (bf16_t*)(smem + 104448);
  float* vcs = (float*)(smem + 138240);
  bf16x8 cf[4];
#pragma unroll
  for (int kk = 0; kk < 4; ++kk) cf[kk] = *(const bf16x8*)(Cb + grow * 1024 + g * 128 + kk * 32 + fq * 8);
  __syncthreads();
  {
    u32x4 bv[8];
#pragma unroll
    for (int i = 0; i < 8; ++i) {
      const int idx = tid + i * NTH;
      bv[i] = *(const u32x4*)(Bb + (size_t)(cc * CH + (idx >> 4)) * 1024 + g * 128 + (idx & 15) * 8);
    }
#pragma unroll
    for (int i = 0; i < 8; ++i) {
      const int idx = tid + i * NTH;
      *(u32x4*)(Bi + (idx >> 4) * 136 + (idx & 15) * 8) = bv[i];
    }
  }
  __syncthreads();
  u32x2 S[16];
#pragma unroll
  for (int jt = 0; jt < 16; ++jt) {
    f32x4 sacc = {0.f, 0.f, 0.f, 0.f};
#pragma unroll
    for (int kk = 0; kk < 4; ++kk) {
      const bf16x8 kf = *(const bf16x8*)(Bi + (jt * 16 + fr) * 136 + kk * 32 + fq * 8);
      sacc = MFMA(kf, cf[kk], sacc);
    }
    S[jt].x = cvt_pk_bf16(sacc[0], sacc[1]); S[jt].y = cvt_pk_bf16(sacc[2], sacc[3]);
  }
  __syncthreads();
  u32x2* Sl = (u32x2*)smem + wid * 1024;
#pragma unroll
  for (int jt = 0; jt < 16; ++jt) Sl[jt * 64 + lane] = S[jt];
  u32x4 hreg[4], xreg[4];
  float vr[4] = {0.f, 0.f, 0.f, 0.f};
#define SSD_PREFETCH(HH)                                                                                              \
  do {                                                                                                                \
    const int h_ = g * 8 + (HH);                                                                                      \
    _Pragma("unroll") for (int i = 0; i < 4; ++i) {                                                                   \
      const int idx = tid + i * NTH;                                                                                  \
      hreg[i] = *(const u32x4*)(SS + ((size_t)(cc * 64 + h_) * 2 + (idx >> 10)) * 8192 + ((idx >> 4) & 63) * 128 + (idx & 15) * 8); \
      xreg[i] = *(const u32x4*)(XT + (size_t)(h_ * 64 + (idx >> 5)) * R + cc * CH + (idx & 31) * 8);                  \
    }                                                                                                                 \
    if (tid < 256) {                                                                                                  \
      const size_t rj = (size_t)(cc * CH + tid) * 64 + h_;                                                            \
      vr[0] = CSF[rj]; vr[1] = RCSB[rj]; vr[2] = DTF[rj]; vr[3] = DTB[rj];                                            \
    }                                                                                                                 \
  } while (0)
  SSD_PREFETCH(0);
  for (int hh = 0; hh < 8; ++hh) {
    const int h = g * 8 + hh;
    __syncthreads();
#pragma unroll
    for (int i = 0; i < 4; ++i) {
      const int idx = tid + i * NTH;
      *(u32x4*)(((idx >> 10) ? Hb : Hf) + ((idx >> 4) & 63) * 136 + (idx & 15) * 8) = hreg[i];
      *(u32x4*)(Xt + (idx >> 5) * 264 + (idx & 31) * 8) = xreg[i];
    }
    if (tid < 256) {
      const float c2 = vr[0] * 1.4426950408889634f, r2 = vr[1] * 1.4426950408889634f;
      vcs[tid] = c2; vcs[256 + tid] = r2;
      vcs[512 + tid] = c2 - __log2f(vr[2]); vcs[768 + tid] = r2 - __log2f(vr[3]);
    }
    __syncthreads();
    if (hh < 7) SSD_PREFETCH(hh + 1);
    int ilv = il;
    asm volatile("" : "+v"(ilv));
    const float csi = vcs[il], rcsi = vcs[256 + il];
    f32x4 Y[4];
    {
      const float ai = exp2f(csi), bi = exp2f(rcsi);
#pragma unroll
      for (int pt = 0; pt < 4; ++pt) {
        f32x4 a = {0.f, 0.f, 0.f, 0.f}, b = {0.f, 0.f, 0.f, 0.f};
#pragma unroll
        for (int kk = 0; kk < 4; ++kk) {
          const bf16x8 hf = *(const bf16x8*)(Hf + (pt * 16 + fr) * 136 + kk * 32 + fq * 8);
          const bf16x8 hb = *(const bf16x8*)(Hb + (pt * 16 + fr) * 136 + kk * 32 + fq * 8);
          a = MFMA(hf, cf[kk], a);
          b = MFMA(hb, cf[kk], b);
        }
        Y[pt] = a * ai + b * bi;
        __builtin_amdgcn_sched_barrier(0);
      }
    }
#pragma unroll 1
    for (int k2 = 0; k2 < 8; ++k2) {
      u32x4 pk;
#pragma unroll
      for (int s = 0; s < 2; ++s) {
        const int jt = k2 * 2 + s, jb = jt * 16 + fq * 4;
        const u32x2 sp = Sl[jt * 64 + lane];
        float w[4];
        const float sv[4] = {bflo(sp.x), bfhi(sp.x), bflo(sp.y), bfhi(sp.y)};
        const int dtile = __builtin_amdgcn_readfirstlane(half * 8 + wid);
        if (jt < dtile) {
          const f32x4 af = *(const f32x4*)(vcs + 512 + jb);
#pragma unroll
          for (int e = 0; e < 4; ++e) w[e] = sv[e] * __builtin_amdgcn_exp2f(csi - af[e]);
        } else if (jt > dtile) {
          const f32x4 ab = *(const f32x4*)(vcs + 768 + jb);
#pragma unroll
          for (int e = 0; e < 4; ++e) w[e] = sv[e] * __builtin_amdgcn_exp2f(rcsi - ab[e]);
        } else {
          const f32x4 af = *(const f32x4*)(vcs + 512 + jb), ab = *(const f32x4*)(vcs + 768 + jb);
#pragma unroll
          for (int e = 0; e < 4; ++e) w[e] = sv[e] * __builtin_amdgcn_exp2f(((jb + e) <= ilv) ? (csi - af[e]) : (rcsi - ab[e]));
        }
        if (s == 0) { pk.x = cvt_pk_bf16(w[0], w[1]); pk.y = cvt_pk_bf16(w[2], w[3]); }
        else { pk.z = cvt_pk_bf16(w[0], w[1]); pk.w = cvt_pk_bf16(w[2], w[3]); }
      }
      const bf16x8 pfr = as_bf16x8(pk);
#pragma unroll
      for (int pt = 0; pt < 4; ++pt) {
        const bf16x4 lo = *(const bf16x4*)(Xt + (pt * 16 + fr) * 264 + k2 * 32 + fq * 4);
        const bf16x4 hi = *(const bf16x4*)(Xt + (pt * 16 + fr) * 264 + k2 * 32 + 16 + fq * 4);
        Y[pt] = MFMA(mk8(lo, hi), pfr, Y[pt]);
      }
      __builtin_amdgcn_sched_barrier(0);
    }
    const float dsk = p.ssd_d[h];
#pragma unroll
    for (int pt = 0; pt < 4; ++pt) {
      float o[4];
#pragma unroll
      for (int e = 0; e < 4; ++e) o[e] = Y[pt][e] + bf2f(Xt[(pt * 16 + fq * 4 + e) * 264 + il]) * dsk;
      u32x2 w; w.x = cvt_pk_bf16(o[0], o[1]); w.y = cvt_pk_bf16(o[2], o[3]);
      *(u32x2*)(YS + ((size_t)(cc - 1) * CH + il) * 4096 + h * 64 + pt * 16 + fq * 4) = w;
    }
  }
  __syncthreads();
}

#ifdef PROBE_AFTER
__device__ void probe_dump(const Params& p, size_t lo0, size_t hi0, size_t lo1, size_t hi1) {
  float* outp = (float*)p.out;
  const size_t n = (size_t)SEQ * DM;
  const bf16_t* b0 = (const bf16_t*)(p.ws + lo0); const size_t n0 = (hi0 - lo0) / 2;
  const bf16_t* b1 = (const bf16_t*)(p.ws + lo1); const size_t n1 = (hi1 - lo1) / 2;
  const size_t k0 = (n0 + n - 1) / n, k1 = n1 ? (n1 + n - 1) / n : 0;
  for (size_t i = (size_t)blockIdx.x * NTH + threadIdx.x; i < n; i += (size_t)gridDim.x * NTH) {
    float a = 0.f;
    for (size_t k = 0; k < k0; ++k) { const size_t j = i + k * n; if (j < n0) { float v = bf2f(b0[j]); if (!(fabsf(v) < 1e30f)) v = 777.f; a += v; } }
    for (size_t k = 0; k < k1; ++k) { const size_t j = i + k * n; if (j < n1) { float v = bf2f(b1[j]); if (!(fabsf(v) < 1e30f)) v = 777.f; a += v; } }
    outp[i] = a;
  }
}
#define PROBE_POINT(idx, lo0, hi0, lo1, hi1) if (PROBE_AFTER == (idx)) { probe_dump(p, lo0, hi0, lo1, hi1); return; }
#else
#define PROBE_POINT(idx, lo0, hi0, lo1, hi1)
#endif

#define XB_TMO      128
#define XB_XCNT(j)  (256  + 64 * (j))
#define XB_XSUB(j)  (1280 + 64 * (j))
#define XB_XGEN(j)  (2304 + 64 * (j))
#define XB_TOP      3328
#define XB_TOPGEN   3392
#define XCD_BAR_WORDS 3456
#define XB_SPIN_CAP (1u << 18)
#define LAS __attribute__((address_space(3)))
__device__ __forceinline__ unsigned xb_ld(unsigned* p)              { return __hip_atomic_load(p, __ATOMIC_RELAXED, __HIP_MEMORY_SCOPE_AGENT); }
__device__ __forceinline__ unsigned xb_add(unsigned* p, unsigned v) { return __hip_atomic_fetch_add(p, v, __ATOMIC_RELAXED, __HIP_MEMORY_SCOPE_AGENT); }
__device__ __forceinline__ unsigned xb_xcc_id() { return (unsigned)__builtin_amdgcn_s_getreg((3 << 11) | 20) & 0xFu; }
#define XB_SPIN(cond, bar) do { unsigned _sp = 0; while (cond) { __builtin_amdgcn_s_sleep(1); \
    if ((++_sp & 255u) == 0u) { if (xb_ld(&(bar)[XB_TMO])) break; if (_sp > XB_SPIN_CAP) { atomicAdd(&(bar)[XB_TMO], 1u); break; } } } } while (0)
struct XcdBarrier { unsigned* bar; unsigned x; volatile LAS unsigned* st; };
__device__ __forceinline__ XcdBarrier xcd_barrier_post(unsigned* bar, volatile LAS unsigned* st) {
  XcdBarrier b; b.bar = bar; b.x = xb_xcc_id(); b.st = st;
  if (threadIdx.x == 0) (void)xb_add(&bar[XB_XCNT(b.x)], 1u);
  return b;
}
__device__ __forceinline__ void xcd_barrier_complete(unsigned* bar, unsigned x, unsigned& nloc, unsigned& nx) {
  const unsigned G = gridDim.x * gridDim.y * gridDim.z;
  unsigned sum, cnt, mine, sp = 0u;
  for (;;) {
    sum = 0u; cnt = 0u; mine = 0u;
#pragma unroll
    for (unsigned j = 0; j < 16; ++j) { const unsigned c = xb_ld(&bar[XB_XCNT(j)]); sum += c; cnt += (c > 0u) ? 1u : 0u; mine = (j == x) ? c : mine; }
    if (sum == G) break;
    __builtin_amdgcn_s_sleep(1);
    if ((++sp & 255u) == 0u) { if (xb_ld(&bar[XB_TMO])) break; if (sp > XB_SPIN_CAP) { atomicAdd(&bar[XB_TMO], 1u); break; } }
  }
  nloc = mine > 0u ? mine : 1u; nx = cnt > 0u ? cnt : 1u;
}
__device__ __forceinline__ void xcd_barrier(const XcdBarrier& b) {
  asm volatile("s_waitcnt vmcnt(0)" ::: "memory");
  __syncthreads();
  if (threadIdx.x == 0) {
    unsigned* bar = b.bar;
    __builtin_amdgcn_s_waitcnt(0);
    unsigned nloc = b.st[0], nx = b.st[1];
    if (nloc == 0u) { xcd_barrier_complete(bar, b.x, nloc, nx); b.st[0] = nloc; b.st[1] = nx; }
    const unsigned old = xb_add(&bar[XB_XSUB(b.x)], 1u);
    const unsigned gen = old / nloc;
    if (old + 1u == (gen + 1u) * nloc) {
      __builtin_amdgcn_fence(__ATOMIC_RELEASE, "agent");
      asm volatile("s_waitcnt vmcnt(0)" ::: "memory");
      const unsigned og = xb_add(&bar[XB_TOP], 1u);
      const unsigned tg = og / nx;
      if (og + 1u == (tg + 1u) * nx) xb_add(&bar[XB_TOPGEN], 1u);
      else XB_SPIN(xb_ld(&bar[XB_TOPGEN]) == tg, bar);
      __builtin_amdgcn_fence(__ATOMIC_ACQUIRE, "agent");
      xb_add(&bar[XB_XGEN(b.x)], 1u);
      asm volatile("s_waitcnt vmcnt(0)" ::: "memory");
    } else {
      XB_SPIN(xb_ld(&bar[XB_XGEN(b.x)]) == gen, bar);
      __builtin_amdgcn_fence(__ATOMIC_ACQUIRE, "agent");
      asm volatile("s_waitcnt vmcnt(0)" ::: "memory");
    }
  }
  __syncthreads();
}

__global__ void __launch_bounds__(NTH) mega(Params p) {
  cg::grid_group grid = cg::this_grid();
  unsigned char* ws = p.ws;
  volatile LAS unsigned* xb_st = (volatile LAS unsigned*)((LAS unsigned char*)smem + (LDS_BYTES - 16));
  if (threadIdx.x == 0) { xb_st[0] = 0u; xb_st[1] = 0u; }
  __syncthreads();
  const XcdBarrier xb = xcd_barrier_post((unsigned*)(ws + OFF_BAR), xb_st);
  const int bid = blockIdx.x, nb = gridDim.x, gnth = nb * NTH;
#define FRESH_TID() int tid = threadIdx.x; asm volatile("" : "+v"(tid)); const int gtid = bid * NTH + tid; (void)gtid;
  float* MOD = (float*)(ws + OFF_MOD);
  float* SUMSQ = (float*)(ws + OFF_SUMSQ);
  float* ROPE = (float*)(ws + OFF_ROPE);
  bf16_t* U = (bf16_t*)(p.out + OOFF_U);
  bf16_t* WBT = (bf16_t*)(p.out + OOFF_WB);
  bf16_t* WA1 = (bf16_t*)(ws + OFF_WA);
  bf16_t* WA2 = WA1 + (size_t)6400 * 2048;

#if (PHASE_MASK >> 0) & 1
  {
  FRESH_TID();
  for (int u = bid; u < 192; u += nb) {
    const int ks = u / 24, j = (u % 24) * NTH + tid;
    float* sc = (float*)smem;
    __syncthreads();
    if (tid < 256) { sc[tid] = siluf_(p.c[ks * 256 + tid]); sc[256 + tid] = siluf_(p.c_ctx[ks * 256 + tid]); }
    __syncthreads();
    float a0 = 0.f, a1 = 0.f;
    for (int k0 = 0; k0 < 256; k0 += 16) {
      float w[16];
#pragma unroll
      for (int e = 0; e < 16; ++e) w[e] = p.w_mod[(size_t)(ks * 256 + k0 + e) * 12288 + j];
#pragma unroll
      for (int e = 0; e < 16; ++e) { a0 += sc[k0 + e] * w[e]; a1 += sc[256 + k0 + e] * w[e]; }
    }
    if (ks == 0) { const float b = p.b_mod[j]; a0 += b; a1 += b; }
    atomicAdd(MOD + j, a0);
    atomicAdd(MOD + 12288 + j, a1);
  }
  __syncthreads();
  for (int i = gtid; i < 256 * 32; i += gnth) {
    const int pos = i >> 5, d = i & 31;
    const float freq = exp2f(-(float)d * (13.287712379549449f / 32.0f));
    const float rev = (float)pos * freq * 0.15915494309189535f;
    const float fr_ = rev - floorf(rev);
    ROPE[i * 2 + 0] = __builtin_amdgcn_cosf(fr_);
    ROPE[i * 2 + 1] = __builtin_amdgcn_sinf(fr_);
  }
  convert_segment(p.w_in, INC, 0, 2048, 2048, WA1, true);
  convert_segment(p.w_in, INC, 2048, 2048, 2048, WA1 + (size_t)2048 * 2048, true);
  convert_segment(p.w_in, INC, 16384, 2048, 2048, WA1 + (size_t)4096 * 2048, false);
  convert_segment(p.w_in, INC, 18432, 128, 2048, WA1 + (size_t)6144 * 2048, false);
  convert_segment(p.w_in, INC, 4096, 2048, 2048, WA2, false);
  convert_segment(p.w_in, INC, 12288, 4096, 2048, WA2 + (size_t)2048 * 2048, false);
  }
#endif
  if (p.ws == nullptr) grid.sync();
  xcd_barrier(xb);

#if (PHASE_MASK >> 1) & 1
  for (int rep_ = 0; rep_ < 1 + ((DUP_MASK >> 1) & 1); ++rep_) {
  modnorm_rows(p.ctx, CTX, p.x, SEQ, p.norm1_w, MOD + 12288 + 2048, MOD + 12288, MOD + 2048, MOD, U);
  }
#endif
  xcd_barrier(xb);

#if (PHASE_MASK >> 2) & 1
  for (int rep_ = 0; rep_ < 1 + ((DUP_MASK >> 2) & 1); ++rep_) {
  {
    EpiA1 e1{(bf16_t*)(ws + OFF_Q), (bf16_t*)(ws + OFF_K), (bf16_t*)(ws + OFF_BCRAW), (float*)(ws + OFF_DTRAW), ROPE};
    EpiA2 e2{(bf16_t*)(ws + OFF_VT), (bf16_t*)(ws + OFF_XTRAW)};
    const int n1 = 65 * 25, n2 = 24 * 65;
    for (int L = bid; L < n1 + n2; L += nb) {
      int pm, pn;
      if (L < n2) { unit_map(L, 24, 65, pm, pn); gemm_unit(WA2, 2048, U, 2048, 2048, pm, pn, e2); }
      else { unit_map(L - n2, 65, 25, pm, pn); gemm_unit(U, 2048, WA1, 2048, 2048, pm, pn, e1); }
    }
    {
      int tid = threadIdx.x;
      asm volatile("" : "+v"(tid));
      unsigned* qhead = (unsigned*)(ws + OFF_BAR) + 3520;
      volatile unsigned* bc = (volatile unsigned*)(smem + 66560);
      for (;;) {
        __syncthreads();
        if (tid == 0) *bc = atomicAdd(qhead, 1u);
        __syncthreads();
        const int t = (int)*bc;
        if (t >= 2304) break;
        if (t < 256) convert_tile(p.w_in, INC, 6144, 2048, WBT, t >> 5, t & 31, tid);
        else if (t < 768) convert_tile(p.w_in, INC, 8192, 2048, WBT + (size_t)2048 * 2048, (t - 256) >> 5, (t - 256) & 31, tid);
        else if (t < 1280) convert_tile(p.w_in, INC, 18560, 2048, WBT + (size_t)6144 * 2048, (t - 768) >> 5, (t - 768) & 31, tid);
        else if (t < 1536) convert_tile(p.w_ret_out, 2048, 0, 2048, (bf16_t*)(ws + OFF_WRO), (t - 1280) >> 5, (t - 1280) & 31, tid);
        else if (t < 2048) convert_tile(p.w_ssd_out, 2048, 0, 4096, (bf16_t*)(ws + OFF_WSO), (t - 1536) >> 6, (t - 1536) & 63, tid);
        else convert_tile(p.w_o, 2048, 0, 2048, (bf16_t*)(ws + OFF_WO), (t - 2048) >> 5, (t - 2048) & 31, tid);
      }
      __syncthreads();
    }
  }
  }
#endif
  xcd_barrier(xb);
  PROBE_POINT(2, OFF_Q, OFF_XT, OFF_SR, OFF_WA)

#if (PHASE_MASK >> 3) & 1
  for (int rep_ = 0; rep_ < 1 + ((DUP_MASK >> 3) & 1); ++rep_) {
  {
  FRESH_TID();
  {
    float* DTRAW = (float*)(ws + OFF_DTRAW);
    float* DTF = (float*)(ws + OFF_DTF); float* DTB = (float*)(ws + OFF_DTB);
    float* CSF = (float*)(ws + OFF_CSF); float* RCSB = (float*)(ws + OFF_RCSB);
    if ((tid >> 6) == 0) {
      for (int w = bid; w < NCH * 2; w += nb) {
        const int c = w >> 1, dir = w & 1, h = tid & 63;
        const float bias = p.ssd_dt_bias[dir * 64 + h], a = -__expf(p.ssd_a_log[dir * 64 + h]);
        float* __restrict__ DTO = dir ? DTB : DTF;
        float* __restrict__ CSO = dir ? RCSB : CSF;
        float cs = 0.f;
        for (int jb = 0; jb < CH; jb += 16) {
          float raw[16];
#pragma unroll
          for (int e = 0; e < 16; ++e) {
            const int j = dir ? (CH - 1 - jb - e) : (jb + e);
            raw[e] = DTRAW[((size_t)c * CH + j) * 128 + dir * 64 + h];
          }
#pragma unroll
          for (int e = 0; e < 16; ++e) {
            const int j = dir ? (CH - 1 - jb - e) : (jb + e);
            const size_t r = (size_t)c * CH + j;
            const float dt = softplusf_(raw[e] + bias);
            cs += dt * a;
            DTO[r * 64 + h] = dt; CSO[r * 64 + h] = cs;
          }
        }
      }
    }
    const bf16_t* __restrict__ BCRAW = (const bf16_t*)(ws + OFF_BCRAW);
    bf16_t* __restrict__ Bb = (bf16_t*)(ws + OFF_B); bf16_t* __restrict__ Cb = (bf16_t*)(ws + OFF_C);
#pragma unroll 2
    for (int i = gtid; i < R * 256; i += gnth) {
      const int r = i >> 8, c8 = (i & 255) * 8;
      const int s0 = r < CTX ? 0 : CTX, s1 = r < CTX ? CTX : R;
      bf16x8 xv[5];
      float msk[5];
#pragma unroll
      for (int j = 0; j < 5; ++j) {
        const int rr = r + j - 2;
        const bool ok = rr >= s0 && rr < s1;
        msk[j] = ok ? 1.f : 0.f;
        xv[j] = *(const bf16x8*)(BCRAW + (size_t)(ok ? rr : r) * 2048 + c8);
      }
      const float* cwp = p.conv_w + 4096 + c8;
      const f32x4 b0 = *(const f32x4*)(p.conv_b + 4096 + c8), b1 = *(const f32x4*)(p.conv_b + 4096 + c8 + 4);
      float a[8] = {b0[0], b0[1], b0[2], b0[3], b1[0], b1[1], b1[2], b1[3]};
#pragma unroll
      for (int j = 0; j < 5; ++j) {
        const f32x4 w0 = *(const f32x4*)(cwp + (size_t)j * 6144) * msk[j], w1 = *(const f32x4*)(cwp + (size_t)j * 6144 + 4) * msk[j];
#pragma unroll
        for (int e = 0; e < 4; ++e) { a[e] += bf2f((unsigned short)xv[j][e]) * w0[e]; a[4 + e] += bf2f((unsigned short)xv[j][4 + e]) * w1[e]; }
      }
      u32x4 w;
      w.x = cvt_pk_bf16(siluf_(a[0]), siluf_(a[1])); w.y = cvt_pk_bf16(siluf_(a[2]), siluf_(a[3]));
      w.z = cvt_pk_bf16(siluf_(a[4]), siluf_(a[5])); w.w = cvt_pk_bf16(siluf_(a[6]), siluf_(a[7]));
      bf16_t* dst = c8 < 1024 ? Bb + (size_t)r * 1024 + c8 : Cb + (size_t)r * 1024 + (c8 - 1024);
      *(u32x4*)dst = w;
    }
    const bf16_t* __restrict__ XTRAW = (const bf16_t*)(ws + OFF_XTRAW);
    bf16_t* __restrict__ XT = (bf16_t*)(ws + OFF_XT);
#pragma unroll 2
    for (int i = gtid; i < 4096 * (R / 16); i += gnth) {
      const int ch = i / (R / 16), t16 = (i % (R / 16)) * 16;
      const int s0 = t16 < CTX ? 0 : CTX, s1 = t16 < CTX ? CTX : R;
      const bf16_t* src = XTRAW + (size_t)ch * R;
      const bool okp = t16 - 8 >= s0, okn = t16 + 16 < s1;
      const bf16x8 vp = *(const bf16x8*)(src + (okp ? t16 - 8 : t16));
      const bf16x8 v0 = __builtin_nontemporal_load((const bf16x8*)(src + t16));
      const bf16x8 v1 = __builtin_nontemporal_load((const bf16x8*)(src + t16 + 8));
      const bf16x8 vn = *(const bf16x8*)(src + (okn ? t16 + 16 : t16));
      float x[20];
      x[0] = okp ? bf2f((unsigned short)vp[6]) : 0.f;
      x[1] = okp ? bf2f((unsigned short)vp[7]) : 0.f;
#pragma unroll
      for (int e = 0; e < 8; ++e) { x[2 + e] = bf2f((unsigned short)v0[e]); x[10 + e] = bf2f((unsigned short)v1[e]); }
      x[18] = okn ? bf2f((unsigned short)vn[0]) : 0.f;
      x[19] = okn ? bf2f((unsigned short)vn[1]) : 0.f;
      float wj[5];
#pragma unroll
      for (int j = 0; j < 5; ++j) wj[j] = p.conv_w[(size_t)j * 6144 + ch];
      const float cb = p.conv_b[ch];
      float o[16];
#pragma unroll
      for (int e = 0; e < 16; ++e) {
        float a = cb;
#pragma unroll
        for (int j = 0; j < 5; ++j) a += x[e + j] * wj[j];
        o[e] = siluf_(a);
      }
      u32x4 w;
      w.x = cvt_pk_bf16(o[0], o[1]); w.y = cvt_pk_bf16(o[2], o[3]); w.z = cvt_pk_bf16(o[4], o[5]); w.w = cvt_pk_bf16(o[6], o[7]);
      *(u32x4*)(XT + (size_t)ch * R + t16) = w;
      w.x = cvt_pk_bf16(o[8], o[9]); w.y = cvt_pk_bf16(o[10], o[11]); w.z = cvt_pk_bf16(o[12], o[13]); w.w = cvt_pk_bf16(o[14], o[15]);
      *(u32x4*)(XT + (size_t)ch * R + t16 + 8) = w;
    }
  }
  }
  }
#endif
  xcd_barrier(xb);
  PROBE_POINT(3, OFF_XT, OFF_DTRAW, OFF_DTF, OFF_SR)

#if (PHASE_MASK >> 4) & 1
  for (int rep_ = 0; rep_ < 1 + ((DUP_MASK >> 4) & 1); ++rep_) {
  for (int it = bid; it < NCH * 24; it += nb) {
    if (it < NCH * 8) state_build_item<1>(p, it >> 3, it & 7);
    else { const int r = it - NCH * 8; state_build_item<0>(p, r >> 4, r & 15); }
  }
  }
#endif
  xcd_barrier(xb);
  PROBE_POINT(4, OFF_SR, OFF_WA, 0, 0)

#if (PHASE_MASK >> 5) & 1
  for (int rep_ = 0; rep_ < 1 + ((DUP_MASK >> 5) & 1); ++rep_) {
  {
  FRESH_TID();
  {
    bf16_t* SR = (bf16_t*)(ws + OFF_SR);
    bf16_t* SS = (bf16_t*)(ws + OFF_SS);
    const float* CSF = (const float*)(ws + OFF_CSF); const float* RCSB = (const float*)(ws + OFF_RCSB);
    for (int i = gtid; i < 65536 + 131072; i += gnth) {
      bf16_t* base; size_t cstride; int dir, h; bool isr = i < 65536;
      if (isr) { const int e = i * 8; dir = e / (16 * 16384); h = (e / 16384) & 15; base = SR + e; cstride = 524288; }
      else { const int e = (i - 65536) * 8; h = e / 16384; dir = (e / 8192) & 1; base = SS + e; cstride = 1048576; }
      float decr = 0.f;
      if (isr) { const float lg = -log1pf(__expf(-p.ret_decay_logit[dir * 16 + h])); decr = __expf(256.0f * lg); }
      float H[8];
#pragma unroll
      for (int e = 0; e < 8; ++e) H[e] = 0.f;
      u32x4 q[4]; float dq[4];
#pragma unroll
      for (int k = 0; k < 4; ++k) {
        const int c = dir == 0 ? k : (k == 0 ? 0 : NCH - k);
        q[k] = *(const u32x4*)(base + (size_t)c * cstride);
        dq[k] = isr ? 0.f : (dir == 0 ? CSF[((size_t)c * CH + 255) * 64 + h] : RCSB[((size_t)c * CH) * 64 + h]);
      }
      for (int s0 = 0; s0 < NCH; s0 += 4) {
#pragma unroll
        for (int k = 0; k < 4; ++k) {
          const int s = s0 + k;
          if (s < NCH) {
            const int c = dir == 0 ? s : (s == 0 ? 0 : NCH - s);
            bf16_t* ptr = base + (size_t)c * cstride;
            const u32x4 tv = q[k];
            const float dl = dq[k];
            if (s + 4 < NCH) {
              const int cn = dir == 0 ? s + 4 : NCH - (s + 4);
              q[k] = *(const u32x4*)(base + (size_t)cn * cstride);
              dq[k] = isr ? 0.f : (dir == 0 ? CSF[((size_t)cn * CH + 255) * 64 + h] : RCSB[((size_t)cn * CH) * 64 + h]);
            }
            u32x4 hv;
            hv.x = cvt_pk_bf16(H[0], H[1]); hv.y = cvt_pk_bf16(H[2], H[3]); hv.z = cvt_pk_bf16(H[4], H[5]); hv.w = cvt_pk_bf16(H[6], H[7]);
            if (rep_ == ((DUP_MASK >> 5) & 1) || p.ws == nullptr) *(u32x4*)ptr = hv;
            const float dec = isr ? decr : __expf(dl);
            H[0] = dec * H[0] + bflo(tv.x); H[1] = dec * H[1] + bfhi(tv.x);
            H[2] = dec * H[2] + bflo(tv.y); H[3] = dec * H[3] + bfhi(tv.y);
            H[4] = dec * H[4] + bflo(tv.z); H[5] = dec * H[5] + bfhi(tv.z);
            H[6] = dec * H[6] + bflo(tv.w); H[7] = dec * H[7] + bfhi(tv.w);
          }
        }
      }
    }
  }
  }
  }
#endif
  xcd_barrier(xb);
  PROBE_POINT(5, OFF_SR, OFF_WA, 0, 0)

#if (PHASE_MASK >> 6) & 1
  for (int rep_ = 0; rep_ < 1 + ((DUP_MASK >> 6) & 1); ++rep_) {
  for (int it = bid; it < 64 * 16 * 2; it += nb) {
    const int half = (it >> 3) & 1, q = ((it >> 4) << 3) | (it & 7), h = q & 15, cc = 1 + (q >> 4);
    ret_out_item(p, cc, h, half, rep_ == ((DUP_MASK >> 6) & 1) || p.ws == nullptr);
  }
  }
#endif
  xcd_barrier(xb);
  PROBE_POINT(6, OFF_Q, OFF_K, 0, 0)

#if (PHASE_MASK >> 7) & 1
  for (int rep_ = 0; rep_ < 1 + ((DUP_MASK >> 7) & 1); ++rep_) {
  for (int ph = 0; ph < 2; ++ph) {
    if ((ph == 0) == ((bid & 1) != 0)) {
      convert_segment(p.w_mlp1, DFF, 0, DFF, 2048, (bf16_t*)(ws + OFF_W1T), false, MOD + 6144, (float*)(ws + OFF_BIAS1));
      convert_segment(p.w_mlp2, 2048, 0, 2048, DFF, (bf16_t*)(ws + OFF_W2T), false);
    }
    if (ph == 0) {
      for (int it = bid; it < 64 * 8 * 2; it += nb) {
        const int half = (it >> 3) & 1, q = ((it >> 4) << 3) | (it & 7), g = q & 7, cc = 1 + (q >> 3);
        ssd_out_item(p, cc, g, half);
      }
    }
  }
  }
#endif
  xcd_barrier(xb);
  PROBE_POINT(7, OFF_YS, OFF_XT, OFF_SR, OFF_SS)

#if (PHASE_MASK >> 8) & 1
  for (int rep_ = 0; rep_ < 1 + ((DUP_MASK >> 8) & 1); ++rep_) {
  {
    EpiB e{(bf16_t*)(ws + OFF_Q), (bf16_t*)(ws + OFF_YS), (bf16_t*)(ws + OFF_G), p.ssd_norm_w, SUMSQ};
    for (int L = bid; L < 64 * 40; L += nb) {
      int pm, pn; unit_map(L, 64, 40, pm, pn);
      gemm_unit(U + (size_t)CTX * 2048, 2048, WBT, 2048, 2048, pm, pn, e);
    }
  }
  }
#endif
  xcd_barrier(xb);
  PROBE_POINT(8, OFF_Q, OFF_B, 0, 0)

#if (PHASE_MASK >> 9) & 1
  for (int rep_ = 0; rep_ < 1 + ((DUP_MASK >> 9) & 1); ++rep_) {
  {
    EpiO1a ea{(const bf16_t*)(ws + OFF_G), (bf16_t*)(ws + OFF_M)};
    EpiO1b eb{(const bf16_t*)(ws + OFF_G), SUMSQ, (bf16_t*)(ws + OFF_M)};
    for (int L = bid; L < 64 * 8; L += nb) {
      int pm, pn; unit_map(L, 64, 8, pm, pn);
      gemm_unit((const bf16_t*)(ws + OFF_Q) + (size_t)CTX * 2048, 2048, (const bf16_t*)(ws + OFF_WRO), 2048, 2048, pm, pn, ea);
      gemm_unit((const bf16_t*)(ws + OFF_YS), 4096, (const bf16_t*)(ws + OFF_WSO), 4096, 4096, pm, pn, eb);
    }
  }
  }
#endif
  xcd_barrier(xb);
  PROBE_POINT(9, OFF_M, OFF_DTRAW, 0, 0)

#if (PHASE_MASK >> 10) & 1
  for (int rep_ = 0; rep_ < 1 + ((DUP_MASK >> 10) & 1); ++rep_) {
  {
    EpiRes9 e{p.x, MOD + 4096, (float*)(ws + OFF_H1), p.norm2_w, MOD + 8192, (bf16_t*)(ws + OFF_F), (float*)(ws + OFF_SUMSQ2)};
    for (int L = bid; L < 64 * 8; L += nb) {
      int pm, pn; unit_map(L, 64, 8, pm, pn);
      gemm_unit((const bf16_t*)(ws + OFF_M), 2048, (const bf16_t*)(ws + OFF_WO), 2048, 2048, pm, pn, e);
    }
  }
  }
#endif
  xcd_barrier(xb);
  PROBE_POINT(10, OFF_H1, OFF_H1 + (size_t)SEQ * DM * 4, 0, 0)

#if (PHASE_MASK >> 12) & 1
  for (int rep_ = 0; rep_ < 1 + ((DUP_MASK >> 12) & 1); ++rep_) {
  {
    EpiM1 e{(bf16_t*)(ws + OFF_A1), (const float*)(ws + OFF_SUMSQ2), (const float*)(ws + OFF_BIAS1)};
    for (int L = bid; L < 64 * 32; L += nb) {
      int pm, pn; unit_map(L, 64, 32, pm, pn);
      gemm_unit((const bf16_t*)(ws + OFF_F), 2048, (const bf16_t*)(ws + OFF_W1T), 2048, 2048, pm, pn, e);
    }
  }
  }
#endif
  xcd_barrier(xb);
  PROBE_POINT(12, OFF_A1, OFF_A1 + (size_t)SEQ * DFF * 2, 0, 0)

#if (PHASE_MASK >> 13) & 1
  for (int rep_ = 0; rep_ < 1 + ((DUP_MASK >> 13) & 1); ++rep_) {
  {
    EpiRes e{(const float*)(ws + OFF_H1), MOD + 10240, (float*)(ws + OFF_H1), rep_ == ((DUP_MASK >> 13) & 1) || p.ws == nullptr};
    for (int L = bid; L < 64 * 8; L += nb) {
      int pm, pn; unit_map(L, 64, 8, pm, pn);
      gemm_unit((const bf16_t*)(ws + OFF_A1), DFF, (const bf16_t*)(ws + OFF_W2T), DFF, DFF, pm, pn, e);
    }
  }
  }
#endif
  xcd_barrier(xb);
  PROBE_POINT(13, OFF_H1, OFF_H1 + (size_t)SEQ * DM * 4, 0, 0)

#if (PHASE_MASK >> 14) & 1
  for (int rep_ = 0; rep_ < 1 + ((DUP_MASK >> 14) & 1); ++rep_) {
  {
  FRESH_TID();
  {
    const float* H2 = (const float*)(ws + OFF_H1);
    float* outp = (float*)p.out;
    const int lane = tid & 63, gw = bid * (NTH / 64) + (tid >> 6), nw_ = nb * (NTH / 64);
    for (int r = gw; r < SEQ; r += nw_) {
      f32x4 v[8];
      float ss = 0.f;
#pragma unroll
      for (int i = 0; i < 8; ++i) { v[i] = __builtin_nontemporal_load((const f32x4*)(H2 + (size_t)r * DM + i * 256 + lane * 4)); ss += v[i][0] * v[i][0] + v[i][1] * v[i][1] + v[i][2] * v[i][2] + v[i][3] * v[i][3]; }
      ss = wave_sum(ss);
      const float rs = rsqrtf(ss * (1.0f / DM) + EPS);
#pragma unroll
      for (int i = 0; i < 8; ++i) {
        const f32x4 w = *(const f32x4*)(p.final_norm_w + i * 256 + lane * 4);
        f32x4 o = v[i] * rs * w;
        __builtin_nontemporal_store(o, (f32x4*)(outp + (size_t)r * DM + i * 256 + lane * 4));
      }
    }
  }
  }
  }
#endif
}

extern "C" void kernel_launch(void* const* d_in, const int* in_sizes, int n_in, void* d_out, int out_size, void* d_ws, size_t ws_size,
                              hipStream_t stream) {
  static int grid_blocks = 0;
  if (!grid_blocks) {
    int dev = 0, cus = 0, per_cu = 0;
    (void)hipGetDevice(&dev);
    (void)hipDeviceGetAttribute(&cus, hipDeviceAttributeMultiprocessorCount, dev);
    (void)hipFuncSetAttribute((const void*)mega, hipFuncAttributeMaxDynamicSharedMemorySize, LDS_BYTES);
    (void)hipOccupancyMaxActiveBlocksPerMultiprocessor(&per_cu, mega, NTH, LDS_BYTES);
    if (per_cu > 1) per_cu = 1;
    grid_blocks = cus * per_cu;
  }
  if (ws_size < WS_NEED || grid_blocks <= 0) { fprintf(stderr, "workspace too small or no occupancy\n"); return; }
  Params p{};
  const float** pp = (const float**)&p;
  for (int i = 0; i < 23; ++i) pp[i] = (const float*)d_in[i];
  p.ws = (unsigned char*)d_ws;
  p.out = (unsigned char*)d_out;
  (void)hipMemsetAsync((unsigned char*)d_ws + OFF_MOD, 0, OFF_ROPE - OFF_MOD, stream);
  void* args[] = {&p};
  hipError_t e = hipLaunchCooperativeKernel((void*)mega, dim3(grid_blocks), dim3(NTH), args, LDS_BYTES, stream);
  if (e != hipSuccess) fprintf(stderr, "cooperative launch failed: %s (grid %d)\n", hipGetErrorString(e), grid_blocks);
}
```
